# Optimizing an MI355X kernel written in HIP

```python
import math
import jax, jax.numpy as jnp
from jax import lax
import numpy as np

D_MODEL = 2048
BATCH = 4
SEQ = 2048
DEPTH = 4

N_A = DEPTH // 2
N_B = DEPTH - N_A
HGRN_HEADS = D_MODEL // 128
HGRN_DK = 128
HGRN_DV = D_MODEL // HGRN_HEADS
HGRN_CHUNK = 32
ATTN_HEAD_DIM = 128
ATTN_HEADS = D_MODEL // ATTN_HEAD_DIM
MOBA_BLOCK = 256
MOBA_TOPK = 3
MOBA_QUERY_BLOCK = 4
D_FF = 4 * D_MODEL
EPS = 1e-6
NEG_BIG = -1e30
LB_FLOOR = 1e-30

kernel_name = "hgrn2_moba_yoco_hybrid"

F32 = jnp.float32


def rms_norm(x, g):
    xf = x.astype(F32)
    return xf * lax.rsqrt(jnp.mean(xf * xf, axis=-1, keepdims=True) + EPS) * g.astype(F32)


def chunked_gla(q, k, v, log_f):
    B, S, H, DK = q.shape
    DV = v.shape[-1]
    C = HGRN_CHUNK
    NC = S // C

    def to_chunks(t):
        return t.reshape(B, NC, C, H, t.shape[-1]).transpose(1, 0, 3, 2, 4)

    causal = jnp.tril(jnp.ones((C, C), dtype=bool))[:, :, None]

    def step(state, inp):
        qc, kc, vc, gc = inp
        b = jnp.cumsum(gc, axis=-2)
        inter = jnp.einsum('bhtd,bhde->bhte', qc * jnp.exp(b), state)
        diff = b[:, :, :, None, :] - b[:, :, None, :, :]
        decay = jnp.where(causal, jnp.exp(jnp.where(causal, diff, 0.0)), 0.0)
        scores = jnp.einsum('bhtd,bhsd,bhtsd->bhts', qc, kc, decay)
        intra = jnp.einsum('bhts,bhse->bhte', scores, vc)
        b_last = b[:, :, -1]
        new_state = jnp.exp(b_last)[..., None] * state + jnp.einsum(
            'bhsd,bhse->bhde', kc * jnp.exp(b_last[:, :, None] - b), vc)
        return new_state, inter + intra

    state0 = jnp.zeros((B, H, DK, DV), F32)
    _, out = lax.scan(step, state0, (to_chunks(q), to_chunks(k), to_chunks(v), to_chunks(log_f)))
    return out.transpose(1, 0, 3, 2, 4).reshape(B, S, H, DV)


def hgrn2_mixer(hn, w_in, lb, head_gain, w_out):
    B, S, _ = hn.shape
    proj = hn @ w_in
    q, f_raw, i, g = jnp.split(proj.astype(F32), 4, axis=-1)
    q = jax.nn.silu(q)
    lb = lb.astype(F32)
    log_f = jnp.logaddexp(jnp.log(jnp.maximum(lb, LB_FLOOR)), jnp.log1p(-lb) + jax.nn.log_sigmoid(f_raw))
    k = (1.0 - lb) * jax.nn.sigmoid(-f_raw)
    heads = lambda t, d: t.reshape(B, S, HGRN_HEADS, d)
    o = chunked_gla(heads(q, HGRN_DK), heads(k, HGRN_DK), heads(i, HGRN_DV), heads(log_f, HGRN_DK))
    o = rms_norm(o, head_gain.reshape(HGRN_HEADS, HGRN_DV)).reshape(B, S, D_MODEL)
    o = o * jax.nn.silu(g)
    return o @ w_out


def shared_kv(h, kv_norm, w_kv, k_norm):
    B, S, _ = h.shape
    hn = rms_norm(h, kv_norm)
    k, v = jnp.split(hn @ w_kv, 2, axis=-1)
    k = rms_norm(k.reshape(B, S, ATTN_HEADS, ATTN_HEAD_DIM), k_norm)
    v = v.reshape(B, S, ATTN_HEADS, ATTN_HEAD_DIM).astype(F32)
    NB = -(-S // MOBA_BLOCK)
    pad = NB * MOBA_BLOCK - S

    def blocks(t):
        t = jnp.pad(t.transpose(0, 2, 1, 3), ((0, 0), (0, 0), (0, pad), (0, 0)))
        return t.reshape(B, ATTN_HEADS, NB, MOBA_BLOCK, ATTN_HEAD_DIM)

    k_blocks, v_blocks = blocks(k), blocks(v)
    counts = jnp.clip(S - jnp.arange(NB) * MOBA_BLOCK, 1, MOBA_BLOCK).astype(F32)
    k_mean = jnp.sum(k_blocks, axis=3) / counts[:, None]
    return k_blocks, v_blocks, k_mean


def moba_mixer(hn, w_q, q_norm, k_blocks, v_blocks, k_mean, w_o):
    B, S, _ = hn.shape
    H, dh = ATTN_HEADS, ATTN_HEAD_DIM
    NB = k_blocks.shape[2]
    q = rms_norm((hn @ w_q).reshape(B, S, H, dh), q_norm).transpose(0, 2, 1, 3)
    pos = jnp.arange(S)
    qblk = pos // MOBA_BLOCK
    gate = jnp.einsum('bhtd,bhnd->bhtn', q, k_mean)
    past = jnp.arange(NB)[None, :] < qblk[:, None]
    gate = jnp.where(past, gate, NEG_BIG)
    _, sel = lax.top_k(gate, min(MOBA_TOPK, NB))
    valid = sel < qblk[:, None]
    own = jnp.broadcast_to(qblk[:, None], (B, H, S, 1))
    sel = jnp.concatenate([sel, own], axis=-1).astype(jnp.int32)
    valid = jnp.concatenate([valid, jnp.ones(own.shape, dtype=bool)], axis=-1)

    scale = dh ** -0.5
    slopes = 2.0 ** (-8.0 * jnp.arange(1, H + 1, dtype=F32) / H)
    bi = jnp.arange(B)[:, None, None, None]
    hi = jnp.arange(H)[None, :, None, None]
    key_off = jnp.arange(MOBA_BLOCK)

    def attend(args):
        qc, selc, validc, tq = args
        kg = k_blocks[bi, hi, selc]
        vg = v_blocks[bi, hi, selc]
        kpos = selc[..., None] * MOBA_BLOCK + key_off
        dist = (tq[:, None, None] - kpos).astype(F32)
        logits = jnp.einsum('bhqd,bhqrkd->bhqrk', qc, kg) * scale - slopes[:, None, None, None] * dist
        mask = validc[..., None] & (dist >= 0)
        logits = jnp.where(mask, logits, NEG_BIG)
        p = jax.nn.softmax(logits.reshape(B, H, qc.shape[2], -1), axis=-1).reshape(logits.shape)
        p = jnp.where(mask, p, 0.0)
        return jnp.einsum('bhqrk,bhqrkd->bhqd', p, vg)

    NQ = S // MOBA_QUERY_BLOCK

    def qblocks(t):
        return jnp.moveaxis(t.reshape(B, H, NQ, MOBA_QUERY_BLOCK, *t.shape[3:]), 2, 0)

    out = lax.map(attend, (qblocks(q), qblocks(sel), qblocks(valid), pos.reshape(NQ, MOBA_QUERY_BLOCK)))
    out = jnp.moveaxis(out, 0, 2).reshape(B, H, S, dh).transpose(0, 2, 1, 3).reshape(B, S, D_MODEL)
    return out @ w_o


def sqrelu_mlp(hn, w1, w2):
    return jnp.square(jax.nn.relu(hn @ w1)) @ w2


def setup_inputs(seed: int = 0) -> dict:
    key = jax.random.key(seed)
    ks = jax.random.split(key, 20)
    nrm = lambda k, shape, fan_in: jax.random.normal(k, shape, F32) * (fan_in ** -0.5)
    gain = lambda k, shape: 1.0 + 0.02 * jax.random.normal(k, shape, F32)
    D = D_MODEL
    return {
        "x": jax.random.normal(ks[0], (BATCH, SEQ, D), F32),
        "a_norm": gain(ks[1], (N_A, D)),
        "a_w_in": nrm(ks[2], (N_A, D, 4 * D), D),
        "a_head_norm": gain(ks[3], (N_A, D)),
        "a_w_out": nrm(ks[4], (N_A, D, D), D),
        "lower_bounds": 0.1 * jax.random.normal(ks[5], (N_A, D), F32),
        "kv_norm": gain(ks[6], (D,)),
        "w_kv": nrm(ks[7], (D, 2 * D), D),
        "k_norm": gain(ks[8], (ATTN_HEAD_DIM,)),
        "b_norm": gain(ks[9], (N_B, D)),
        "b_w_q": nrm(ks[10], (N_B, D, D), D),
        "b_q_norm": gain(ks[11], (N_B, ATTN_HEAD_DIM)),
        "b_w_o": nrm(ks[12], (N_B, D, D), D),
        "mlp_norm": gain(ks[13], (DEPTH, D)),
        "mlp_w1": nrm(ks[14], (DEPTH, D, D_FF), D),
        "mlp_w2": nrm(ks[15], (DEPTH, D_FF, D), D_FF),
    }


def reference(x, a_norm, a_w_in, a_head_norm, a_w_out, lower_bounds, kv_norm, w_kv, k_norm,
              b_norm, b_w_q, b_q_norm, b_w_o, mlp_norm, mlp_w1, mlp_w2):
    h = x
    p = jax.nn.softmax(lower_bounds.astype(F32), axis=0)
    lbs = jnp.cumsum(p, axis=0) - p[0]
    k_blocks = v_blocks = k_mean = None
    for l in range(DEPTH):
        if l < N_A:
            mix = hgrn2_mixer(rms_norm(h, a_norm[l]), a_w_in[l], lbs[l], a_head_norm[l], a_w_out[l])
        else:
            if l == N_A:
                k_blocks, v_blocks, k_mean = shared_kv(h, kv_norm, w_kv, k_norm)
            j = l - N_A
            mix = moba_mixer(rms_norm(h, b_norm[j]), b_w_q[j], b_q_norm[j], k_blocks, v_blocks, k_mean, b_w_o[j])
        h = h + mix.astype(h.dtype)
        h = h + sqrelu_mlp(rms_norm(h, mlp_norm[l]), mlp_w1[l], mlp_w2[l]).astype(h.dtype)
    return h
```

```cpp
#include <hip/hip_runtime.h>
#include <cstdio>
#include <cstdint>

constexpr int D = 2048, NB = 4, S = 2048, M = NB * S, FF = 8192, H = 16, DH = 128, NBLK = 8, BLK = 256;
constexpr float EPS = 1e-6f;

__device__ __forceinline__ float wave_sum(float v) {
#pragma unroll
    for (int o = 1; o < 64; o <<= 1) v += __shfl_xor(v, o);
    return v;
}
__device__ __forceinline__ float wave_max(float v) {
#pragma unroll
    for (int o = 1; o < 64; o <<= 1) v = fmaxf(v, __shfl_xor(v, o));
    return v;
}

__global__ void k_copy(const float4* in, float4* out, size_t n4) {
    for (size_t i = (size_t)blockIdx.x * blockDim.x + threadIdx.x; i < n4; i += (size_t)gridDim.x * blockDim.x) out[i] = in[i];
}

__global__ void k_lbs(const float* lb, float* lbs) {
    const int d = blockIdx.x * blockDim.x + threadIdx.x;
    if (d >= D) return;
    const float a = lb[d], b = lb[D + d], m = fmaxf(a, b), ea = expf(a - m), eb = expf(b - m), s = ea + eb, p0 = ea / s, p1 = eb / s;
    lbs[d] = 0.f; lbs[D + d] = (p0 + p1) - p0;
}

__global__ __launch_bounds__(256) void k_rmsnorm(const float* h, const float* gain, float* out) {
    const int row = blockIdx.x * 4 + (threadIdx.x >> 6), lane = threadIdx.x & 63;
    const float4* p = (const float4*)(h + (size_t)row * D);
    const float4* g = (const float4*)gain;
    float4 v[8]; float s = 0.f;
#pragma unroll
    for (int j = 0; j < 8; ++j) { v[j] = p[lane + 64 * j]; s += v[j].x * v[j].x + v[j].y * v[j].y + v[j].z * v[j].z + v[j].w * v[j].w; }
    s = wave_sum(s);
    const float r = rsqrtf(s * (1.0f / D) + EPS);
    float4* o = (float4*)(out + (size_t)row * D);
#pragma unroll
    for (int j = 0; j < 8; ++j) { const float4 gg = g[lane + 64 * j]; float4 w; w.x = v[j].x * r * gg.x; w.y = v[j].y * r * gg.y; w.z = v[j].z * r * gg.z; w.w = v[j].w * r * gg.w; o[lane + 64 * j] = w; }
}

template <int MODE> __global__ __launch_bounds__(256) void k_gemm(const float* A, int lda, const float* W, int ldw, float* C, int ldc, int K) {
    __shared__ float As[16][132];
    __shared__ float Bs[16][132];
    const int bm = blockIdx.y * 128, bn = blockIdx.x * 128, tid = threadIdx.x, tx = tid & 15, ty = tid >> 4;
    float acc[8][8];
#pragma unroll
    for (int i = 0; i < 8; ++i)
#pragma unroll
        for (int j = 0; j < 8; ++j) acc[i][j] = 0.f;
    for (int k0 = 0; k0 < K; k0 += 16) {
#pragma unroll
        for (int i = 0; i < 2; ++i) {
            const int idx = tid + i * 256, r = idx >> 2, c4 = (idx & 3) * 4;
            const float4 a = *(const float4*)(A + (size_t)(bm + r) * lda + k0 + c4);
            As[c4 + 0][r] = a.x; As[c4 + 1][r] = a.y; As[c4 + 2][r] = a.z; As[c4 + 3][r] = a.w;
            const int rb = idx >> 5, cb = (idx & 31) * 4;
            *(float4*)&Bs[rb][cb] = *(const float4*)(W + (size_t)(k0 + rb) * ldw + bn + cb);
        }
        __syncthreads();
#pragma unroll
        for (int k = 0; k < 16; ++k) {
            float a[8], b[8];
#pragma unroll
            for (int i = 0; i < 8; ++i) a[i] = As[k][ty * 8 + i];
#pragma unroll
            for (int j = 0; j < 8; ++j) b[j] = Bs[k][tx * 8 + j];
#pragma unroll
            for (int i = 0; i < 8; ++i)
#pragma unroll
                for (int j = 0; j < 8; ++j) acc[i][j] = fmaf(a[i], b[j], acc[i][j]);
        }
        __syncthreads();
    }
#pragma unroll
    for (int i = 0; i < 8; ++i) {
        float* c = C + (size_t)(bm + ty * 8 + i) * ldc + bn + tx * 8;
#pragma unroll
        for (int j = 0; j < 8; ++j) {
            float v = acc[i][j];
            if (MODE == 1) v += c[j];
            if (MODE == 2) { v = fmaxf(v, 0.f); v = v * v; }
            c[j] = v;
        }
    }
}

__device__ __forceinline__ float log_sigmoid(float x) { return fminf(x, 0.f) - log1pf(expf(-fabsf(x))); }
__device__ __forceinline__ float logaddexp(float a, float b) { return fmaxf(a, b) + log1pf(expf(-fabsf(a - b))); }
__device__ __forceinline__ float silu(float x) { return x / (1.f + expf(-x)); }

__global__ void k_hgrn_elem(float* proj, const float* lbs_l, float* Kbuf) {
    for (size_t idx = (size_t)blockIdx.x * blockDim.x + threadIdx.x; idx < (size_t)M * D; idx += (size_t)gridDim.x * blockDim.x) {
        const size_t row = idx / D; const int d = (int)(idx % D);
        float* p = proj + row * (4 * D);
        const float q = p[d], f = p[D + d], g = p[3 * D + d], lb = lbs_l[d];
        p[d] = silu(q);
        const float a = logf(fmaxf(lb, 1e-30f)), bb = log1pf(-lb) + log_sigmoid(f);
        p[D + d] = logaddexp(a, bb);
        Kbuf[idx] = (1.f - lb) / (1.f + expf(f));
        p[3 * D + d] = silu(g);
    }
}

__global__ __launch_bounds__(64) void k_gla(const float* proj, const float* Kbuf, float* O) {
    const int bh = blockIdx.x >> 2, es = blockIdx.x & 3, b = bh / H, h = bh % H;
    const int lane = threadIdx.x, e = lane & 31, dh = lane >> 5;
    __shared__ float sq[16][128], sf[16][128], sk[16][128], sv[16][32];
    float St[64];
#pragma unroll
    for (int i = 0; i < 64; ++i) St[i] = 0.f;
    for (int t0 = 0; t0 < S; t0 += 16) {
        for (int i = lane; i < 16 * 128; i += 64) {
            const int tt = i >> 7, d = i & 127; const size_t row = (size_t)b * S + t0 + tt;
            sq[tt][d] = proj[row * (4 * D) + h * DH + d];
            sf[tt][d] = expf(proj[row * (4 * D) + D + h * DH + d]);
            sk[tt][d] = Kbuf[row * D + h * DH + d];
        }
        for (int i = lane; i < 16 * 32; i += 64) {
            const int tt = i >> 5, ee = i & 31; const size_t row = (size_t)b * S + t0 + tt;
            sv[tt][ee] = proj[row * (4 * D) + 2 * D + h * DH + es * 32 + ee];
        }
        __syncthreads();
        for (int tt = 0; tt < 16; ++tt) {
            const float v = sv[tt][e]; float o = 0.f;
#pragma unroll
            for (int i = 0; i < 64; ++i) { const int d = dh * 64 + i; St[i] = fmaf(sf[tt][d], St[i], sk[tt][d] * v); o = fmaf(St[i], sq[tt][d], o); }
            o += __shfl_xor(o, 32);
            if (dh == 0) O[((size_t)b * S + t0 + tt) * D + h * DH + es * 32 + e] = o;
        }
        __syncthreads();
    }
}

__global__ __launch_bounds__(256) void k_headnorm_gate(const float* O, const float* proj, const float* head_gain, float* OG) {
    const size_t gw = (size_t)blockIdx.x * 4 + (threadIdx.x >> 6); const int lane = threadIdx.x & 63;
    const size_t row = gw / H; const int h = (int)(gw % H);
    const size_t off = row * D + h * DH + lane * 2;
    const float2 v = *(const float2*)(O + off);
    const float s = wave_sum(v.x * v.x + v.y * v.y), r = rsqrtf(s * (1.0f / DH) + EPS);
    const float2 gn = *(const float2*)(head_gain + h * DH + lane * 2);
    const float2 g = *(const float2*)(proj + row * (4 * D) + 3 * D + h * DH + lane * 2);
    float2 o; o.x = v.x * r * gn.x * g.x; o.y = v.y * r * gn.y * g.y;
    *(float2*)(OG + off) = o;
}

__global__ __launch_bounds__(256) void k_kvnorm(const float* KV, const float* k_norm, float* Kn) {
    const size_t gw = (size_t)blockIdx.x * 4 + (threadIdx.x >> 6); const int lane = threadIdx.x & 63;
    const size_t row = gw / H; const int h = (int)(gw % H);
    const float2 v = *(const float2*)(KV + row * (2 * D) + h * DH + lane * 2);
    const float s = wave_sum(v.x * v.x + v.y * v.y), r = rsqrtf(s * (1.0f / DH) + EPS);
    const float2 gn = *(const float2*)(k_norm + lane * 2);
    float2 o; o.x = v.x * r * gn.x; o.y = v.y * r * gn.y;
    *(float2*)(Kn + row * D + h * DH + lane * 2) = o;
}

__global__ __launch_bounds__(128) void k_kmean(const float* Kn, float* kmean) {
    const int n = blockIdx.x % NBLK, h = (blockIdx.x / NBLK) % H, b = blockIdx.x / (NBLK * H), d = threadIdx.x;
    float s = 0.f;
    for (int j = 0; j < BLK; ++j) s += Kn[((size_t)b * S + n * BLK + j) * D + h * DH + d];
    kmean[(size_t)blockIdx.x * DH + d] = s * (1.0f / BLK);
}

__global__ __launch_bounds__(256) void k_moba(const float* Q, const float* q_norm, const float* Kn, const float* KV, const float* kmean, float* O) {
    __shared__ float sqv[4][DH];
    const int w = threadIdx.x >> 6, lane = threadIdx.x & 63;
    const size_t gw = (size_t)blockIdx.x * 4 + w;
    const size_t row = gw / H; const int h = (int)(gw % H);
    const int b = (int)(row / S), t = (int)(row % S), qb = t >> 8;
    float2 qv = *(const float2*)(Q + row * D + h * DH + lane * 2);
    {
        const float s = wave_sum(qv.x * qv.x + qv.y * qv.y), r = rsqrtf(s * (1.0f / DH) + EPS);
        const float2 gn = *(const float2*)(q_norm + lane * 2);
        qv.x *= r * gn.x; qv.y *= r * gn.y;
    }
    sqv[w][lane * 2] = qv.x; sqv[w][lane * 2 + 1] = qv.y;
    float gate[NBLK];
#pragma unroll
    for (int n = 0; n < NBLK; ++n) {
        const float2 km = *(const float2*)(kmean + ((size_t)(b * H + h) * NBLK + n) * DH + lane * 2);
        const float dd = wave_sum(qv.x * km.x + qv.y * km.y);
        gate[n] = (n < qb) ? dd : -1e30f;
    }
    unsigned selmask = 0u;
    if (qb <= 3) selmask = (1u << qb) - 1u;
    else {
#pragma unroll
        for (int it = 0; it < 3; ++it) {
            float best = -3e38f; int bi = 0;
#pragma unroll
            for (int n = 0; n < NBLK; ++n) { const bool ok = (n < qb) && !((selmask >> n) & 1u); if (ok && gate[n] > best) { best = gate[n]; bi = n; } }
            selmask |= 1u << bi;
        }
    }
    selmask |= 1u << qb;
    __syncthreads();
    const float scale = 0.08838834764831845f;
    const float slope = exp2f(-8.0f * (float)(h + 1) / (float)H);
    float m = -1e30f, l = 0.f, o0 = 0.f, o1 = 0.f;
    for (int n = 0; n <= qb; ++n) {
        if (!((selmask >> n) & 1u)) continue;
        for (int c = 0; c < BLK; c += 64) {
            const int kpos = n * BLK + c + lane;
            if (n * BLK + c > t) break;
            const float* kr = Kn + ((size_t)b * S + kpos) * D + h * DH;
            float dot = 0.f;
#pragma unroll 8
            for (int d4 = 0; d4 < DH / 4; ++d4) {
                const float4 kk = *(const float4*)(kr + d4 * 4); const float4 qq = *(const float4*)(&sqv[w][d4 * 4]);
                dot += kk.x * qq.x + kk.y * qq.y + kk.z * qq.z + kk.w * qq.w;
            }
            const bool valid = kpos <= t;
            const float logit = dot * scale - slope * (float)(t - kpos);
            const float cm = wave_max(valid ? logit : -1e30f);
            const float mn = fmaxf(m, cm);
            const float p = valid ? expf(logit - mn) : 0.f;
            const float alpha = expf(m - mn);
            l = l * alpha + wave_sum(p); o0 *= alpha; o1 *= alpha; m = mn;
            for (int j = 0; j < 64; ++j) {
                const float pj = __shfl(p, j);
                const float2 vv = *(const float2*)(KV + ((size_t)b * S + n * BLK + c + j) * (2 * D) + D + h * DH + lane * 2);
                o0 = fmaf(pj, vv.x, o0); o1 = fmaf(pj, vv.y, o1);
            }
        }
    }
    float2 o; o.x = o0 / l; o.y = o1 / l;
    *(float2*)(O + row * D + h * DH + lane * 2) = o;
}

extern "C" void kernel_launch(void* const* d_in, const int* in_sizes, int n_in, void* d_out, int out_size, void* d_ws, size_t ws_size, hipStream_t stream) {
    const float* x = (const float*)d_in[0];
    const float* a_norm = (const float*)d_in[1];
    const float* a_w_in = (const float*)d_in[2];
    const float* a_head_norm = (const float*)d_in[3];
    const float* a_w_out = (const float*)d_in[4];
    const float* lower_bounds = (const float*)d_in[5];
    const float* kv_norm = (const float*)d_in[6];
    const float* w_kv = (const float*)d_in[7];
    const float* k_norm = (const float*)d_in[8];
    const float* b_norm = (const float*)d_in[9];
    const float* b_w_q = (const float*)d_in[10];
    const float* b_q_norm = (const float*)d_in[11];
    const float* b_w_o = (const float*)d_in[12];
    const float* mlp_norm = (const float*)d_in[13];
    const float* mlp_w1 = (const float*)d_in[14];
    const float* mlp_w2 = (const float*)d_in[15];
    float* h = (float*)d_out;

    const size_t MD = (size_t)M * D;
    char* ws = (char*)d_ws; size_t off = 0;
    auto carve = [&](size_t bytes) { char* p = ws + off; off += (bytes + 255) & ~(size_t)255; return p; };
    float* lbs = (float*)carve(2 * D * 4);
    float* kmean = (float*)carve((size_t)NB * H * NBLK * DH * 4);
    float* hn = (float*)carve(MD * 4);
    float* proj = (float*)carve((size_t)M * FF * 4);
    float* Kbuf = (float*)carve(MD * 4);
    float* O = (float*)carve(MD * 4);
    float* OG = (float*)carve(MD * 4);
    float* Kn = (float*)carve(MD * 4);
    float* KV = (float*)carve(MD * 2 * 4);
    if (off > ws_size || n_in != 16 || out_size != (int)MD) { fprintf(stderr, "kernel_launch: bad sizes (ws %zu need %zu, n_in %d, out %d)\n", ws_size, off, n_in, out_size); return; }

    k_copy<<<2048, 256, 0, stream>>>((const float4*)x, (float4*)h, MD / 4);
    k_lbs<<<D / 256, 256, 0, stream>>>(lower_bounds, lbs);
    auto mlp = [&](int l) {
        k_rmsnorm<<<M / 4, 256, 0, stream>>>(h, mlp_norm + (size_t)l * D, hn);
        k_gemm<2><<<dim3(FF / 128, M / 128), 256, 0, stream>>>(hn, D, mlp_w1 + (size_t)l * D * FF, FF, proj, FF, D);
        k_gemm<1><<<dim3(D / 128, M / 128), 256, 0, stream>>>(proj, FF, mlp_w2 + (size_t)l * FF * D, D, h, D, FF);
    };
    for (int l = 0; l < 2; ++l) {
        k_rmsnorm<<<M / 4, 256, 0, stream>>>(h, a_norm + (size_t)l * D, hn);
        k_gemm<0><<<dim3(4 * D / 128, M / 128), 256, 0, stream>>>(hn, D, a_w_in + (size_t)l * D * 4 * D, 4 * D, proj, 4 * D, D);
        k_hgrn_elem<<<4096, 256, 0, stream>>>(proj, lbs + (size_t)l * D, Kbuf);
        k_gla<<<NB * H * 4, 64, 0, stream>>>(proj, Kbuf, O);
        k_headnorm_gate<<<(unsigned)((size_t)M * H / 4), 256, 0, stream>>>(O, proj, a_head_norm + (size_t)l * D, OG);
        k_gemm<1><<<dim3(D / 128, M / 128), 256, 0, stream>>>(OG, D, a_w_out + (size_t)l * D * D, D, h, D, D);
        mlp(l);
    }
    for (int l = 2; l < 4; ++l) {
        const int j = l - 2;
        if (l == 2) {
            k_rmsnorm<<<M / 4, 256, 0, stream>>>(h, kv_norm, hn);
            k_gemm<0><<<dim3(2 * D / 128, M / 128), 256, 0, stream>>>(hn, D, w_kv, 2 * D, KV, 2 * D, D);
            k_kvnorm<<<(unsigned)((size_t)M * H / 4), 256, 0, stream>>>(KV, k_norm, Kn);
            k_kmean<<<NB * H * NBLK, 128, 0, stream>>>(Kn, kmean);
        }
        k_rmsnorm<<<M / 4, 256, 0, stream>>>(h, b_norm + (size_t)j * D, hn);
        k_gemm<0><<<dim3(D / 128, M / 128), 256, 0, stream>>>(hn, D, b_w_q + (size_t)j * D * D, D, proj, D, D);
        k_moba<<<(unsigned)((size_t)M * H / 4), 256, 0, stream>>>(proj, b_q_norm + (size_t)j * DH, Kn, KV, kmean, O);
        k_gemm<1><<<dim3(D / 128, M / 128), 256, 0, stream>>>(O, D, b_w_o + (size_t)j * D * D, D, h, D, D);
        mlp(l);
    }
}
```

```cpp
#include <hip/hip_runtime.h>
#include <cstdio>
#include <cstdint>

namespace pg8 {
#define PG8_LAS __attribute__((address_space(3)))
typedef unsigned short bf16_t;
typedef short bf16x8 __attribute__((ext_vector_type(8)));
typedef float f32x4 __attribute__((ext_vector_type(4)));
typedef unsigned u32x4 __attribute__((ext_vector_type(4)));
constexpr int BM = 256, BK = 64, HALF = 128, HTB = HALF * BK * 2  , STAGE_BYTES = 8 * HTB, NXCD = 8, WGM = 8;

__host__ __device__ __forceinline__ int lds_byte(int r, int c) { const int st = (r >> 4) * 2 + (c >> 5), rr = r & 15, cc = c & 31, ob = rr * 64 + cc * 2; return st * 1024 + (ob ^ (((ob >> 9) & 1) << 5)); }
__host__ __device__ __forceinline__ void stage_rc(int b, int& R, int& C) { const int st = b / 1024, sb = b % 1024, swz = sb ^ (((sb >> 9) & 1) << 5); R = (st >> 1) * 16 + swz / 64; C = (st & 1) * 32 + (swz % 64) / 2; }
__host__ __device__ __forceinline__ int perm32(int rho) { const int n = rho >> 4, i = rho & 15; return 8 * (i >> 2) + 4 * n + (i & 3); }

struct Unit { int pm, pn; };
struct Gemm { const bf16_t* A; const bf16_t* Bt; int M, N, K; };

struct StaticOrder {
    int nM, nN, nwg, G, c;
    __host__ __device__ void init(int M, int N, int G_, int c_) { nM = M / BM; nN = N / BM; nwg = nM * nN; G = G_; c = c_; }
    __host__ __device__ bool next(int i, Unit& u) const {
        const long L = (long)i * G + c; if (L >= nwg) return false;
        int wgid = (int)L; { const int q = nwg / NXCD, r = nwg % NXCD, xcd = wgid % NXCD, off = wgid / NXCD; wgid = (xcd < r ? xcd * (q + 1) : r * (q + 1) + (xcd - r) * q) + off; }
        const int nig = WGM * nN, gid = wgid / nig, fm = gid * WGM, gsz = (nM - fm) < WGM ? (nM - fm) : WGM;
        u.pm = fm + ((wgid % nig) % gsz); u.pn = (wgid % nig) / gsz; return true;
    }
    __device__ __forceinline__ void a_ready(const Unit&) const {}
    __device__ __forceinline__ void done(const Unit&) const {}
};

__device__ __forceinline__ unsigned cvt_pk_bf16(float lo, float hi) { unsigned r; asm volatile("v_cvt_pk_bf16_f32 %0, %1, %2" : "=v"(r) : "v"(lo), "v"(hi)); return r; }
typedef float f32x2 __attribute__((ext_vector_type(2)));
struct EpiRes {
    static constexpr bool PERM = false, AFTER_DRAIN = false;
    float* Hh; int ldc;
    __device__ __forceinline__ void operator()(const f32x4 (&acc)[2][2][4][2], const Unit& u, int wr, int wc, int fr, int fq) const {
        const int row0 = u.pm * BM + wr * 64 + fr, col0 = u.pn * BM + wc * 32 + 4 * fq;
#pragma unroll
        for (int ai = 0; ai < 2; ++ai)
#pragma unroll
            for (int m = 0; m < 4; ++m) { float* rowp = Hh + (size_t)(row0 + ai * HALF + m * 16) * ldc + col0;
#pragma unroll
                for (int bj = 0; bj < 2; ++bj)
#pragma unroll
                    for (int n = 0; n < 2; ++n) { f32x4* p = (f32x4*)(rowp + bj * HALF + n * 16); *p = *p + acc[ai][bj][m][n]; } }
    }
};
struct EpiRelu2 {
    static constexpr bool PERM = true, AFTER_DRAIN = false;
    bf16_t* O; int ldc;
    __device__ __forceinline__ void operator()(const f32x4 (&acc)[2][2][4][2], const Unit& u, int wr, int wc, int fr, int fq) const {
        const int row0 = u.pm * BM + wr * 64 + fr, col0 = u.pn * BM + wc * 32 + 8 * fq;
#pragma unroll
        for (int ai = 0; ai < 2; ++ai)
#pragma unroll
            for (int m = 0; m < 4; ++m) { bf16_t* rowp = O + (size_t)(row0 + ai * HALF + m * 16) * ldc + col0;
#pragma unroll
                for (int bj = 0; bj < 2; ++bj) { f32x4 v0 = acc[ai][bj][m][0], v1 = acc[ai][bj][m][1];
#pragma unroll
                    for (int j = 0; j < 4; ++j) { const float a = fmaxf(v0[j], 0.f), b = fmaxf(v1[j], 0.f); v0[j] = a * a; v1[j] = b * b; }
                    u32x4 w; w.x = cvt_pk_bf16(v0[0], v0[1]); w.y = cvt_pk_bf16(v0[2], v0[3]); w.z = cvt_pk_bf16(v1[0], v1[1]); w.w = cvt_pk_bf16(v1[2], v1[3]);
                    *(u32x4*)(rowp + bj * HALF) = w; } }
    }
};
struct EpiSplit {
    static constexpr bool PERM = true, AFTER_DRAIN = false;
    bf16_t* O0; size_t gstride; int g0;
    __device__ __forceinline__ void operator()(const f32x4 (&acc)[2][2][4][2], const Unit& u, int wr, int wc, int fr, int fq) const {
        const int g = g0 + (u.pn >> 3); bf16_t* base = O0 + (size_t)g * gstride;
        const int row0 = u.pm * BM + wr * 64 + fr, col0 = (u.pn & 7) * BM + wc * 32 + 8 * fq;
#pragma unroll
        for (int ai = 0; ai < 2; ++ai)
#pragma unroll
            for (int m = 0; m < 4; ++m) { bf16_t* rowp = base + (size_t)(row0 + ai * HALF + m * 16) * 2048 + col0;
#pragma unroll
                for (int bj = 0; bj < 2; ++bj) { const f32x4 v0 = acc[ai][bj][m][0], v1 = acc[ai][bj][m][1];
                    u32x4 w; w.x = cvt_pk_bf16(v0[0], v0[1]); w.y = cvt_pk_bf16(v0[2], v0[3]); w.z = cvt_pk_bf16(v1[0], v1[1]); w.w = cvt_pk_bf16(v1[2], v1[3]);
                    *(u32x4*)(rowp + bj * HALF) = w; } }
    }
};
struct EpiHgrn {
    static constexpr bool PERM = true, AFTER_DRAIN = false;
    bf16_t* Qs; size_t qstride; float* Gs; const float* lb;
    __device__ __forceinline__ void operator()(const f32x4 (&acc)[2][2][4][2], const Unit& u, int wr, int wc, int fr, int fq) const {
        const int quarter = u.pn >> 3;
        const int row0 = u.pm * BM + wr * 64 + fr, col0 = (u.pn & 7) * BM + wc * 32 + 8 * fq;
        if (quarter == 1) {
            f32x4 lbv[2][2];
#pragma unroll
            for (int bj = 0; bj < 2; ++bj)
#pragma unroll
                for (int n = 0; n < 2; ++n) lbv[bj][n] = *(const f32x4*)(lb + col0 + bj * HALF + 4 * n);
#pragma unroll
            for (int ai = 0; ai < 2; ++ai)
#pragma unroll
                for (int m = 0; m < 4; ++m) { const size_t ro = (size_t)(row0 + ai * HALF + m * 16) * 2048 + col0;
#pragma unroll
                    for (int bj = 0; bj < 2; ++bj) { f32x4 lf[2], kk[2];
#pragma unroll
                        for (int n = 0; n < 2; ++n)
#pragma unroll
                            for (int j = 0; j < 4; ++j) { const float x = fmaxf(acc[ai][bj][m][n][j], -80.f), e = __expf(-x), r = __builtin_amdgcn_rcpf(1.f + e);
                                const float l0 = lbv[bj][n][j], om = 1.f - l0; lf[n][j] = __logf(fmaf(om, r, l0)); kk[n][j] = om * e * r; }
                        *(f32x4*)(Gs + ro + bj * HALF) = lf[0]; *(f32x4*)(Gs + ro + bj * HALF + 4) = lf[1];
                        u32x4 w; w.x = cvt_pk_bf16(kk[0][0], kk[0][1]); w.y = cvt_pk_bf16(kk[0][2], kk[0][3]); w.z = cvt_pk_bf16(kk[1][0], kk[1][1]); w.w = cvt_pk_bf16(kk[1][2], kk[1][3]);
                        *(u32x4*)(Qs + qstride + ro + bj * HALF) = w; } }
        } else {
            bf16_t* base = Qs + (size_t)quarter * qstride;
            const bool act = quarter != 2;
#pragma unroll
            for (int ai = 0; ai < 2; ++ai)
#pragma unroll
                for (int m = 0; m < 4; ++m) { bf16_t* rowp = base + (size_t)(row0 + ai * HALF + m * 16) * 2048 + col0;
#pragma unroll
                    for (int bj = 0; bj < 2; ++bj) { f32x4 v0 = acc[ai][bj][m][0], v1 = acc[ai][bj][m][1];
                        if (act) {
#pragma unroll
                            for (int j = 0; j < 4; ++j) { const float a = fmaxf(v0[j], -80.f), b = fmaxf(v1[j], -80.f);
                                v0[j] = a * __builtin_amdgcn_rcpf(1.f + __expf(-a)); v1[j] = b * __builtin_amdgcn_rcpf(1.f + __expf(-b)); } }
                        u32x4 w; w.x = cvt_pk_bf16(v0[0], v0[1]); w.y = cvt_pk_bf16(v0[2], v0[3]); w.z = cvt_pk_bf16(v1[0], v1[1]); w.w = cvt_pk_bf16(v1[2], v1[3]);
                        *(u32x4*)(rowp + bj * HALF) = w; } }
        }
    }
};


template <class Epi, class Sched, bool ALIGN_EPI = false, bool SP2 = false>
__device__ __forceinline__ void gemm_phase(PG8_LAS unsigned char* lds, const Gemm g, const Sched& S, const Epi& E) {
    int tid_ = threadIdx.x; asm volatile("" : "+v"(tid_));
    const int tid = tid_, wid = __builtin_amdgcn_readfirstlane(tid >> 6), lane = tid & 63, wr = wid >> 2, wc = wid & 3, fr = lane & 15, fq = lane >> 4;
    const int K = g.K, nt = K / BK;
    unsigned voffA[2], voffB[2];
#pragma unroll
    for (int i = 0; i < 2; ++i) { int R, C; stage_rc(tid * 16 + i * 8192, R, C); const int Rb = Epi::PERM ? ((R & ~31) + perm32(R & 31)) : R;
        voffA[i] = (unsigned)(R * K + C) * 2u; voffB[i] = (unsigned)(Rb * K + C) * 2u; }
    const size_t kstep = (size_t)(BK * 2);
    const size_t hstep = (size_t)HALF * K * 2;
    const size_t tstep = 2 * hstep;
    const unsigned ldsw = (unsigned)wid * 1024u;
    const int aoff = lds_byte(wr * 64 + fr, fq * 8), boff = lds_byte(wc * 32 + fr, fq * 8);
#define PG8_SA(b, h) (((b) * 2 + (h)) * HTB)
#define PG8_SB(b, h) ((4 + (b) * 2 + (h)) * HTB)
#define PG8_STAGE(bufoff, gbase, voff) do { _Pragma("unroll") for (int _i = 0; _i < 2; ++_i) \
        __builtin_amdgcn_global_load_lds((const unsigned*)((const char*)(gbase) + (voff)[_i]), (PG8_LAS unsigned*)(lds + (bufoff) + ldsw + _i * 8192), 16, 0, 0); } while (0)
#define PG8_LDA(dst, b, h) do { _Pragma("unroll") for (int m = 0; m < 4; ++m) _Pragma("unroll") for (int k = 0; k < 2; ++k) dst[m][k] = *(const PG8_LAS bf16x8*)(lds + PG8_SA(b, h) + aoff + m * 2048 + k * 1024); } while (0)
#define PG8_LDB(dst, b, h) do { _Pragma("unroll") for (int n = 0; n < 2; ++n) _Pragma("unroll") for (int k = 0; k < 2; ++k) dst[n][k] = *(const PG8_LAS bf16x8*)(lds + PG8_SB(b, h) + boff + n * 2048 + k * 1024); } while (0)
#define PG8_MMA(ai, bj, At, Bt) do { __builtin_amdgcn_s_setprio(1); _Pragma("unroll") for (int m = 0; m < 4; ++m) _Pragma("unroll") for (int n = 0; n < 2; ++n) _Pragma("unroll") for (int k = 0; k < 2; ++k) \
        acc[ai][bj][m][n] = __builtin_amdgcn_mfma_f32_16x16x32_bf16(Bt[n][k], At[m][k], acc[ai][bj][m][n], 0, 0, 0); __builtin_amdgcn_s_setprio(0); } while (0)
#define PG8_WAIT_V(n) asm volatile("s_waitcnt vmcnt(" #n ")" ::: "memory")
#define PG8_WAIT_L(n) asm volatile("s_waitcnt lgkmcnt(" #n ")" ::: "memory")
#define PG8_BAR __builtin_amdgcn_s_barrier()
#define PG8_SCHED __builtin_amdgcn_sched_barrier(0)
    Unit cur, nxt; int ui = 0;
    if (!S.next(0, cur)) return;
    f32x4 acc[2][2][4][2];
#pragma unroll
    for (int a = 0; a < 2; ++a)
#pragma unroll
        for (int b = 0; b < 2; ++b)
#pragma unroll
            for (int m = 0; m < 4; ++m)
#pragma unroll
                for (int n = 0; n < 2; ++n) acc[a][b][m][n] = (f32x4){0.f, 0.f, 0.f, 0.f};
    bf16x8 At[4][2], B0[2][2], B1[2][2];
    const char* cA = (const char*)g.A + (size_t)cur.pm * tstep; const char* cB = (const char*)g.Bt + (size_t)cur.pn * tstep;
    S.a_ready(cur);
    if constexpr (SP2) {
        PG8_STAGE(PG8_SB(0, 0), cB, voffB); PG8_STAGE(PG8_SB(0, 1), cB + hstep, voffB); PG8_STAGE(PG8_SA(0, 0), cA, voffA); PG8_STAGE(PG8_SA(0, 1), cA + hstep, voffA);
        if (wr == 1) PG8_BAR;
        PG8_WAIT_V(2); PG8_BAR;
        PG8_STAGE(PG8_SB(1, 0), cB + kstep, voffB); PG8_STAGE(PG8_SA(1, 0), cA + kstep, voffA); PG8_STAGE(PG8_SB(1, 1), cB + hstep + kstep, voffB);
        PG8_WAIT_V(6); PG8_BAR;
    } else {
        PG8_STAGE(PG8_SB(0, 0), cB, voffB); PG8_STAGE(PG8_SA(0, 0), cA, voffA); PG8_STAGE(PG8_SB(0, 1), cB + hstep, voffB); PG8_STAGE(PG8_SA(0, 1), cA + hstep, voffA);
        if (wr == 1) PG8_BAR;
        PG8_WAIT_V(4); PG8_BAR;
        PG8_STAGE(PG8_SB(1, 0), cB + kstep, voffB); PG8_STAGE(PG8_SA(1, 0), cA + kstep, voffA); PG8_STAGE(PG8_SB(1, 1), cB + hstep + kstep, voffB);
        PG8_WAIT_V(6); PG8_BAR;
    }
    for (;;) {
        const bool has_next = S.next(ui + 1, nxt);
        const char* nA = has_next ? (const char*)g.A + (size_t)nxt.pm * tstep : cA; const char* nB = has_next ? (const char*)g.Bt + (size_t)nxt.pn * tstep : cB;
        for (int t = 0; t < nt; t += 2) {
            const bool last = (t == nt - 2);
            const char* a1 = cA + (size_t)(t + 1) * kstep;
            const char* a2 = last ? nA : cA + (size_t)(t + 2) * kstep; const char* b2 = last ? nB : cB + (size_t)(t + 2) * kstep;
            const char* a3 = a2 + kstep; const char* b3 = b2 + kstep;
            if (last && has_next) S.a_ready(nxt);
            if constexpr (SP2) {
            PG8_LDB(B0, 0, 0); PG8_LDB(B1, 0, 1); PG8_SCHED; PG8_LDA(At, 0, 0); PG8_STAGE(PG8_SA(1, 1), a1 + hstep, voffA);
            PG8_WAIT_V(8); PG8_WAIT_L(0); PG8_BAR; PG8_MMA(0, 0, At, B0); PG8_MMA(0, 1, At, B1); PG8_BAR; PG8_SCHED;
            PG8_LDA(At, 0, 1); PG8_STAGE(PG8_SB(0, 0), b2, voffB); PG8_STAGE(PG8_SB(0, 1), b2 + hstep, voffB); PG8_STAGE(PG8_SA(0, 0), a2, voffA);
            PG8_WAIT_V(8); PG8_WAIT_L(0); PG8_BAR; PG8_MMA(1, 0, At, B0); PG8_MMA(1, 1, At, B1); PG8_BAR; PG8_SCHED;
            PG8_LDB(B0, 1, 0); PG8_LDB(B1, 1, 1); PG8_SCHED; PG8_LDA(At, 1, 0); PG8_STAGE(PG8_SA(0, 1), a2 + hstep, voffA);
            PG8_WAIT_V(8); PG8_WAIT_L(0); PG8_BAR; PG8_MMA(0, 0, At, B0); PG8_MMA(0, 1, At, B1); PG8_BAR; PG8_SCHED;
            PG8_LDA(At, 1, 1); PG8_STAGE(PG8_SB(1, 0), b3, voffB); PG8_STAGE(PG8_SB(1, 1), b3 + hstep, voffB); PG8_STAGE(PG8_SA(1, 0), a3, voffA);
            PG8_WAIT_V(8); PG8_WAIT_L(0); PG8_BAR; PG8_MMA(1, 0, At, B0); PG8_MMA(1, 1, At, B1); PG8_BAR; PG8_SCHED;
            } else {
            PG8_LDB(B0, 0, 0); PG8_SCHED; PG8_LDA(At, 0, 0); PG8_STAGE(PG8_SA(1, 1), a1 + hstep, voffA);
            PG8_WAIT_L(8); PG8_BAR; PG8_WAIT_L(0); PG8_MMA(0, 0, At, B0); PG8_BAR; PG8_SCHED;
            PG8_LDB(B1, 0, 1); PG8_STAGE(PG8_SB(0, 0), b2, voffB);
            PG8_BAR; PG8_WAIT_L(0); PG8_MMA(0, 1, At, B1); PG8_BAR;
            PG8_LDA(At, 0, 1); PG8_STAGE(PG8_SA(0, 0), a2, voffA);
            PG8_BAR; PG8_WAIT_L(0); PG8_MMA(1, 0, At, B0); PG8_BAR; PG8_SCHED;
            PG8_STAGE(PG8_SB(0, 1), b2 + hstep, voffB);
            PG8_WAIT_V(6); PG8_BAR; PG8_MMA(1, 1, At, B1); PG8_BAR;
            PG8_LDB(B0, 1, 0); PG8_SCHED; PG8_LDA(At, 1, 0); PG8_STAGE(PG8_SA(0, 1), a2 + hstep, voffA);
            PG8_WAIT_L(8); PG8_BAR; PG8_WAIT_L(0); PG8_MMA(0, 0, At, B0); PG8_BAR; PG8_SCHED;
            PG8_LDB(B1, 1, 1); PG8_STAGE(PG8_SB(1, 0), b3, voffB);
            PG8_BAR; PG8_WAIT_L(0); PG8_MMA(0, 1, At, B1); PG8_BAR;
            PG8_LDA(At, 1, 1); PG8_STAGE(PG8_SA(1, 0), a3, voffA);
            PG8_BAR; PG8_WAIT_L(0); PG8_MMA(1, 0, At, B0); PG8_BAR; PG8_SCHED;
            PG8_STAGE(PG8_SB(1, 1), b3 + hstep, voffB);
            PG8_WAIT_V(6); PG8_BAR; PG8_MMA(1, 1, At, B1); PG8_BAR;
            }
        }
        if constexpr (ALIGN_EPI) { if (wr == 0) PG8_BAR; }
        if constexpr (!Epi::AFTER_DRAIN) { E(acc, cur, wr, wc, fr, fq); S.done(cur); }
        if (!has_next) break;
#pragma unroll
        for (int a = 0; a < 2; ++a)
#pragma unroll
            for (int b = 0; b < 2; ++b)
#pragma unroll
                for (int m = 0; m < 4; ++m)
#pragma unroll
                    for (int n = 0; n < 2; ++n) acc[a][b][m][n] = (f32x4){0.f, 0.f, 0.f, 0.f};
        cur = nxt; cA = nA; cB = nB; ++ui;
        if constexpr (ALIGN_EPI) { if (wr == 1) PG8_BAR; }
    }
    PG8_WAIT_V(0);
    if constexpr (!ALIGN_EPI) { if (wr == 0) PG8_BAR; }
    PG8_BAR;
    if constexpr (Epi::AFTER_DRAIN) { E.fused(acc, cur, wr, wc, fr, fq, lds, wid, lane); S.done(cur); }
#undef PG8_SA
#undef PG8_SB
#undef PG8_STAGE
#undef PG8_LDA
#undef PG8_LDB
#undef PG8_MMA
#undef PG8_WAIT_V
#undef PG8_WAIT_L
#undef PG8_BAR
#undef PG8_SCHED
}
}

constexpr int D = 2048, NB = 4, S = 2048, M = NB * S, FF = 8192, H = 16, DH = 128, NBLK = 8, BLK = 256;
constexpr float EPS = 1e-6f;
constexpr int NWAVES = 8;
constexpr size_t MiB = 1u << 20;
constexpr size_t WS_CTL = 0, CTL_ZERO_BYTES = 1 * MiB;
constexpr size_t WS_WT = 1 * MiB;
constexpr size_t WE_WIN = 0, WE_WOUT = 33554432, WE_KVQ = 41943040, WE_Q1 = 54525952, WE_WO = 58720256, WE_W1 = 67108864, WE_W2 = 134217728, WE_END = 201326592;
constexpr size_t WS_XN = 385 * MiB, WS_QS = 417 * MiB, WS_KS = 449 * MiB, WS_VS = 481 * MiB, WS_GT = 513 * MiB, WS_GS = 545 * MiB, WS_OG = 609 * MiB, WS_U = 641 * MiB;
constexpr size_t WS_KRAW = 769 * MiB, WS_VV = 801 * MiB, WS_QRAW = 833 * MiB, WS_OF = 865 * MiB, WS_KN = 929 * MiB, WS_SMALL = 993 * MiB, WS_END = 994 * MiB;
constexpr size_t SM_LBS = 0, SM_KMEAN = 65536;
constexpr int CW_BAR = 4096;
constexpr int RING_OFF = 0, RING_BYTES = 131072;
constexpr int LDSCTL_OFF = RING_BYTES, MISC_OFF = LDSCTL_OFF + 320;
constexpr int LDS_BYTES = 147456;

#define GAS __attribute__((address_space(1)))
#define LAS __attribute__((address_space(3)))
typedef unsigned short bf16;
typedef unsigned v4u __attribute__((ext_vector_type(4)));
typedef unsigned v2u __attribute__((ext_vector_type(2)));
typedef float f32x4 __attribute__((ext_vector_type(4)));
typedef short bf16x8 __attribute__((ext_vector_type(8)));
typedef GAS unsigned gu32;
#define RLX_AGENT __ATOMIC_RELAXED, __HIP_MEMORY_SCOPE_AGENT
#define LDS_WAIT() asm volatile("s_waitcnt lgkmcnt(0)" ::: "memory")
#define VM_WAIT() asm volatile("s_waitcnt vmcnt(0)" ::: "memory")
__device__ __forceinline__ unsigned f2bf(float f) { unsigned u = __builtin_bit_cast(unsigned, f); return (u + 0x7fffu + ((u >> 16) & 1u)) >> 16; }
__device__ __forceinline__ unsigned pk2(float lo, float hi) { return f2bf(lo) | (f2bf(hi) << 16); }
__device__ __forceinline__ float bf2f(unsigned short b) { return __builtin_bit_cast(float, (unsigned)b << 16); }
__device__ __forceinline__ float bflo(unsigned w) { return __builtin_bit_cast(float, w << 16); }
__device__ __forceinline__ float bfhi(unsigned w) { return __builtin_bit_cast(float, w & 0xffff0000u); }
__device__ __forceinline__ float wave_sum(float v) {
#pragma unroll
    for (int o = 1; o < 64; o <<= 1) v += __shfl_xor(v, o);
    return v;
}
__device__ __forceinline__ float wave_max(float v) {
#pragma unroll
    for (int o = 1; o < 64; o <<= 1) v = fmaxf(v, __shfl_xor(v, o));
    return v;
}

static_assert(WS_VS - WS_KS == WS_KS - WS_QS && WS_GT - WS_VS == WS_KS - WS_QS && WS_QRAW - WS_VV == WS_VV - WS_KRAW, "strided tensor groups");
#define XB_TMO      128
#define XB_XCNT(j)  (256  + 64 * (j))
#define XB_XSUB(j)  (1280 + 64 * (j))
#define XB_XGEN(j)  (2304 + 64 * (j))
#define XB_TOP      3328
#define XB_TOPGEN   3392
#define XCD_BAR_WORDS 3456
#define XB_SPIN_CAP (1u << 18)

__device__ __forceinline__ unsigned xb_ld(unsigned* p)              { return __hip_atomic_load(p, __ATOMIC_RELAXED, __HIP_MEMORY_SCOPE_AGENT); }
__device__ __forceinline__ unsigned xb_add(unsigned* p, unsigned v) { return __hip_atomic_fetch_add(p, v, __ATOMIC_RELAXED, __HIP_MEMORY_SCOPE_AGENT); }
__device__ __forceinline__ unsigned xb_xcc_id() { return (unsigned)__builtin_amdgcn_s_getreg((3 << 11) | 20) & 0xFu; }
#define XB_SPIN(cond, bar) do { unsigned _sp = 0; while (cond) { __builtin_amdgcn_s_sleep(1); \
    if ((++_sp & 255u) == 0u) { if (xb_ld(&(bar)[XB_TMO])) break; if (_sp > XB_SPIN_CAP) { atomicAdd(&(bar)[XB_TMO], 1u); break; } } } } while (0)

struct XcdBarrier {
    unsigned* bar; unsigned x;
    volatile LAS unsigned* st;
};

__device__ __forceinline__ XcdBarrier xcd_barrier_post(unsigned* bar, volatile LAS unsigned* st) {
    XcdBarrier b; b.bar = bar; b.x = xb_xcc_id(); b.st = st;
    if (threadIdx.x == 0) (void)xb_add(&bar[XB_XCNT(b.x)], 1u);
    return b;
}
__device__ __forceinline__ void xcd_barrier_complete(unsigned* bar, unsigned x, unsigned& nloc, unsigned& nx) {
    const unsigned G = gridDim.x * gridDim.y * gridDim.z;
    unsigned sum, cnt, mine, sp = 0u;
    for (;;) {
        sum = 0u; cnt = 0u; mine = 0u;
#pragma unroll
        for (unsigned j = 0; j < 16; ++j) { const unsigned c = xb_ld(&bar[XB_XCNT(j)]); sum += c; cnt += (c > 0u) ? 1u : 0u; mine = (j == x) ? c : mine; }
        if (sum == G) break;
        __builtin_amdgcn_s_sleep(1);
        if ((++sp & 255u) == 0u) { if (xb_ld(&bar[XB_TMO])) break; if (sp > XB_SPIN_CAP) { atomicAdd(&bar[XB_TMO], 1u); break; } }
    }
    nloc = mine > 0u ? mine : 1u; nx = cnt > 0u ? cnt : 1u;
}

__device__ __forceinline__ void xcd_barrier(const XcdBarrier& b) {
    asm volatile("s_waitcnt vmcnt(0)" ::: "memory");
    __syncthreads();
    if (threadIdx.x == 0) {
        unsigned* bar = b.bar;
        __builtin_amdgcn_s_waitcnt(0);
        unsigned nloc = b.st[0], nx = b.st[1];
        if (nloc == 0u) { xcd_barrier_complete(bar, b.x, nloc, nx); b.st[0] = nloc; b.st[1] = nx; }
        const unsigned old = xb_add(&bar[XB_XSUB(b.x)], 1u);
        const unsigned gen = old / nloc;
        if (old + 1u == (gen + 1u) * nloc) {
            __builtin_amdgcn_fence(__ATOMIC_RELEASE, "agent");
            asm volatile("s_waitcnt vmcnt(0)" ::: "memory");
            const unsigned og = xb_add(&bar[XB_TOP], 1u);
            const unsigned tg = og / nx;
            if (og + 1u == (tg + 1u) * nx) xb_add(&bar[XB_TOPGEN], 1u);
            else XB_SPIN(xb_ld(&bar[XB_TOPGEN]) == tg, bar);
            __builtin_amdgcn_fence(__ATOMIC_ACQUIRE, "agent");
            xb_add(&bar[XB_XGEN(b.x)], 1u);
            asm volatile("s_waitcnt vmcnt(0)" ::: "memory");
        } else {
            XB_SPIN(xb_ld(&bar[XB_XGEN(b.x)]) == gen, bar);
            __builtin_amdgcn_fence(__ATOMIC_ACQUIRE, "agent");
            asm volatile("s_waitcnt vmcnt(0)" ::: "memory");
        }
    }
    __syncthreads();
}


struct Args { const float* in[16]; float* out; unsigned char* ws; int ph_lo, ph_hi, li, pad; };
enum InIdx { I_X = 0, I_ANORM, I_AWIN, I_AHEAD, I_AWOUT, I_LB, I_KVNORM, I_WKV, I_KNORM, I_BNORM, I_BWQ, I_BQNORM, I_BWO, I_MLPNORM, I_W1, I_W2 };

__device__ __forceinline__ void transpose_item(const float* W, const float* gain, int K, int N, bf16* WT, LAS float* scr, int item, int lane) {
    const int nblk = N / 32, kb = item / nblk, nb = item % nblk, k0 = 64 * kb, n0 = 32 * nb;
#pragma unroll 8
    for (int i = 0; i < 32; ++i) { const int kk = 2 * i + (lane >> 5); float w = W[(size_t)(k0 + kk) * N + n0 + (lane & 31)]; if (gain) w *= gain[k0 + kk]; scr[kk * 33 + (lane & 31)] = w; }
    LDS_WAIT(); asm volatile("" ::: "memory");
    const int c = lane & 7;
#pragma unroll
    for (int j = 0; j < 4; ++j) { const int n = (lane >> 3) + 8 * j; const LAS float* s = scr + (8 * c) * 33 + n;
        v4u o; o.x = pk2(s[0 * 33], s[1 * 33]); o.y = pk2(s[2 * 33], s[3 * 33]); o.z = pk2(s[4 * 33], s[5 * 33]); o.w = pk2(s[6 * 33], s[7 * 33]);
        *(GAS v4u*)(WT + (size_t)(n0 + n) * K + k0 + 8 * c) = o; }
    LDS_WAIT(); asm volatile("" ::: "memory");
}
struct MatDesc { const float* src; const float* gain; bf16* dst; int K, N, items; };
__device__ __forceinline__ MatDesc mat_desc(const Args& a, bf16* WT, int id) {
    MatDesc m;
    if (id < 2)       { m.src = a.in[I_AWIN] + (size_t)id * D * 4 * D; m.gain = a.in[I_ANORM] + id * D; m.dst = WT + WE_WIN + (size_t)id * D * 4 * D; m.K = D; m.N = 4 * D; }
    else if (id < 4)  { const int l = id - 2; m.src = a.in[I_AWOUT] + (size_t)l * D * D; m.gain = a.in[I_AHEAD] + l * D; m.dst = WT + WE_WOUT + (size_t)l * D * D; m.K = D; m.N = D; }
    else if (id == 4) { m.src = a.in[I_WKV]; m.gain = a.in[I_KVNORM]; m.dst = WT + WE_KVQ; m.K = D; m.N = 2 * D; }
    else if (id == 5) { m.src = a.in[I_BWQ]; m.gain = a.in[I_BNORM]; m.dst = WT + WE_KVQ + (size_t)2 * D * D; m.K = D; m.N = D; }
    else if (id == 6) { m.src = a.in[I_BWQ] + (size_t)D * D; m.gain = a.in[I_BNORM] + D; m.dst = WT + WE_Q1; m.K = D; m.N = D; }
    else if (id < 9)  { const int j = id - 7; m.src = a.in[I_BWO] + (size_t)j * D * D; m.gain = nullptr; m.dst = WT + WE_WO + (size_t)j * D * D; m.K = D; m.N = D; }
    else if (id < 13) { const int l = id - 9; m.src = a.in[I_W1] + (size_t)l * D * FF; m.gain = a.in[I_MLPNORM] + l * D; m.dst = WT + WE_W1 + (size_t)l * D * FF; m.K = D; m.N = FF; }
    else              { const int l = id - 13; m.src = a.in[I_W2] + (size_t)l * FF * D; m.gain = nullptr; m.dst = WT + WE_W2 + (size_t)l * FF * D; m.K = FF; m.N = D; }
    m.items = (m.K / 64) * (m.N / 32);
    return m;
}
__device__ __forceinline__ void norm_row(const float* hrow, bf16* xrow, float* hcopy, int lane) {
    const GAS f32x4* xr = (const GAS f32x4*)hrow + lane;
    f32x4 v[8]; float s = 0.f;
#pragma unroll
    for (int j = 0; j < 8; ++j) { v[j] = xr[64 * j]; s += (v[j].x * v[j].x + v[j].y * v[j].y) + (v[j].z * v[j].z + v[j].w * v[j].w); }
    const float r = rsqrtf(wave_sum(s) * (1.f / D) + EPS);
    GAS v2u* o8 = (GAS v2u*)xrow + lane;
#pragma unroll
    for (int j = 0; j < 8; ++j) { v2u w; w.x = pk2(v[j].x * r, v[j].y * r); w.y = pk2(v[j].z * r, v[j].w * r); o8[64 * j] = w; }
    if (hcopy) { GAS f32x4* hc = (GAS f32x4*)hcopy + lane;
#pragma unroll
        for (int j = 0; j < 8; ++j) hc[64 * j] = v[j]; }
}

__global__ void __launch_bounds__(NWAVES * 64, 2) fwd(Args args) {
    extern __shared__ __attribute__((aligned(16))) unsigned char lds_raw[];
    LAS unsigned char* lds = (LAS unsigned char*)lds_raw;
    volatile LAS unsigned* MISC = (volatile LAS unsigned*)(lds + MISC_OFF);
    const int tid = threadIdx.x, lane = tid & 63, wave = __builtin_amdgcn_readfirstlane(tid >> 6);
    const int G = gridDim.x;
    unsigned char* ws = args.ws;
    gu32* ctl = (gu32*)(ws + WS_CTL);
    for (int u = tid; u < (LDS_BYTES - LDSCTL_OFF) / 4; u += NWAVES * 64) ((LAS unsigned*)(lds + LDSCTL_OFF))[u] = 0u;
    __syncthreads();
    XcdBarrier bar = xcd_barrier_post((unsigned*)(ctl + CW_BAR) + args.li * XCD_BAR_WORDS, MISC + 8);

    bf16* WT = (bf16*)(ws + WS_WT);
    bf16* XN = (bf16*)(ws + WS_XN);
    bf16* QS = (bf16*)(ws + WS_QS); bf16* KS = (bf16*)(ws + WS_KS); bf16* VS = (bf16*)(ws + WS_VS); bf16* GT = (bf16*)(ws + WS_GT); float* GS = (float*)(ws + WS_GS);
    bf16* OG = (bf16*)(ws + WS_OG); bf16* U = (bf16*)(ws + WS_U);
    bf16* KRAW = (bf16*)(ws + WS_KRAW); bf16* VV = (bf16*)(ws + WS_VV); bf16* QRAW = (bf16*)(ws + WS_QRAW);
    float* LBS = (float*)(ws + WS_SMALL + SM_LBS);
    float* hres = args.out;
    const int lo = args.ph_lo, hi = args.ph_hi;
    const int gw = blockIdx.x * NWAVES + wave, NGW = G * NWAVES;
    bool any = false;
#define PHASE_BEGIN(p) if (lo <= (p) && (p) < hi) { if (any) xcd_barrier(bar); any = true;
#define PHASE_END() }

    PHASE_BEGIN(0)
        {
            const int d = blockIdx.x * (NWAVES * 64) + tid;
            if (d < D) { const float a = args.in[I_LB][d], b = args.in[I_LB][D + d], mx = fmaxf(a, b), ea = expf(a - mx), eb = expf(b - mx), sm = ea + eb, p0 = ea / sm, p1 = eb / sm;
                LBS[d] = 0.f; LBS[D + d] = (p0 + p1) - p0; }
        }
        for (int m = gw; m < M; m += NGW) norm_row(args.in[I_X] + (size_t)m * D, XN + (size_t)m * D, hres + (size_t)m * D, lane);
        {
            LAS float* scr = (LAS float*)(lds + RING_OFF + wave * 16384);
            int id = 0; MatDesc md = mat_desc(args, WT, 0); int base = 0;
            for (int it = gw; it < 98304; it += NGW) {
                while (it >= base + md.items) { base += md.items; ++id; md = mat_desc(args, WT, id); }
                transpose_item(md.src, md.gain, md.K, md.N, md.dst, scr, it - base, lane);
            }
        }
    PHASE_END()

    for (int l = 0; l < 4; ++l) {
        const int pb = 1 + 9 * l;
        if (l > 0) {
            PHASE_BEGIN(pb + 0)
                for (int m = gw; m < M; m += NGW) norm_row(hres + (size_t)m * D, XN + (size_t)m * D, nullptr, lane);
            PHASE_END()
        }
        if (l < 2) {
            PHASE_BEGIN(pb + 1)
                pg8::Gemm g{XN, WT + WE_WIN + (size_t)l * D * 4 * D, M, 4 * D, D}; pg8::StaticOrder So; So.init(M, 4 * D, G, (int)blockIdx.x);
                pg8::EpiHgrn E{QS, (size_t)(WS_KS - WS_QS) / 2, GS, LBS + l * D};
                pg8::gemm_phase<pg8::EpiHgrn, pg8::StaticOrder, true, true>(lds + RING_OFF, g, So, E);
            PHASE_END()
        } else {
            PHASE_BEGIN(pb + 1)
                const bool first = (l == 2);
                pg8::Gemm g{XN, first ? WT + WE_KVQ : WT + WE_Q1, M, first ? 3 * D : D, D}; pg8::StaticOrder So; So.init(M, first ? 3 * D : D, G, (int)blockIdx.x);
                pg8::EpiSplit E{KRAW, (size_t)(WS_VV - WS_KRAW) / 2, first ? 0 : 2};
                pg8::gemm_phase<pg8::EpiSplit, pg8::StaticOrder, true, true>(lds + RING_OFF, g, So, E);
            PHASE_END()
        }
        PHASE_BEGIN(pb + 5)
            pg8::Gemm g{OG, l < 2 ? WT + WE_WOUT + (size_t)l * D * D : WT + WE_WO + (size_t)(l - 2) * D * D, M, D, D}; pg8::StaticOrder So; So.init(M, D, G, (int)blockIdx.x);
            pg8::EpiRes E{hres, D};
            pg8::gemm_phase<pg8::EpiRes, pg8::StaticOrder, true, true>(lds + RING_OFF, g, So, E);
        PHASE_END()
        PHASE_BEGIN(pb + 6)
            for (int m = gw; m < M; m += NGW) norm_row(hres + (size_t)m * D, XN + (size_t)m * D, nullptr, lane);
        PHASE_END()
        PHASE_BEGIN(pb + 7)
            pg8::Gemm g{XN, WT + WE_W1 + (size_t)l * D * FF, M, FF, D}; pg8::StaticOrder So; So.init(M, FF, G, (int)blockIdx.x);
            pg8::EpiRelu2 E{U, FF};
            pg8::gemm_phase<pg8::EpiRelu2, pg8::StaticOrder, true, true>(lds + RING_OFF, g, So, E);
        PHASE_END()
        PHASE_BEGIN(pb + 8)
            pg8::Gemm g{U, WT + WE_W2 + (size_t)l * FF * D, M, D, FF}; pg8::StaticOrder So; So.init(M, D, G, (int)blockIdx.x);
            pg8::EpiRes E{hres, D};
            pg8::gemm_phase<pg8::EpiRes, pg8::StaticOrder, true, true>(lds + RING_OFF, g, So, E);
        PHASE_END()
    }
#undef PHASE_BEGIN
#undef PHASE_END
}


__global__ __launch_bounds__(64) void k_gla(const bf16* QS, const bf16* KS, const bf16* VS, const float* GS, float* O) {
    const int bh = blockIdx.x >> 2, es = blockIdx.x & 3, b = bh / H, h = bh % H;
    const int lane = threadIdx.x, e = lane & 31, dh = lane >> 5;
    __shared__ float sq[16][128], sf[16][128], sk[16][128], sv[16][32];
    float St[64];
#pragma unroll
    for (int i = 0; i < 64; ++i) St[i] = 0.f;
    for (int t0 = 0; t0 < S; t0 += 16) {
        for (int i = lane; i < 16 * 128; i += 64) {
            const int tt = i >> 7, d = i & 127; const size_t o = ((size_t)b * S + t0 + tt) * D + h * DH + d;
            sq[tt][d] = bf2f(QS[o]); sf[tt][d] = expf(GS[o]); sk[tt][d] = bf2f(KS[o]);
        }
        for (int i = lane; i < 16 * 32; i += 64) {
            const int tt = i >> 5, ee = i & 31;
            sv[tt][ee] = bf2f(VS[((size_t)b * S + t0 + tt) * D + h * DH + es * 32 + ee]);
        }
        __syncthreads();
        for (int tt = 0; tt < 16; ++tt) {
            const float v = sv[tt][e]; float o = 0.f;
#pragma unroll
            for (int i = 0; i < 64; ++i) { const int d = dh * 64 + i; St[i] = fmaf(sf[tt][d], St[i], sk[tt][d] * v); o = fmaf(St[i], sq[tt][d], o); }
            o += __shfl_xor(o, 32);
            if (dh == 0) O[((size_t)b * S + t0 + tt) * D + h * DH + es * 32 + e] = o;
        }
        __syncthreads();
    }
}
__global__ __launch_bounds__(256) void k_headnorm_gate(const float* O, const bf16* GT, bf16* OG) {
    const size_t gw = (size_t)blockIdx.x * 4 + (threadIdx.x >> 6); const int lane = threadIdx.x & 63;
    const size_t row = gw / H; const int h = (int)(gw % H);
    const size_t off = row * D + h * DH + lane * 2;
    const float2 v = *(const float2*)(O + off);
    const float s = wave_sum(v.x * v.x + v.y * v.y), r = rsqrtf(s * (1.0f / DH) + EPS);
    const unsigned g = *(const unsigned*)(GT + off);
    *(unsigned*)(OG + off) = pk2(v.x * r * bflo(g), v.y * r * bfhi(g));
}
__global__ __launch_bounds__(256) void k_kvnorm(const bf16* KRAW, const float* k_norm, float* Kn) {
    const size_t gw = (size_t)blockIdx.x * 4 + (threadIdx.x >> 6); const int lane = threadIdx.x & 63;
    const size_t row = gw / H; const int h = (int)(gw % H);
    const size_t off = row * D + h * DH + lane * 2;
    const unsigned kw = *(const unsigned*)(KRAW + off);
    const float vx = bflo(kw), vy = bfhi(kw);
    const float s = wave_sum(vx * vx + vy * vy), r = rsqrtf(s * (1.0f / DH) + EPS);
    const float2 gn = *(const float2*)(k_norm + lane * 2);
    float2 o; o.x = vx * r * gn.x; o.y = vy * r * gn.y;
    *(float2*)(Kn + off) = o;
}
__global__ __launch_bounds__(128) void k_kmean(const float* Kn, float* kmean) {
    const int n = blockIdx.x % NBLK, h = (blockIdx.x / NBLK) % H, b = blockIdx.x / (NBLK * H), d = threadIdx.x;
    float s = 0.f;
    for (int j = 0; j < BLK; ++j) s += Kn[((size_t)b * S + n * BLK + j) * D + h * DH + d];
    kmean[(size_t)blockIdx.x * DH + d] = s * (1.0f / BLK);
}
__global__ __launch_bounds__(256) void k_moba(const bf16* QRAW, const float* q_norm, const float* Kn, const bf16* VV, const float* kmean, bf16* O) {
    __shared__ float sqv[4][DH];
    const int w = threadIdx.x >> 6, lane = threadIdx.x & 63;
    const size_t gw = (size_t)blockIdx.x * 4 + w;
    const size_t row = gw / H; const int h = (int)(gw % H);
    const int b = (int)(row / S), t = (int)(row % S), qb = t >> 8;
    float2 qv;
    {
        const unsigned qw = *(const unsigned*)(QRAW + row * D + h * DH + lane * 2);
        qv.x = bflo(qw); qv.y = bfhi(qw);
        const float s = wave_sum(qv.x * qv.x + qv.y * qv.y), r = rsqrtf(s * (1.0f / DH) + EPS);
        const float2 gn = *(const float2*)(q_norm + lane * 2);
        qv.x *= r * gn.x; qv.y *= r * gn.y;
    }
    sqv[w][lane * 2] = qv.x; sqv[w][lane * 2 + 1] = qv.y;
    float gate[NBLK];
#pragma unroll
    for (int n = 0; n < NBLK; ++n) {
        const float2 km = *(const float2*)(kmean + ((size_t)(b * H + h) * NBLK + n) * DH + lane * 2);
        const float dd = wave_sum(qv.x * km.x + qv.y * km.y);
        gate[n] = (n < qb) ? dd : -1e30f;
    }
    unsigned selmask = 0u;
    if (qb <= 3) selmask = (1u << qb) - 1u;
    else {
#pragma unroll
        for (int it = 0; it < 3; ++it) {
            float best = -3e38f; int bi = 0;
#pragma unroll
            for (int n = 0; n < NBLK; ++n) { const bool ok = (n < qb) && !((selmask >> n) & 1u); if (ok && gate[n] > best) { best = gate[n]; bi = n; } }
            selmask |= 1u << bi;
        }
    }
    selmask |= 1u << qb;
    __syncthreads();
    const float scale = 0.08838834764831845f;
    const float slope = exp2f(-8.0f * (float)(h + 1) / (float)H);
    float m = -1e30f, l = 0.f, o0 = 0.f, o1 = 0.f;
    for (int n = 0; n <= qb; ++n) {
        if (!((selmask >> n) & 1u)) continue;
        for (int c = 0; c < BLK; c += 64) {
            const int kpos = n * BLK + c + lane;
            if (n * BLK + c > t) break;
            const float* kr = Kn + ((size_t)b * S + kpos) * D + h * DH;
            float dot = 0.f;
#pragma unroll 8
            for (int d4 = 0; d4 < DH / 4; ++d4) {
                const float4 kk = *(const float4*)(kr + d4 * 4); const float4 qq = *(const float4*)(&sqv[w][d4 * 4]);
                dot += kk.x * qq.x + kk.y * qq.y + kk.z * qq.z + kk.w * qq.w;
            }
            const bool valid = kpos <= t;
            const float logit = dot * scale - slope * (float)(t - kpos);
            const float cm = wave_max(valid ? logit : -1e30f);
            const float mn = fmaxf(m, cm);
            const float p = valid ? expf(logit - mn) : 0.f;
            const float alpha = expf(m - mn);
            l = l * alpha + wave_sum(p); o0 *= alpha; o1 *= alpha; m = mn;
            for (int j = 0; j < 64; ++j) {
                const float pj = __shfl(p, j);
                const unsigned vw = *(const unsigned*)(VV + ((size_t)b * S + n * BLK + c + j) * D + h * DH + lane * 2);
                o0 = fmaf(pj, bflo(vw), o0); o1 = fmaf(pj, bfhi(vw), o1);
            }
        }
    }
    *(unsigned*)(O + row * D + h * DH + lane * 2) = pk2(o0 / l, o1 / l);
}

extern "C" void kernel_launch(void* const* d_in, const int* in_sizes, int n_in, void* d_out, int out_size, void* d_ws, size_t ws_size, hipStream_t stream) {
    static int grid = 0;
    if (grid == 0) {
        if (n_in != 16 || out_size != M * D || ws_size < WS_END) { fprintf(stderr, "kernel_launch: unexpected sizes (n_in %d, out %d, ws %zu < %zu); nothing launched\n", n_in, out_size, ws_size, (size_t)WS_END); grid = -1; return; }
        int dev = 0, cus = 0, per_cu = 0;
        if (hipGetDevice(&dev) != hipSuccess || hipDeviceGetAttribute(&cus, hipDeviceAttributeMultiprocessorCount, dev) != hipSuccess) { grid = -1; return; }
        if (hipFuncSetAttribute((const void*)fwd, hipFuncAttributeMaxDynamicSharedMemorySize, LDS_BYTES) != hipSuccess) { fprintf(stderr, "kernel_launch: hipFuncSetAttribute failed\n"); grid = -1; return; }
        if (hipOccupancyMaxActiveBlocksPerMultiprocessor(&per_cu, (const void*)fwd, NWAVES * 64, LDS_BYTES) != hipSuccess || per_cu < 1) { fprintf(stderr, "kernel_launch: occupancy query says %d blocks per CU\n", per_cu); }
        (void)hipGetLastError();
        grid = cus;
    }
    if (grid < 0) return;
    if (hipMemsetAsync((char*)d_ws + WS_CTL, 0, CTL_ZERO_BYTES, stream) != hipSuccess) return;
    Args a{};
    for (int i = 0; i < 16; ++i) a.in[i] = (const float*)d_in[i];
    a.out = (float*)d_out; a.ws = (unsigned char*)d_ws;
    unsigned char* ws = (unsigned char*)d_ws;
    const bf16* QS = (const bf16*)(ws + WS_QS); const bf16* KS = (const bf16*)(ws + WS_KS); const bf16* VS = (const bf16*)(ws + WS_VS); const bf16* GT = (const bf16*)(ws + WS_GT);
    const float* GS = (const float*)(ws + WS_GS); bf16* OG = (bf16*)(ws + WS_OG);
    const bf16* KRAW = (const bf16*)(ws + WS_KRAW); const bf16* VV = (const bf16*)(ws + WS_VV); const bf16* QRAW = (const bf16*)(ws + WS_QRAW);
    float* OF = (float*)(ws + WS_OF); float* KN = (float*)(ws + WS_KN); float* KMEAN = (float*)(ws + WS_SMALL + SM_KMEAN);
    int li = 0;
    auto run = [&](int lo, int hi) { a.ph_lo = lo; a.ph_hi = hi; a.li = li++; hipLaunchKernelGGL(fwd, dim3(grid), dim3(NWAVES * 64), LDS_BYTES, stream, a); };
    run(0, 1);
    for (int l = 0; l < 4; ++l) {
        const int pb = 1 + 9 * l;
        run(pb, pb + 2);
        if (l < 2) {
            k_gla<<<NB * H * 4, 64, 0, stream>>>(QS, KS, VS, GS, OF);
            k_headnorm_gate<<<(unsigned)((size_t)M * H / 4), 256, 0, stream>>>(OF, GT, OG);
        } else {
            if (l == 2) {
                k_kvnorm<<<(unsigned)((size_t)M * H / 4), 256, 0, stream>>>(KRAW, (const float*)d_in[I_KNORM], KN);
                k_kmean<<<NB * H * NBLK, 128, 0, stream>>>(KN, KMEAN);
            }
            k_moba<<<(unsigned)((size_t)M * H / 4), 256, 0, stream>>>(QRAW, (const float*)d_in[I_BQNORM] + (size_t)(l - 2) * DH, KN, VV, KMEAN, OG);
        }
        run(pb + 5, pb + 9);
    }
}
```

```cpp
#include <hip/hip_runtime.h>
#include <cstdio>
#include <cstdint>

template <int K> __device__ __forceinline__ float swz_xor(float v) { return __builtin_bit_cast(float, __builtin_amdgcn_ds_swizzle(__builtin_bit_cast(int, v), (K << 10) | 0x1f)); }
__device__ __forceinline__ float half_sum(float v) { auto rr = __builtin_amdgcn_permlane32_swap(__float_as_uint(v), __float_as_uint(v), false, false); const unsigned r0 = rr[0], r1 = rr[1]; return __uint_as_float(r0) + __uint_as_float(r1); }
__device__ __forceinline__ float sum16(float v) { v += swz_xor<1>(v); v += swz_xor<2>(v); v += swz_xor<4>(v); v += swz_xor<8>(v); return v; }
__device__ __forceinline__ float wave_sum(float v) { v = sum16(v); v += swz_xor<16>(v); return half_sum(v); }

namespace pg8 {
#define PG8_LAS __attribute__((address_space(3)))
typedef unsigned short bf16_t;
typedef short bf16x8 __attribute__((ext_vector_type(8)));
typedef float f32x4 __attribute__((ext_vector_type(4)));
typedef unsigned u32x4 __attribute__((ext_vector_type(4)));
constexpr int BM = 256, BK = 64, HALF = 128, HTB = HALF * BK * 2  , STAGE_BYTES = 8 * HTB, NXCD = 8, WGM = 8;

__host__ __device__ __forceinline__ int lds_byte(int r, int c) { const int st = (r >> 4) * 2 + (c >> 5), rr = r & 15, cc = c & 31, ob = rr * 64 + cc * 2; return st * 1024 + (ob ^ (((ob >> 9) & 1) << 5)); }
__host__ __device__ __forceinline__ void stage_rc(int b, int& R, int& C) { const int st = b / 1024, sb = b % 1024, swz = sb ^ (((sb >> 9) & 1) << 5); R = (st >> 1) * 16 + swz / 64; C = (st & 1) * 32 + (swz % 64) / 2; }
__host__ __device__ __forceinline__ int perm32(int rho) { const int n = rho >> 4, i = rho & 15; return 8 * (i >> 2) + 4 * n + (i & 3); }

struct Unit { int pm, pn, ord; };
struct Gemm { const bf16_t* A; const bf16_t* Bt; int M, N, K, lda, ldb; size_t ksa, ksb, tsa, tsb; };
__host__ __device__ inline Gemm gemm_rowmajor(const bf16_t* A, const bf16_t* Bt, int M, int N, int K) { return Gemm{A, Bt, M, N, K, K, K, 128, 128, (size_t)256 * K * 2, (size_t)256 * K * 2}; }

struct StaticOrder {
    int nM, nN, nwg, G, c;
    __host__ __device__ void init(int M, int N, int G_, int c_) { nM = M / BM; nN = N / BM; nwg = nM * nN; G = G_; c = c_; }
    __host__ __device__ bool next(int i, Unit& u) const {
        const long L = (long)i * G + c; if (L >= nwg) return false;
        int wgid = (int)L; { const int q = nwg / NXCD, r = nwg % NXCD, xcd = wgid % NXCD, off = wgid / NXCD; wgid = (xcd < r ? xcd * (q + 1) : r * (q + 1) + (xcd - r) * q) + off; }
        const int nig = WGM * nN, gid = wgid / nig, fm = gid * WGM, gsz = (nM - fm) < WGM ? (nM - fm) : WGM;
        u.pm = fm + ((wgid % nig) % gsz); u.pn = (wgid % nig) / gsz; u.ord = i; return true;
    }
    __device__ __forceinline__ void a_ready(const Unit&) const {}
    __device__ __forceinline__ void done(const Unit&) const {}
};

__device__ __forceinline__ unsigned cvt_pk_bf16(float lo, float hi) { unsigned r; asm("v_cvt_pk_bf16_f32 %0, %1, %2" : "=v"(r) : "v"(lo), "v"(hi)); return r; }
typedef float f32x2 __attribute__((ext_vector_type(2)));
template <class Sched> __device__ __forceinline__ void row_scale_table(const float* PS, PG8_LAS float* RS, const Sched& So, int tid) {
#pragma unroll
    for (int pass = 0; pass < 4; ++pass) { Unit uu; const int i = 2 * pass + (tid >> 8);
        if (So.next(i, uu)) { const f32x4* p = (const f32x4*)(PS + (size_t)(uu.pm * BM + (tid & 255)) * 32); f32x4 a = p[0];
#pragma unroll
            for (int k = 1; k < 8; ++k) a = a + p[k];
            RS[i * 256 + (tid & 255)] = rsqrtf(((a[0] + a[1]) + (a[2] + a[3])) * (1.0f / 2048.0f) + 1e-6f); } }
    asm volatile("s_waitcnt vmcnt(0) lgkmcnt(0)" ::: "memory"); __builtin_amdgcn_s_barrier(); asm volatile("" ::: "memory");
}
template <bool LAST>
struct EpiRes {
    static constexpr bool PERM = true, AFTER_DRAIN = false;
    bf16_t* HB; float* PS; float* Fout; int ldc;
    __device__ __forceinline__ void operator()(const f32x4 (&acc)[2][2][4][2], const Unit& u, int wr, int wc, int fr, int fq) const {
        const int row0 = u.pm * BM + wr * 64 + fr, col0 = u.pn * BM + wc * 64 + 8 * fq;
        u32x4 hv[2][4][2];
#pragma unroll
        for (int ai = 0; ai < 2; ++ai)
#pragma unroll
            for (int m = 0; m < 4; ++m)
#pragma unroll
                for (int bj = 0; bj < 2; ++bj) hv[ai][m][bj] = *(const u32x4*)(HB + (size_t)(row0 + ai * HALF + m * 16) * ldc + col0 + bj * 32);
#pragma unroll
        for (int ai = 0; ai < 2; ++ai)
#pragma unroll
            for (int m = 0; m < 4; ++m) { const int row = row0 + ai * HALF + m * 16; float ss = 0.f;
#pragma unroll
                for (int bj = 0; bj < 2; ++bj) { const u32x4 r = hv[ai][m][bj]; const size_t off = (size_t)row * ldc + col0 + bj * 32;
                    const f32x4 h0 = (f32x4){__builtin_bit_cast(float, r.x << 16), __builtin_bit_cast(float, r.x & 0xffff0000u), __builtin_bit_cast(float, r.y << 16), __builtin_bit_cast(float, r.y & 0xffff0000u)} + acc[ai][bj][m][0];
                    const f32x4 h1 = (f32x4){__builtin_bit_cast(float, r.z << 16), __builtin_bit_cast(float, r.z & 0xffff0000u), __builtin_bit_cast(float, r.w << 16), __builtin_bit_cast(float, r.w & 0xffff0000u)} + acc[ai][bj][m][1];
                    if constexpr (LAST) { *(f32x4*)(Fout + off) = h0; *(f32x4*)(Fout + off + 4) = h1; }
                    else { ss += ((h0[0] * h0[0] + h0[1] * h0[1]) + (h0[2] * h0[2] + h0[3] * h0[3])) + ((h1[0] * h1[0] + h1[1] * h1[1]) + (h1[2] * h1[2] + h1[3] * h1[3]));
                        u32x4 w; w.x = cvt_pk_bf16(h0[0], h0[1]); w.y = cvt_pk_bf16(h0[2], h0[3]); w.z = cvt_pk_bf16(h1[0], h1[1]); w.w = cvt_pk_bf16(h1[2], h1[3]);
                        *(u32x4*)(HB + off) = w; } }
                if constexpr (!LAST) { ss += swz_xor<16>(ss); ss = half_sum(ss);
                    if (fq == 0) PS[(size_t)row * 32 + u.pn * 4 + wc] = ss; } }
    }
};
struct EpiRelu2 {
    static constexpr bool PERM = true, AFTER_DRAIN = false;
    bf16_t* O; int ncols; PG8_LAS float* RS;
    __device__ __forceinline__ void operator()(const f32x4 (&acc)[2][2][4][2], const Unit& u, int wr, int wc, int fr, int fq) const {
        bf16_t* tile = O + ((size_t)(u.pm * (ncols / 64) + u.pn * 4 + wc) * 256 + wr * 64 + fr) * 64 + 8 * fq;
#pragma unroll
        for (int ai = 0; ai < 2; ++ai)
#pragma unroll
            for (int m = 0; m < 4; ++m) { bf16_t* rowp = tile + (ai * HALF + m * 16) * 64; const float rs = RS[u.ord * 256 + ai * HALF + wr * 64 + m * 16 + fr], rs2 = rs * rs;
#pragma unroll
                for (int bj = 0; bj < 2; ++bj) { f32x4 v0 = acc[ai][bj][m][0], v1 = acc[ai][bj][m][1];
#pragma unroll
                    for (int j = 0; j < 4; ++j) { const float a = __builtin_amdgcn_fmed3f(v0[j], 0.f, 3.0e38f), b = __builtin_amdgcn_fmed3f(v1[j], 0.f, 3.0e38f); v0[j] = (a * a) * rs2; v1[j] = (b * b) * rs2; }
                    u32x4 w; w.x = cvt_pk_bf16(v0[0], v0[1]); w.y = cvt_pk_bf16(v0[2], v0[3]); w.z = cvt_pk_bf16(v1[0], v1[1]); w.w = cvt_pk_bf16(v1[2], v1[3]);
                    *(u32x4*)(rowp + bj * 32) = w; } }
    }
};
struct EpiSplit {
    static constexpr bool PERM = true, AFTER_DRAIN = false;
    bf16_t* O0; size_t gstride; int g0; PG8_LAS float* RS;
    __device__ __forceinline__ void operator()(const f32x4 (&acc)[2][2][4][2], const Unit& u, int wr, int wc, int fr, int fq) const {
        const int g = g0 + (u.pn >> 3); bf16_t* base = O0 + (size_t)g * gstride;
        const int row0 = u.pm * BM + wr * 64 + fr, col0 = (u.pn & 7) * BM + wc * 64 + 8 * fq;
#pragma unroll
        for (int ai = 0; ai < 2; ++ai)
#pragma unroll
            for (int m = 0; m < 4; ++m) { bf16_t* rowp = base + (size_t)(row0 + ai * HALF + m * 16) * 2048 + col0; const float rs = RS[u.ord * 256 + ai * HALF + wr * 64 + m * 16 + fr];
#pragma unroll
                for (int bj = 0; bj < 2; ++bj) { const f32x4 v0 = acc[ai][bj][m][0] * rs, v1 = acc[ai][bj][m][1] * rs;
                    u32x4 w; w.x = cvt_pk_bf16(v0[0], v0[1]); w.y = cvt_pk_bf16(v0[2], v0[3]); w.z = cvt_pk_bf16(v1[0], v1[1]); w.w = cvt_pk_bf16(v1[2], v1[3]);
                    *(u32x4*)(rowp + bj * 32) = w; } }
    }
};
struct EpiHgrn {
    static constexpr bool PERM = true, AFTER_DRAIN = false;
    bf16_t* Qs; size_t qstride; float* Gs; const float* lb; PG8_LAS float* RS;
    __device__ __forceinline__ void operator()(const f32x4 (&acc)[2][2][4][2], const Unit& u, int wr, int wc, int fr, int fq) const {
        const int quarter = u.pn >> 3;
        const int row0 = u.pm * BM + wr * 64 + fr, col0 = (u.pn & 7) * BM + wc * 64 + 8 * fq;
        if (quarter == 1) {
            f32x4 lbv[2][2];
#pragma unroll
            for (int bj = 0; bj < 2; ++bj)
#pragma unroll
                for (int n = 0; n < 2; ++n) lbv[bj][n] = *(const f32x4*)(lb + col0 + bj * 32 + 4 * n);
#pragma unroll
            for (int ai = 0; ai < 2; ++ai)
#pragma unroll
                for (int m = 0; m < 4; ++m) { const size_t ro = (size_t)(row0 + ai * HALF + m * 16) * 2048 + col0; const float rs = RS[u.ord * 256 + ai * HALF + wr * 64 + m * 16 + fr];
#pragma unroll
                    for (int bj = 0; bj < 2; ++bj) { f32x4 lf[2], kk[2];
#pragma unroll
                        for (int n = 0; n < 2; ++n)
#pragma unroll
                            for (int j = 0; j < 4; ++j) { const float x = fmaxf(acc[ai][bj][m][n][j] * rs, -80.f), e = __expf(-x), r = __builtin_amdgcn_rcpf(1.f + e);
                                const float l0 = lbv[bj][n][j], om = 1.f - l0; lf[n][j] = __log2f(fmaf(om, r, l0)); kk[n][j] = om * e * r; }
                        *(f32x4*)(Gs + ro + bj * 32) = lf[0]; *(f32x4*)(Gs + ro + bj * 32 + 4) = lf[1];
                        u32x4 w; w.x = cvt_pk_bf16(kk[0][0], kk[0][1]); w.y = cvt_pk_bf16(kk[0][2], kk[0][3]); w.z = cvt_pk_bf16(kk[1][0], kk[1][1]); w.w = cvt_pk_bf16(kk[1][2], kk[1][3]);
                        *(u32x4*)(Qs + qstride + ro + bj * 32) = w; } }
        } else {
            bf16_t* base = Qs + (size_t)quarter * qstride;
            const bool act = quarter != 2;
#pragma unroll
            for (int ai = 0; ai < 2; ++ai)
#pragma unroll
                for (int m = 0; m < 4; ++m) { bf16_t* rowp = base + (size_t)(row0 + ai * HALF + m * 16) * 2048 + col0; const float rs = RS[u.ord * 256 + ai * HALF + wr * 64 + m * 16 + fr];
#pragma unroll
                    for (int bj = 0; bj < 2; ++bj) { f32x4 v0 = acc[ai][bj][m][0] * rs, v1 = acc[ai][bj][m][1] * rs;
                        if (act) {
#pragma unroll
                            for (int j = 0; j < 4; ++j) { const float a = fmaxf(v0[j], -80.f), b = fmaxf(v1[j], -80.f);
                                v0[j] = a * __builtin_amdgcn_rcpf(1.f + __expf(-a)); v1[j] = b * __builtin_amdgcn_rcpf(1.f + __expf(-b)); } }
                        u32x4 w; w.x = cvt_pk_bf16(v0[0], v0[1]); w.y = cvt_pk_bf16(v0[2], v0[3]); w.z = cvt_pk_bf16(v1[0], v1[1]); w.w = cvt_pk_bf16(v1[2], v1[3]);
                        *(u32x4*)(rowp + bj * 32) = w; } }
        }
    }
};


template <class Epi, class Sched, bool ALIGN_EPI = false, bool SP2 = false>
__device__ __forceinline__ void gemm_phase(PG8_LAS unsigned char* lds, const Gemm g, const Sched& S, const Epi& E) {
    int tid_ = threadIdx.x; asm volatile("" : "+v"(tid_));
    const int tid = tid_, wid = __builtin_amdgcn_readfirstlane(tid >> 6), lane = tid & 63, wr = wid >> 2, wc = wid & 3, fr = lane & 15, fq = lane >> 4;
    const int K = g.K, nt = K / BK;
    unsigned voffA[2], voffB[2];
#pragma unroll
    for (int i = 0; i < 2; ++i) { int R, C; stage_rc(tid * 16 + i * 8192, R, C); const int Rb = Epi::PERM ? (2 * (R & ~31) + perm32(R & 31)) : R;
        voffA[i] = (unsigned)(R * g.lda + C) * 2u; voffB[i] = (unsigned)(Rb * g.ldb + C) * 2u; }
    const size_t kstepA = g.ksa, kstepB = g.ksb;
    const size_t hstepA = (size_t)HALF * g.lda * 2, hstepB = (size_t)(Epi::PERM ? 32 : HALF) * g.ldb * 2;
    const size_t tstepA = g.tsa, tstepB = g.tsb;
    const unsigned ldsw = (unsigned)wid * 1024u;
    const int aoff = lds_byte(wr * 64 + fr, fq * 8), boff = lds_byte(wc * 32 + fr, fq * 8);
#define PG8_SA(b, h) (((b) * 2 + (h)) * HTB)
#define PG8_SB(b, h) ((4 + (b) * 2 + (h)) * HTB)
#define PG8_STAGE(bufoff, gbase, voff) do { _Pragma("unroll") for (int _i = 0; _i < 2; ++_i) \
        __builtin_amdgcn_global_load_lds((const unsigned*)((const char*)(gbase) + (voff)[_i]), (PG8_LAS unsigned*)(lds + (bufoff) + ldsw + _i * 8192), 16, 0, 0); } while (0)
#define PG8_LDA(dst, b, h) do { _Pragma("unroll") for (int m = 0; m < 4; ++m) _Pragma("unroll") for (int k = 0; k < 2; ++k) dst[m][k] = *(const PG8_LAS bf16x8*)(lds + PG8_SA(b, h) + aoff + m * 2048 + k * 1024); } while (0)
#define PG8_LDB(dst, b, h) do { _Pragma("unroll") for (int n = 0; n < 2; ++n) _Pragma("unroll") for (int k = 0; k < 2; ++k) dst[n][k] = *(const PG8_LAS bf16x8*)(lds + PG8_SB(b, h) + boff + n * 2048 + k * 1024); } while (0)
#define PG8_MMA(ai, bj, At, Bt) do { __builtin_amdgcn_s_setprio(1); _Pragma("unroll") for (int m = 0; m < 4; ++m) _Pragma("unroll") for (int n = 0; n < 2; ++n) _Pragma("unroll") for (int k = 0; k < 2; ++k) \
        acc[ai][bj][m][n] = __builtin_amdgcn_mfma_f32_16x16x32_bf16(Bt[n][k], At[m][k], acc[ai][bj][m][n], 0, 0, 0); __builtin_amdgcn_s_setprio(0); } while (0)
#define PG8_WAIT_V(n) asm volatile("s_waitcnt vmcnt(" #n ")" ::: "memory")
#define PG8_WAIT_L(n) asm volatile("s_waitcnt lgkmcnt(" #n ")" ::: "memory")
#define PG8_BAR __builtin_amdgcn_s_barrier()
#define PG8_SCHED __builtin_amdgcn_sched_barrier(0)
    Unit cur, nxt; int ui = 0;
    if (!S.next(0, cur)) return;
    f32x4 acc[2][2][4][2];
#pragma unroll
    for (int a = 0; a < 2; ++a)
#pragma unroll
        for (int b = 0; b < 2; ++b)
#pragma unroll
            for (int m = 0; m < 4; ++m)
#pragma unroll
                for (int n = 0; n < 2; ++n) acc[a][b][m][n] = (f32x4){0.f, 0.f, 0.f, 0.f};
    bf16x8 At[4][2], B0[2][2], B1[2][2];
    const char* cA = (const char*)g.A + (size_t)cur.pm * tstepA; const char* cB = (const char*)g.Bt + (size_t)cur.pn * tstepB;
    S.a_ready(cur);
    if constexpr (SP2) {
        PG8_STAGE(PG8_SB(0, 0), cB, voffB); PG8_STAGE(PG8_SB(0, 1), cB + hstepB, voffB); PG8_STAGE(PG8_SA(0, 0), cA, voffA); PG8_STAGE(PG8_SA(0, 1), cA + hstepA, voffA);
        if (wr == 1) PG8_BAR;
        PG8_WAIT_V(2); PG8_BAR;
        PG8_STAGE(PG8_SB(1, 0), cB + kstepB, voffB); PG8_STAGE(PG8_SA(1, 0), cA + kstepA, voffA); PG8_STAGE(PG8_SB(1, 1), cB + hstepB + kstepB, voffB);
        PG8_WAIT_V(6); PG8_BAR;
    } else {
        PG8_STAGE(PG8_SB(0, 0), cB, voffB); PG8_STAGE(PG8_SA(0, 0), cA, voffA); PG8_STAGE(PG8_SB(0, 1), cB + hstepB, voffB); PG8_STAGE(PG8_SA(0, 1), cA + hstepA, voffA);
        if (wr == 1) PG8_BAR;
        PG8_WAIT_V(4); PG8_BAR;
        PG8_STAGE(PG8_SB(1, 0), cB + kstepB, voffB); PG8_STAGE(PG8_SA(1, 0), cA + kstepA, voffA); PG8_STAGE(PG8_SB(1, 1), cB + hstepB + kstepB, voffB);
        PG8_WAIT_V(6); PG8_BAR;
    }
    for (;;) {
        const bool has_next = S.next(ui + 1, nxt);
        const char* nA = has_next ? (const char*)g.A + (size_t)nxt.pm * tstepA : cA; const char* nB = has_next ? (const char*)g.Bt + (size_t)nxt.pn * tstepB : cB;
        for (int t = 0; t < nt; t += 2) {
            const bool last = (t == nt - 2);
            const char* a1 = cA + (size_t)(t + 1) * kstepA;
            const char* a2 = last ? nA : cA + (size_t)(t + 2) * kstepA; const char* b2 = last ? nB : cB + (size_t)(t + 2) * kstepB;
            const char* a3 = a2 + kstepA; const char* b3 = b2 + kstepB;
            if (last && has_next) S.a_ready(nxt);
            if constexpr (SP2) {
            PG8_LDB(B0, 0, 0); PG8_LDB(B1, 0, 1); PG8_SCHED; PG8_LDA(At, 0, 0); PG8_STAGE(PG8_SA(1, 1), a1 + hstepA, voffA);
            PG8_WAIT_V(8); PG8_WAIT_L(0); PG8_BAR; PG8_MMA(0, 0, At, B0); PG8_MMA(0, 1, At, B1); PG8_BAR; PG8_SCHED;
            PG8_LDA(At, 0, 1); PG8_STAGE(PG8_SB(0, 0), b2, voffB); PG8_STAGE(PG8_SB(0, 1), b2 + hstepB, voffB); PG8_STAGE(PG8_SA(0, 0), a2, voffA);
            PG8_WAIT_V(8); PG8_WAIT_L(0); PG8_BAR; PG8_MMA(1, 0, At, B0); PG8_MMA(1, 1, At, B1); PG8_BAR; PG8_SCHED;
            PG8_LDB(B0, 1, 0); PG8_LDB(B1, 1, 1); PG8_SCHED; PG8_LDA(At, 1, 0); PG8_STAGE(PG8_SA(0, 1), a2 + hstepA, voffA);
            PG8_WAIT_V(8); PG8_WAIT_L(0); PG8_BAR; PG8_MMA(0, 0, At, B0); PG8_MMA(0, 1, At, B1); PG8_BAR; PG8_SCHED;
            PG8_LDA(At, 1, 1); PG8_STAGE(PG8_SB(1, 0), b3, voffB); PG8_STAGE(PG8_SB(1, 1), b3 + hstepB, voffB); PG8_STAGE(PG8_SA(1, 0), a3, voffA);
            PG8_WAIT_V(8); PG8_WAIT_L(0); PG8_BAR; PG8_MMA(1, 0, At, B0); PG8_MMA(1, 1, At, B1); PG8_BAR; PG8_SCHED;
            } else {
            PG8_LDB(B0, 0, 0); PG8_SCHED; PG8_LDA(At, 0, 0); PG8_STAGE(PG8_SA(1, 1), a1 + hstepA, voffA);
            PG8_WAIT_L(8); PG8_BAR; PG8_WAIT_L(0); PG8_MMA(0, 0, At, B0); PG8_BAR; PG8_SCHED;
            PG8_LDB(B1, 0, 1); PG8_STAGE(PG8_SB(0, 0), b2, voffB);
            PG8_BAR; PG8_WAIT_L(0); PG8_MMA(0, 1, At, B1); PG8_BAR;
            PG8_LDA(At, 0, 1); PG8_STAGE(PG8_SA(0, 0), a2, voffA);
            PG8_BAR; PG8_WAIT_L(0); PG8_MMA(1, 0, At, B0); PG8_BAR; PG8_SCHED;
            PG8_STAGE(PG8_SB(0, 1), b2 + hstepB, voffB);
            PG8_WAIT_V(6); PG8_BAR; PG8_MMA(1, 1, At, B1); PG8_BAR;
            PG8_LDB(B0, 1, 0); PG8_SCHED; PG8_LDA(At, 1, 0); PG8_STAGE(PG8_SA(0, 1), a2 + hstepA, voffA);
            PG8_WAIT_L(8); PG8_BAR; PG8_WAIT_L(0); PG8_MMA(0, 0, At, B0); PG8_BAR; PG8_SCHED;
            PG8_LDB(B1, 1, 1); PG8_STAGE(PG8_SB(1, 0), b3, voffB);
            PG8_BAR; PG8_WAIT_L(0); PG8_MMA(0, 1, At, B1); PG8_BAR;
            PG8_LDA(At, 1, 1); PG8_STAGE(PG8_SA(1, 0), a3, voffA);
            PG8_BAR; PG8_WAIT_L(0); PG8_MMA(1, 0, At, B0); PG8_BAR; PG8_SCHED;
            PG8_STAGE(PG8_SB(1, 1), b3 + hstepB, voffB);
            PG8_WAIT_V(6); PG8_BAR; PG8_MMA(1, 1, At, B1); PG8_BAR;
            }
        }
        if constexpr (ALIGN_EPI) { if (wr == 0) PG8_BAR; }
        if constexpr (!Epi::AFTER_DRAIN) { E(acc, cur, wr, wc, fr, fq); S.done(cur); }
        if (!has_next) break;
#pragma unroll
        for (int a = 0; a < 2; ++a)
#pragma unroll
            for (int b = 0; b < 2; ++b)
#pragma unroll
                for (int m = 0; m < 4; ++m)
#pragma unroll
                    for (int n = 0; n < 2; ++n) acc[a][b][m][n] = (f32x4){0.f, 0.f, 0.f, 0.f};
        cur = nxt; cA = nA; cB = nB; ++ui;
        if constexpr (ALIGN_EPI) { if (wr == 1) PG8_BAR; }
    }
    PG8_WAIT_V(0);
    if constexpr (!ALIGN_EPI) { if (wr == 0) PG8_BAR; }
    PG8_BAR;
    if constexpr (Epi::AFTER_DRAIN) { E.fused(acc, cur, wr, wc, fr, fq, lds, wid, lane); S.done(cur); }
#undef PG8_SA
#undef PG8_SB
#undef PG8_STAGE
#undef PG8_LDA
#undef PG8_LDB
#undef PG8_MMA
#undef PG8_WAIT_V
#undef PG8_WAIT_L
#undef PG8_BAR
#undef PG8_SCHED
}
}

constexpr int D = 2048, NB = 4, S = 2048, M = NB * S, FF = 8192, H = 16, DH = 128, NBLK = 8, BLK = 256;
constexpr float EPS = 1e-6f;
constexpr int NWAVES = 8;
constexpr size_t MiB = 1u << 20;
constexpr size_t WS_CTL = 0, CTL_ZERO_BYTES = 32768;
constexpr size_t WS_WT = 1 * MiB;
constexpr size_t WE_WIN = 0, WE_WOUT = 33554432, WE_KVQ = 41943040, WE_Q1 = 54525952, WE_WO = 58720256, WE_W1 = 67108864, WE_W2 = 134217728, WE_END = 201326592;
constexpr size_t WS_XN = 385 * MiB, WS_QS = 417 * MiB, WS_KS = 449 * MiB, WS_VS = 481 * MiB, WS_GT = 513 * MiB, WS_GS = 545 * MiB, WS_OG = 609 * MiB, WS_U = 641 * MiB;
constexpr size_t WS_KRAW = 769 * MiB, WS_VV = 801 * MiB, WS_QRAW = 833 * MiB, WS_OF = 865 * MiB, WS_KN = 929 * MiB, WS_SMALL = 993 * MiB, WS_END = 994 * MiB;
constexpr size_t SM_LBS = 0, SM_KNORM = 16384, SM_QNORM = 16384 + 512, SM_KMEAN = 65536;
static_assert((4096 + 3456) * 4 <= 32768, "barrier words inside the memset");
constexpr int CW_BAR = 4096;
constexpr int RING_OFF = 0, RING_BYTES = 131072;
constexpr int LDSCTL_OFF = RING_BYTES, MISC_OFF = LDSCTL_OFF + 320;
constexpr int LDS_BYTES = 147456;

#define GAS __attribute__((address_space(1)))
#define LAS __attribute__((address_space(3)))
typedef unsigned short bf16;
typedef unsigned v4u __attribute__((ext_vector_type(4)));
typedef unsigned v2u __attribute__((ext_vector_type(2)));
typedef float f32x2 __attribute__((ext_vector_type(2)));
typedef float f32x4 __attribute__((ext_vector_type(4)));
typedef short bf16x8 __attribute__((ext_vector_type(8)));
typedef GAS unsigned gu32;
#define RLX_AGENT __ATOMIC_RELAXED, __HIP_MEMORY_SCOPE_AGENT
#define LDS_WAIT() asm volatile("s_waitcnt lgkmcnt(0)" ::: "memory")
#define VM_WAIT() asm volatile("s_waitcnt vmcnt(0)" ::: "memory")
__device__ __forceinline__ unsigned f2bf(float f) { unsigned u = __builtin_bit_cast(unsigned, f); return (u + 0x7fffu + ((u >> 16) & 1u)) >> 16; }
__device__ __forceinline__ unsigned pk2(float lo, float hi) { return f2bf(lo) | (f2bf(hi) << 16); }
__device__ __forceinline__ float bf2f(unsigned short b) { return __builtin_bit_cast(float, (unsigned)b << 16); }
__device__ __forceinline__ float bflo(unsigned w) { return __builtin_bit_cast(float, w << 16); }
__device__ __forceinline__ float bfhi(unsigned w) { return __builtin_bit_cast(float, w & 0xffff0000u); }
static_assert(WS_VS - WS_KS == WS_KS - WS_QS && WS_GT - WS_VS == WS_KS - WS_QS && WS_QRAW - WS_VV == WS_VV - WS_KRAW, "strided tensor groups");
#define XB_TMO      128
#define XB_XCNT(j)  (256  + 64 * (j))
#define XB_XSUB(j)  (1280 + 64 * (j))
#define XB_XGEN(j)  (2304 + 64 * (j))
#define XB_TOP      3328
#define XB_TOPGEN   3392
#define XCD_BAR_WORDS 3456
#define XB_SPIN_CAP (1u << 18)

__device__ __forceinline__ unsigned xb_ld(unsigned* p)              { return __hip_atomic_load(p, __ATOMIC_RELAXED, __HIP_MEMORY_SCOPE_AGENT); }
__device__ __forceinline__ unsigned xb_add(unsigned* p, unsigned v) { return __hip_atomic_fetch_add(p, v, __ATOMIC_RELAXED, __HIP_MEMORY_SCOPE_AGENT); }
__device__ __forceinline__ unsigned xb_xcc_id() { return (unsigned)__builtin_amdgcn_s_getreg((3 << 11) | 20) & 0xFu; }
#define XB_SPIN(cond, bar) do { unsigned _sp = 0; while (cond) { __builtin_amdgcn_s_sleep(1); \
    if ((++_sp & 255u) == 0u) { if (xb_ld(&(bar)[XB_TMO])) break; if (_sp > XB_SPIN_CAP) { atomicAdd(&(bar)[XB_TMO], 1u); break; } } } } while (0)

struct XcdBarrier {
    unsigned* bar; unsigned x;
    volatile LAS unsigned* st;
};

__device__ __forceinline__ XcdBarrier xcd_barrier_post(unsigned* bar, volatile LAS unsigned* st) {
    XcdBarrier b; b.bar = bar; b.x = xb_xcc_id(); b.st = st;
    if (threadIdx.x == 0) (void)xb_add(&bar[XB_XCNT(b.x)], 1u);
    return b;
}
__device__ __forceinline__ void xcd_barrier_complete(unsigned* bar, unsigned x, unsigned& nloc, unsigned& nx) {
    const unsigned G = gridDim.x * gridDim.y * gridDim.z;
    unsigned sum, cnt, mine, sp = 0u;
    for (;;) {
        sum = 0u; cnt = 0u; mine = 0u;
#pragma unroll
        for (unsigned j = 0; j < 16; ++j) { const unsigned c = xb_ld(&bar[XB_XCNT(j)]); sum += c; cnt += (c > 0u) ? 1u : 0u; mine = (j == x) ? c : mine; }
        if (sum == G) break;
        __builtin_amdgcn_s_sleep(1);
        if ((++sp & 255u) == 0u) { if (xb_ld(&bar[XB_TMO])) break; if (sp > XB_SPIN_CAP) { atomicAdd(&bar[XB_TMO], 1u); break; } }
    }
    nloc = mine > 0u ? mine : 1u; nx = cnt > 0u ? cnt : 1u;
}

__device__ __forceinline__ void xcd_barrier(const XcdBarrier& b) {
    asm volatile("s_waitcnt vmcnt(0)" ::: "memory");
    __syncthreads();
    if (threadIdx.x == 0) {
        unsigned* bar = b.bar;
        __builtin_amdgcn_s_waitcnt(0);
        unsigned nloc = b.st[0], nx = b.st[1];
        if (nloc == 0u) { xcd_barrier_complete(bar, b.x, nloc, nx); b.st[0] = nloc; b.st[1] = nx; }
        const unsigned old = xb_add(&bar[XB_XSUB(b.x)], 1u);
        const unsigned gen = old / nloc;
        if (old + 1u == (gen + 1u) * nloc) {
            __builtin_amdgcn_fence(__ATOMIC_RELEASE, "agent");
            asm volatile("s_waitcnt vmcnt(0)" ::: "memory");
            const unsigned og = xb_add(&bar[XB_TOP], 1u);
            const unsigned tg = og / nx;
            if (og + 1u == (tg + 1u) * nx) xb_add(&bar[XB_TOPGEN], 1u);
            else XB_SPIN(xb_ld(&bar[XB_TOPGEN]) == tg, bar);
            __builtin_amdgcn_fence(__ATOMIC_ACQUIRE, "agent");
            xb_add(&bar[XB_XGEN(b.x)], 1u);
            asm volatile("s_waitcnt vmcnt(0)" ::: "memory");
        } else {
            XB_SPIN(xb_ld(&bar[XB_XGEN(b.x)]) == gen, bar);
            __builtin_amdgcn_fence(__ATOMIC_ACQUIRE, "agent");
            asm volatile("s_waitcnt vmcnt(0)" ::: "memory");
        }
    }
    __syncthreads();
}


struct Args { const float* in[16]; float* out; unsigned char* ws; int ph_lo, ph_hi, li, pad; };
enum InIdx { I_X = 0, I_ANORM, I_AWIN, I_AHEAD, I_AWOUT, I_LB, I_KVNORM, I_WKV, I_KNORM, I_BNORM, I_BWQ, I_BQNORM, I_BWO, I_MLPNORM, I_W1, I_W2 };
__device__ __forceinline__ const float* in_ptr(int i) {
    const __attribute__((address_space(4))) unsigned char* ka = (const __attribute__((address_space(4))) unsigned char*)__builtin_amdgcn_kernarg_segment_ptr();
    int off = i * 8; asm volatile("" : "+s"(off));
    const float* p = *(const float* const __attribute__((address_space(4)))*)(ka + off);
    return (const float*)(const GAS float*)p;
}

__device__ __forceinline__ void transpose_item(const float* W, const float* gain, int K, int N, bf16* WT, LAS float* scr, int item, int lane, int tiled) {
    const int nblk = N / 32, kb = item / nblk, nb = item % nblk, k0 = 64 * kb, n0 = 32 * nb;
    const int ks = lane >> 3, n4 = (lane & 7) * 4, c = lane & 7;
    f32x4 v[8];
#pragma unroll
    for (int i = 0; i < 8; ++i) v[i] = *(const GAS f32x4*)(W + (size_t)(k0 + ks + 8 * i) * N + n0 + n4);
    f32x4 g0 = (f32x4){1.f, 1.f, 1.f, 1.f}, g1 = g0;
    if (gain) { g0 = *(const GAS f32x4*)(gain + k0 + 8 * c); g1 = *(const GAS f32x4*)(gain + k0 + 8 * c + 4); }
#pragma unroll
    for (int i = 0; i < 8; ++i) { LAS float* d = scr + (ks + 8 * i) * 33 + n4; d[0] = v[i].x; d[1] = v[i].y; d[2] = v[i].z; d[3] = v[i].w; }
    LDS_WAIT(); asm volatile("" ::: "memory");
#pragma unroll
    for (int j = 0; j < 4; ++j) { const int n = (lane >> 3) + 8 * j; const LAS float* s = scr + (8 * c) * 33 + n;
        v4u o; o.x = pk2(s[0 * 33] * g0.x, s[1 * 33] * g0.y); o.y = pk2(s[2 * 33] * g0.z, s[3 * 33] * g0.w); o.z = pk2(s[4 * 33] * g1.x, s[5 * 33] * g1.y); o.w = pk2(s[6 * 33] * g1.z, s[7 * 33] * g1.w);
        bf16* dst = tiled ? WT + (((size_t)((n0 + n) >> 8) * (K / 64) + kb) * 256 + ((n0 + n) & 255)) * 64 + 8 * c
                          : WT + (size_t)(n0 + n) * K + k0 + 8 * c;
        *(GAS v4u*)dst = o; }
    LDS_WAIT(); asm volatile("" ::: "memory");
}
struct MatDesc { const float* src; const float* gain; bf16* dst; int K, N, items, tiled; };
__device__ __forceinline__ MatDesc mat_desc(bf16* WT, int id) {
    MatDesc m; int kind, l;
    if (id < 4)        { kind = id; l = 0; }
    else if (id < 8)   { kind = id - 4; l = 1; }
    else if (id == 8)  { kind = 4; l = 0; }
    else if (id == 9)  { kind = 5; l = 0; }
    else if (id == 10) { kind = 6; l = 0; }
    else if (id == 11) { kind = 2; l = 2; }
    else if (id == 12) { kind = 3; l = 2; }
    else if (id == 13) { kind = 5; l = 1; }
    else if (id == 14) { kind = 6; l = 1; }
    else if (id == 15) { kind = 2; l = 3; }
    else               { kind = 3; l = 3; }
    if (kind == 0)      { m.src = in_ptr(I_AWIN) + (size_t)l * D * 4 * D; m.gain = in_ptr(I_ANORM) + l * D; m.dst = WT + WE_WIN + (size_t)l * D * 4 * D; m.K = D; m.N = 4 * D; }
    else if (kind == 1) { m.src = in_ptr(I_AWOUT) + (size_t)l * D * D; m.gain = in_ptr(I_AHEAD) + l * D; m.dst = WT + WE_WOUT + (size_t)l * D * D; m.K = D; m.N = D; }
    else if (kind == 2) { m.src = in_ptr(I_W1) + (size_t)l * D * FF; m.gain = in_ptr(I_MLPNORM) + l * D; m.dst = WT + WE_W1 + (size_t)l * D * FF; m.K = D; m.N = FF; }
    else if (kind == 3) { m.src = in_ptr(I_W2) + (size_t)l * FF * D; m.gain = nullptr; m.dst = WT + WE_W2 + (size_t)l * FF * D; m.K = FF; m.N = D; }
    else if (kind == 4) { m.src = in_ptr(I_WKV); m.gain = in_ptr(I_KVNORM); m.dst = WT + WE_KVQ; m.K = D; m.N = 2 * D; }
    else if (kind == 5) { m.src = in_ptr(I_BWQ) + (size_t)l * D * D; m.gain = in_ptr(I_BNORM) + l * D; m.dst = l == 0 ? WT + WE_KVQ + (size_t)2 * D * D : WT + WE_Q1; m.K = D; m.N = D; }
    else                { m.src = in_ptr(I_BWO) + (size_t)l * D * D; m.gain = nullptr; m.dst = WT + WE_WO + (size_t)l * D * D; m.K = D; m.N = D; }
    m.items = (m.K / 64) * (m.N / 32); m.tiled = (kind == 3) ? 1 : 0;
    return m;
}
__device__ __forceinline__ void convert_weights(bf16* WT, int id_lo, int id_hi, int wv, int nwv, LAS float* scr, int lane) {
    int id = id_lo; MatDesc md = mat_desc(WT, id); int base = 0;
    for (int it = wv; ; it += nwv) {
        while (it >= base + md.items) { base += md.items; ++id; if (id >= id_hi) return; md = mat_desc(WT, id); }
        transpose_item(md.src, md.gain, md.K, md.N, md.dst, scr, it - base, lane, md.tiled);
    }
}
__device__ __forceinline__ void intake_row(const float* xrow, bf16* hbrow, float* psrow, int lane) {
    const GAS f32x4* xr = (const GAS f32x4*)xrow + lane;
    f32x4 v[8]; float s = 0.f;
#pragma unroll
    for (int j = 0; j < 8; ++j) { v[j] = xr[64 * j]; s += (v[j].x * v[j].x + v[j].y * v[j].y) + (v[j].z * v[j].z + v[j].w * v[j].w); }
    s = wave_sum(s);
    GAS v2u* o8 = (GAS v2u*)hbrow + lane;
#pragma unroll
    for (int j = 0; j < 8; ++j) { v2u w; w.x = pk2(v[j].x, v[j].y); w.y = pk2(v[j].z, v[j].w); o8[64 * j] = w; }
    if (lane < 32) psrow[lane] = (lane == 0) ? s : 0.f;
}

constexpr int GC = 64, NCH = S / GC;
constexpr int GQ_PT = 0, GQ_SS = 4096, GQ_QT = 5120, GQ_KT = GQ_QT + 64 * 272, GQ_VT = GQ_KT + 64 * 272, GQ_AM = GQ_VT + 128 * 144, GQ_SX = 67584, GQ_KDT = GQ_SX + 128 * 272;
static_assert(GQ_AM + 64 * 144 <= GQ_SX && GQ_KDT + 128 * 144 <= RING_BYTES, "GLA LDS map");
__device__ __forceinline__ bf16x8 lds_frag(LAS const unsigned char* base, int stride_bytes, int row0, int k0, int lane) {
    return *(const LAS bf16x8*)(base + (row0 + (lane & 15)) * stride_bytes + (k0 + 8 * (lane >> 4)) * 2);
}
__device__ __forceinline__ unsigned cvtpk_bf16(float lo, float hi) { unsigned r; asm("v_cvt_pk_bf16_f32 %0, %1, %2" : "=v"(r) : "v"(lo), "v"(hi)); return r; }
__device__ __forceinline__ void gla_seq(int bh, const bf16* QS, const bf16* KS, const bf16* VS, const float* GS, const bf16* GT, bf16* OG, LAS unsigned char* L, int tid) {
    const int b = bh >> 4, h = bh & 15;
    const int lane = tid & 63, w = __builtin_amdgcn_readfirstlane(tid >> 6);
    const int tt = w >> 1, sh = w & 1, g4 = 4 * (lane >> 4), l15 = lane & 15;
    LAS float* PT = (LAS float*)(L + GQ_PT); LAS float* SS = (LAS float*)(L + GQ_SS);
    const size_t ebase = (size_t)b * S * D + h * DH;
    const __amdgpu_buffer_rsrc_t rq = __builtin_amdgcn_make_buffer_rsrc((void*)(QS + ebase), 0, S * D * 2, 0x00020000), rk = __builtin_amdgcn_make_buffer_rsrc((void*)(KS + ebase), 0, S * D * 2, 0x00020000);
    const __amdgpu_buffer_rsrc_t rv = __builtin_amdgcn_make_buffer_rsrc((void*)(VS + ebase), 0, S * D * 2, 0x00020000), rg = __builtin_amdgcn_make_buffer_rsrc((void*)(GS + ebase), 0, S * D * 4, 0x00020000);
    const __amdgpu_buffer_rsrc_t rt = __builtin_amdgcn_make_buffer_rsrc((void*)(GT + ebase), 0, S * D * 2, 0x00020000), ro = __builtin_amdgcn_make_buffer_rsrc((void*)(OG + ebase), 0, S * D * 2, 0x00020000);
    const unsigned vo2 = (unsigned)((w * 8) * D + 2 * lane) * 2u, vo4 = vo2 * 2u;
    const unsigned vog = (unsigned)(g4 * D + l15) * 2u;
    f32x4 st[8];
#pragma unroll
    for (int j = 0; j < 8; ++j) st[j] = (f32x4){0.f, 0.f, 0.f, 0.f};
    f32x2 cs[8]; unsigned qq[8], kk[8], vv[8];
#define GLA_LOAD(c) do { const int so_ = (c) * GC * D * 2; f32x2 run_ = (f32x2){0.f, 0.f}; \
        _Pragma("unroll") for (int i = 0; i < 8; ++i) { const v2u g_ = __builtin_amdgcn_raw_buffer_load_b64(rg, vo4, 2 * (so_ + i * D * 2), 0); run_ += (f32x2){__uint_as_float(g_.x), __uint_as_float(g_.y)}; cs[i] = run_; \
            qq[i] = __builtin_amdgcn_raw_buffer_load_b32(rq, vo2, so_ + i * D * 2, 0); kk[i] = __builtin_amdgcn_raw_buffer_load_b32(rk, vo2, so_ + i * D * 2, 0); } \
        _Pragma("unroll") for (int i = 0; i < 8; ++i) vv[i] = __builtin_amdgcn_raw_buffer_load_b32(rv, vo2, so_ + i * D * 2, 0); } while (0)
#define GLA_BAR() do { asm volatile("s_waitcnt lgkmcnt(0)" ::: "memory"); __builtin_amdgcn_s_barrier(); asm volatile("" ::: "memory"); } while (0)
    GLA_LOAD(0);
    for (int c = 0; c < NCH; ++c) {
        *(LAS f32x2*)(PT + w * 128 + 2 * lane) = cs[7];
        GLA_BAR();
        {
            f32x2 offs = (f32x2){0.f, 0.f}, bref = offs, tot = offs;
#pragma unroll
            for (int p = 0; p < 8; ++p) { const f32x2 x = *(const LAS f32x2*)(PT + p * 128 + 2 * lane); tot += x; if (p < 4) bref += x; if (p < w) offs += x; }
            const f32x2 fdec = (f32x2){__builtin_amdgcn_exp2f(tot.x - bref.x), __builtin_amdgcn_exp2f(tot.y - bref.y)};
            offs -= bref;
            unsigned kd0[4], kd1[4]; f32x2 kdp;
#pragma unroll
            for (int i = 0; i < 8; ++i) { const f32x2 x = offs + cs[i];
                const f32x2 e1 = (f32x2){__builtin_amdgcn_exp2f(x.x), __builtin_amdgcn_exp2f(x.y)}, e2 = (f32x2){__builtin_amdgcn_exp2f(-x.x), __builtin_amdgcn_exp2f(-x.y)};
                const f32x2 qf = (f32x2){__uint_as_float(qq[i] << 16), __uint_as_float(qq[i] & 0xffff0000u)} * e1, kf = (f32x2){__uint_as_float(kk[i] << 16), __uint_as_float(kk[i] & 0xffff0000u)} * e2;
                *(LAS unsigned*)(L + GQ_QT + (w * 8 + i) * 272 + lane * 4) = cvtpk_bf16(qf.x, qf.y);
                *(LAS unsigned*)(L + GQ_KT + (w * 8 + i) * 272 + lane * 4) = cvtpk_bf16(kf.x, kf.y);
                const f32x2 kd = kf * fdec;
                if (i & 1) { kd0[i >> 1] = cvtpk_bf16(kdp.x, kd.x); kd1[i >> 1] = cvtpk_bf16(kdp.y, kd.y); } else kdp = kd; }
            *(LAS v4u*)(L + GQ_KDT + (2 * lane) * 144 + w * 16) = (v4u){kd0[0], kd0[1], kd0[2], kd0[3]};
            *(LAS v4u*)(L + GQ_KDT + (2 * lane + 1) * 144 + w * 16) = (v4u){kd1[0], kd1[1], kd1[2], kd1[3]};
            *(LAS v4u*)(L + GQ_VT + (2 * lane) * 144 + w * 16) = (v4u){(vv[0] & 0xffffu) | (vv[1] << 16), (vv[2] & 0xffffu) | (vv[3] << 16), (vv[4] & 0xffffu) | (vv[5] << 16), (vv[6] & 0xffffu) | (vv[7] << 16)};
            *(LAS v4u*)(L + GQ_VT + (2 * lane + 1) * 144 + w * 16) = (v4u){(vv[0] >> 16) | (vv[1] & 0xffff0000u), (vv[2] >> 16) | (vv[3] & 0xffff0000u), (vv[4] >> 16) | (vv[5] & 0xffff0000u), (vv[6] >> 16) | (vv[7] & 0xffff0000u)};
        }
        f32x4 dr;
        {
            const int d0 = 16 * w + g4;
            const f32x4 pa = (*(const LAS f32x4*)(PT + d0) + *(const LAS f32x4*)(PT + 128 + d0)) + (*(const LAS f32x4*)(PT + 256 + d0) + *(const LAS f32x4*)(PT + 384 + d0));
            const f32x4 pb = (*(const LAS f32x4*)(PT + 512 + d0) + *(const LAS f32x4*)(PT + 640 + d0)) + (*(const LAS f32x4*)(PT + 768 + d0) + *(const LAS f32x4*)(PT + 896 + d0));
            f32x4 er;
#pragma unroll
            for (int r = 0; r < 4; ++r) { er[r] = __builtin_amdgcn_exp2f(pa[r]); dr[r] = __builtin_amdgcn_exp2f(pa[r] + pb[r]); }
#pragma unroll
            for (int j = 0; j < 8; ++j) { v2u o; o.x = cvtpk_bf16(st[j][0] * er[0], st[j][1] * er[1]); o.y = cvtpk_bf16(st[j][2] * er[2], st[j][3] * er[3]);
                *(LAS v2u*)(L + GQ_SX + (16 * j + l15) * 272 + d0 * 2) = o; }
        }
        { const int cn = (c + 1 < NCH) ? c + 1 : c; GLA_LOAD(cn); }
        const int so_out = ((c * GC + 16 * tt) * D + 64 * sh) * 2;
        unsigned short gt[4][4];
#pragma unroll
        for (int r = 0; r < 4; ++r)
#pragma unroll
            for (int j = 0; j < 4; ++j) gt[r][j] = (unsigned short)__builtin_amdgcn_raw_buffer_load_b16(rt, vog, so_out + (r * D + 16 * j) * 2, 0);
        GLA_BAR();
#pragma unroll
        for (int u = 0; u < 2; ++u) { const int stl = 2 * sh + u; f32x4 a = (f32x4){0.f, 0.f, 0.f, 0.f};
            if (stl <= tt) {
#pragma unroll
                for (int ks = 0; ks < 4; ++ks) a = __builtin_amdgcn_mfma_f32_16x16x32_bf16(lds_frag(L + GQ_QT, 272, 16 * tt, 32 * ks, lane), lds_frag(L + GQ_KT, 272, 16 * stl, 32 * ks, lane), a, 0, 0, 0);
            }
            const int s_ = 16 * stl + l15, t0 = 16 * tt + g4;
            const unsigned w01 = cvtpk_bf16(s_ <= t0 ? a[0] : 0.f, s_ <= t0 + 1 ? a[1] : 0.f), w23 = cvtpk_bf16(s_ <= t0 + 2 ? a[2] : 0.f, s_ <= t0 + 3 ? a[3] : 0.f);
            *(LAS unsigned short*)(L + GQ_AM + (t0 + 0) * 144 + s_ * 2) = (unsigned short)w01; *(LAS unsigned short*)(L + GQ_AM + (t0 + 1) * 144 + s_ * 2) = (unsigned short)(w01 >> 16);
            *(LAS unsigned short*)(L + GQ_AM + (t0 + 2) * 144 + s_ * 2) = (unsigned short)w23; *(LAS unsigned short*)(L + GQ_AM + (t0 + 3) * 144 + s_ * 2) = (unsigned short)(w23 >> 16); }
#pragma unroll
        for (int j = 0; j < 8; ++j) st[j] = st[j] * dr;
#pragma unroll
        for (int ks = 0; ks < 2; ++ks) { const bf16x8 a = lds_frag(L + GQ_KDT, 144, 16 * w, 32 * ks, lane);
#pragma unroll
            for (int j = 0; j < 8; ++j) st[j] = __builtin_amdgcn_mfma_f32_16x16x32_bf16(a, lds_frag(L + GQ_VT, 144, 16 * j, 32 * ks, lane), st[j], 0, 0, 0); }
        GLA_BAR();
        f32x4 acc[4];
#pragma unroll
        for (int j = 0; j < 4; ++j) acc[j] = (f32x4){0.f, 0.f, 0.f, 0.f};
#pragma unroll
        for (int ks = 0; ks < 4; ++ks) { const bf16x8 a = lds_frag(L + GQ_QT, 272, 16 * tt, 32 * ks, lane);
#pragma unroll
            for (int j = 0; j < 4; ++j) acc[j] = __builtin_amdgcn_mfma_f32_16x16x32_bf16(a, lds_frag(L + GQ_SX, 272, 16 * (4 * sh + j), 32 * ks, lane), acc[j], 0, 0, 0); }
#pragma unroll
        for (int ks = 0; ks < 2; ++ks) { const bf16x8 a = lds_frag(L + GQ_AM, 144, 16 * tt, 32 * ks, lane);
#pragma unroll
            for (int j = 0; j < 4; ++j) acc[j] = __builtin_amdgcn_mfma_f32_16x16x32_bf16(a, lds_frag(L + GQ_VT, 144, 16 * (4 * sh + j), 32 * ks, lane), acc[j], 0, 0, 0); }
        float ssq[4];
#pragma unroll
        for (int r = 0; r < 4; ++r) { float x = 0.f;
#pragma unroll
            for (int j = 0; j < 4; ++j) x += acc[j][r] * acc[j][r];
            ssq[r] = sum16(x); }
        if (l15 == 0) {
#pragma unroll
            for (int r = 0; r < 4; ++r) SS[(16 * tt + g4 + r) * 2 + sh] = ssq[r]; }
        GLA_BAR();
#pragma unroll
        for (int r = 0; r < 4; ++r) { const int t = 16 * tt + g4 + r;
            const float rn = rsqrtf((SS[t * 2] + SS[t * 2 + 1]) * (1.0f / DH) + EPS);
            const unsigned w01 = cvtpk_bf16(acc[0][r] * rn * bf2f(gt[r][0]), acc[1][r] * rn * bf2f(gt[r][1])), w23 = cvtpk_bf16(acc[2][r] * rn * bf2f(gt[r][2]), acc[3][r] * rn * bf2f(gt[r][3]));
            __builtin_amdgcn_raw_buffer_store_b16((unsigned short)w01, ro, vog, so_out + (r * D + 0) * 2, 0); __builtin_amdgcn_raw_buffer_store_b16((unsigned short)(w01 >> 16), ro, vog, so_out + (r * D + 16) * 2, 0);
            __builtin_amdgcn_raw_buffer_store_b16((unsigned short)w23, ro, vog, so_out + (r * D + 32) * 2, 0); __builtin_amdgcn_raw_buffer_store_b16((unsigned short)(w23 >> 16), ro, vog, so_out + (r * D + 48) * 2, 0); }
    }
#undef GLA_LOAD
#undef GLA_BAR
}


namespace moba {
using f32x16 = __attribute__((ext_vector_type(16))) float;
using s16x4  = __attribute__((ext_vector_type(4))) short;
using u32x4  = __attribute__((ext_vector_type(4))) unsigned;
constexpr int LD = 2048;
constexpr float SCALE = 0.088388347648318440f;
constexpr float C2 = SCALE * 1.4426950408889634f;
constexpr float THR_RAW = 8.0f / SCALE;
constexpr size_t SHM_V = 64 * 128 * 2, SHM_K = 64 * 128 * 2;
constexpr int OFF_WS = 2 * SHM_V + 2 * SHM_K, OFF_KM = OFF_WS + 8 * 64 * 4, ATT_LDS = OFF_KM + 8 * 128 * 4;
#define KSWZ(row, colB) ((row) * 256 + ((colB) ^ (((row) & 7) << 4)))
#define SBAR() __builtin_amdgcn_sched_barrier(0)
__device__ __forceinline__ int crow(int r, int hi) { return (r & 3) + 8 * (r >> 2) + 4 * hi; }
__device__ __forceinline__ unsigned cvtpk(float lo, float hi) { unsigned r; asm volatile("v_cvt_pk_bf16_f32 %0, %1, %2" : "=v"(r) : "v"(lo), "v"(hi)); return r; }
__device__ __forceinline__ void partialSM(f32x16& p0, f32x16& p1, float& m_reg, float& mn, float& alpha, float a, float yl, bool diag, int dlim, int hi) {
    const float NINF = -__builtin_inff();
    const float a3 = 3.f * a, a8 = 8.f * a, a24 = 24.f * a, a32 = 32.f * a;
#pragma unroll
    for (int r = 0; r < 16; ++r) { const int i = r & 3, k = r >> 2; float x = p0[r], z = p1[r];
        if (i == 1) { x += a; z += a; } else if (i == 2) { x = fmaf(a, 2.f, x); z = fmaf(a, 2.f, z); } else if (i == 3) { x += a3; z += a3; }
        if (k == 1) { x += a8; z += a8; } else if (k == 2) { x = fmaf(a8, 2.f, x); z = fmaf(a8, 2.f, z); } else if (k == 3) { x += a24; z += a24; }
        p0[r] = x; p1[r] = z; }
    if (diag) {
#pragma unroll
        for (int r = 0; r < 16; ++r) { const int k0 = (r & 3) + 8 * (r >> 2); p0[r] = (k0 > dlim) ? NINF : p0[r]; p1[r] = (32 + k0 > dlim) ? NINF : p1[r]; }
    }
    float pmax = p0[0], pmax1 = p1[0];
#pragma unroll
    for (int r = 1; r < 16; ++r) { pmax = fmaxf(pmax, p0[r]); pmax1 = fmaxf(pmax1, p1[r]); }
    pmax = fmaxf(pmax, pmax1 + a32) + yl;
    { auto rr = __builtin_amdgcn_permlane32_swap(__float_as_uint(pmax), __float_as_uint(pmax), false, false);
      pmax = fmaxf(__uint_as_float(rr[0]), __uint_as_float(rr[1])); }
    if (__builtin_expect(__all(pmax - m_reg <= THR_RAW), 1)) { mn = m_reg; alpha = 1.f; }
    else { mn = fmaxf(m_reg, pmax); alpha = __builtin_amdgcn_exp2f((m_reg - mn) * C2); m_reg = mn; }
    const float mnC = (yl - mn) * C2, mnC1 = (yl - mn + a32) * C2;
#pragma unroll
    for (int r = 0; r < 16; ++r) { p0[r] = fmaf(p0[r], C2, mnC); p1[r] = fmaf(p1[r], C2, mnC1); }
#pragma unroll
    for (int r = 0; r < 16; ++r) p0[r] = __builtin_amdgcn_exp2f(p0[r]);
}
__device__ __forceinline__ void finishSM(f32x16& p0, f32x16& p1, float alpha, float& l_reg, bf16x8& pa0, bf16x8& pa1, bf16x8& pa2, bf16x8& pa3) {
#pragma unroll
    for (int r = 0; r < 16; ++r) p1[r] = __builtin_amdgcn_exp2f(p1[r]);
    float ps = 0.f;
#pragma unroll
    for (int r = 0; r < 16; ++r) ps += p0[r];
#pragma unroll
    for (int r = 0; r < 16; ++r) ps += p1[r];
    { auto rr = __builtin_amdgcn_permlane32_swap(__float_as_uint(ps), __float_as_uint(ps), false, false);
      ps = __uint_as_float(rr[0]) + __uint_as_float(rr[1]); }
    l_reg = l_reg * alpha + ps;
#define PK4(P, BASE, OUT) do { unsigned a0 = cvtpk(P[BASE + 0], P[BASE + 1]), a1 = cvtpk(P[BASE + 2], P[BASE + 3]);   \
    unsigned b0 = cvtpk(P[BASE + 4], P[BASE + 5]), b1 = cvtpk(P[BASE + 6], P[BASE + 7]);                              \
    auto r0 = __builtin_amdgcn_permlane32_swap(a0, b0, false, false); auto r1 = __builtin_amdgcn_permlane32_swap(a1, b1, false, false); \
    u32x4 w = {r0[0], r1[0], r0[1], r1[1]}; OUT = *reinterpret_cast<bf16x8*>(&w); } while (0)
    PK4(p0, 0, pa0); PK4(p0, 8, pa1); PK4(p1, 0, pa2); PK4(p1, 8, pa3);
#undef PK4
}
__device__ __forceinline__ void qkt(f32x16& p0, f32x16& p1, const LAS char* Ks, const bf16x8* qr, int r32, int hi) {
    p0 = f32x16{}; p1 = f32x16{};
#pragma unroll
    for (int d0 = 0; d0 < 8; ++d0) { const int cb = (d0 * 16 + hi * 8) * 2;
        const bf16x8 b0 = *(const LAS bf16x8*)(Ks + KSWZ(r32, cb));
        const bf16x8 b1 = *(const LAS bf16x8*)(Ks + KSWZ(32 + r32, cb));
        p0 = __builtin_amdgcn_mfma_f32_32x32x16_bf16(b0, qr[d0], p0, 0, 0, 0);
        p1 = __builtin_amdgcn_mfma_f32_32x32x16_bf16(b1, qr[d0], p1, 0, 0, 0); }
}
__device__ __forceinline__ int v_st(int k, int c) { const int kk = (k & ~0xC) | ((k & 4) << 1) | ((k & 8) >> 1); return ((kk >> 3) * 4 + (c >> 5)) * 512 + ((kk & 7) * 32 + (c & 31)) * 2; }
__device__ __forceinline__ int v_rd_base(int lane) { return ((lane & 3) << 3) | (((lane >> 2) & 3) << 6) | (((lane >> 4) & 1) << 5) | (((lane >> 5) & 1) << 8); }
constexpr int v_rd_off(int d0, int ks, int half) { return d0 * 512 + ks * 4096 + half * 2048; }
template <int OFF> __device__ __forceinline__ s16x4 tr_read(int vb) {
    s16x4 r; asm volatile("ds_read_b64_tr_b16 %0, %1 offset:%2" : "=&v"(r) : "v"(vb), "i"(OFF) : "memory"); return r;
}
template <int D0> __device__ __forceinline__ void pv_one(f32x16& od, int vb, bf16x8 pa0, bf16x8 pa1, bf16x8 pa2, bf16x8 pa3) {
    const s16x4 l0 = tr_read<v_rd_off(D0, 0, 0)>(vb), h0 = tr_read<v_rd_off(D0, 0, 1)>(vb), l1 = tr_read<v_rd_off(D0, 1, 0)>(vb), h1 = tr_read<v_rd_off(D0, 1, 1)>(vb);
    const s16x4 l2 = tr_read<v_rd_off(D0, 2, 0)>(vb), h2 = tr_read<v_rd_off(D0, 2, 1)>(vb), l3 = tr_read<v_rd_off(D0, 3, 0)>(vb), h3 = tr_read<v_rd_off(D0, 3, 1)>(vb);
    asm volatile("s_waitcnt lgkmcnt(0)" ::: "memory"); SBAR();
#define PK(L, H) (bf16x8){L[0], L[1], L[2], L[3], H[0], H[1], H[2], H[3]}
    od = __builtin_amdgcn_mfma_f32_32x32x16_bf16(pa0, PK(l0, h0), od, 0, 0, 0);
    od = __builtin_amdgcn_mfma_f32_32x32x16_bf16(pa1, PK(l1, h1), od, 0, 0, 0);
    od = __builtin_amdgcn_mfma_f32_32x32x16_bf16(pa2, PK(l2, h2), od, 0, 0, 0);
    od = __builtin_amdgcn_mfma_f32_32x32x16_bf16(pa3, PK(l3, h3), od, 0, 0, 0);
#undef PK
}
__device__ __forceinline__ void pv_d0(f32x16* o, int vb, bf16x8 pa0, bf16x8 pa1, bf16x8 pa2, bf16x8 pa3) {
    pv_one<0>(o[0], vb, pa0, pa1, pa2, pa3); pv_one<1>(o[1], vb, pa0, pa1, pa2, pa3); pv_one<2>(o[2], vb, pa0, pa1, pa2, pa3); pv_one<3>(o[3], vb, pa0, pa1, pa2, pa3);
}
__device__ __forceinline__ void unit(const bf16* __restrict__ Qb, const bf16* __restrict__ Kh, const bf16* __restrict__ Vh, bf16* __restrict__ Ob,
                                     const float* __restrict__ qn, const float* __restrict__ kmp, int qb, int h, LAS char* lds, int tid_in) {
    int tid = tid_in;
    const int wid = __builtin_amdgcn_readfirstlane(tid >> 6), lane = tid & 63, r32 = lane & 31, hi = lane >> 5;
    LAS char* V_lds = lds; LAS char* K_lds = lds + 2 * SHM_V;
    LAS float* wsf = (LAS float*)(lds + OFF_WS) + wid * 64; LAS float* li_l = wsf; LAS float* al_l = wsf + 32;
    LAS float* KM = (LAS float*)(lds + OFF_KM);
    for (int i = tid; i < 8 * 128; i += 512) { const int n = i >> 7, d = i & 127; const float* p = kmp + (size_t)n * 512 + d; KM[i] = ((p[0] + p[128]) + (p[256] + p[384])) * (1.0f / 256.0f); }
    __syncthreads();
    float m_reg = -1e30f, l_reg = 0.f; bf16x8 qr[8];
    unsigned selmask;
    {
        const bf16* Qw = Qb + (size_t)(wid * 32 + r32) * LD + hi * 8;
        v4u raw[8]; float ss = 0.f;
#pragma unroll
        for (int d0 = 0; d0 < 8; ++d0) { raw[d0] = *(const v4u*)(Qw + d0 * 16);
            const float x0 = bflo(raw[d0].x), x1 = bfhi(raw[d0].x), x2 = bflo(raw[d0].y), x3 = bfhi(raw[d0].y), x4 = bflo(raw[d0].z), x5 = bfhi(raw[d0].z), x6 = bflo(raw[d0].w), x7 = bfhi(raw[d0].w);
            ss += (x0 * x0 + x1 * x1) + (x2 * x2 + x3 * x3) + (x4 * x4 + x5 * x5) + (x6 * x6 + x7 * x7); }
        ss = half_sum(ss);
        const float rinv = rsqrtf(ss * (1.0f / 128.0f) + EPS);
        float gate[8];
#pragma unroll
        for (int n = 0; n < 8; ++n) gate[n] = 0.f;
#pragma unroll
        for (int d0 = 0; d0 < 8; ++d0) { const f32x4 g0 = *(const f32x4*)(qn + d0 * 16 + hi * 8), g1 = *(const f32x4*)(qn + d0 * 16 + hi * 8 + 4);
            const float q0 = bflo(raw[d0].x) * rinv * g0.x, q1 = bfhi(raw[d0].x) * rinv * g0.y, q2 = bflo(raw[d0].y) * rinv * g0.z, q3 = bfhi(raw[d0].y) * rinv * g0.w;
            const float q4 = bflo(raw[d0].z) * rinv * g1.x, q5 = bfhi(raw[d0].z) * rinv * g1.y, q6 = bflo(raw[d0].w) * rinv * g1.z, q7 = bfhi(raw[d0].w) * rinv * g1.w;
            if (qb > 3) {
#pragma unroll
                for (int n = 0; n < 8; ++n) { const f32x4 k0 = *(const LAS f32x4*)(KM + n * 128 + d0 * 16 + hi * 8), k1 = *(const LAS f32x4*)(KM + n * 128 + d0 * 16 + hi * 8 + 4);
                    gate[n] += (q0 * k0.x + q1 * k0.y) + (q2 * k0.z + q3 * k0.w) + (q4 * k1.x + q5 * k1.y) + (q6 * k1.z + q7 * k1.w); } }
            u32x4 w = {cvtpk(q0, q1), cvtpk(q2, q3), cvtpk(q4, q5), cvtpk(q6, q7)};
            qr[d0] = *reinterpret_cast<bf16x8*>(&w); }
        selmask = 0u;
        if (qb <= 3) selmask = (1u << qb) - 1u;
        else {
#pragma unroll
            for (int n = 0; n < 8; ++n) { gate[n] = half_sum(gate[n]); gate[n] = (n < qb) ? gate[n] : -3e38f; }
#pragma unroll
            for (int it = 0; it < 3; ++it) { float best = -3e38f; int bi = 0;
#pragma unroll
                for (int n = 0; n < 8; ++n) { const bool ok = (n < qb) && !((selmask >> n) & 1u); if (ok && gate[n] > best) { best = gate[n]; bi = n; } }
                selmask |= 1u << bi; }
        }
        selmask |= 1u << qb;
    }
    asm volatile("" : "+v"(tid));
    f32x16 o[4] = {};
    float a = exp2f(-0.5f * (float)(h + 1)) * (1.0f / SCALE);
    asm volatile("" : "+v"(a));
    const float NINF = -__builtin_inff();
    const int trow = wid * 32 + r32;
#define TILE_PARAMS(j, yl, dg, dl) do { const int n_ = (j) >> 2, jj_ = (j) & 3; const float yb_ = a * (float)(64 * (j) - 256 * qb + 4 * hi); \
        if (n_ < qb) { yl = ((selmask >> n_) & 1u) ? yb_ : NINF; dg = false; dl = 0; } \
        else if (64 * jj_ + 63 <= 32 * wid) { yl = yb_; dg = false; dl = 0; } \
        else if (64 * jj_ > 32 * wid + 31) { yl = NINF; dg = false; dl = 0; } \
        else { yl = yb_; dg = true; dl = trow - 64 * jj_ - 4 * hi; } } while (0)
    const int sr = tid >> 4, sc = (tid & 15) * 8, vst0 = v_st(sr, sc), vst1 = v_st(32 + sr, sc);
    const int vb0 = (int)(uintptr_t)V_lds + v_rd_base(tid & 63);
    const unsigned goff0 = (unsigned)(sr * LD + sc) * 2u, goff1 = goff0 + 32u * LD * 2u;
    struct { bf16x8 vs0, vs1, ks0, ks1; } sr_[1];
#define SLOAD(i, k0) do { const char* vt_ = (const char*)Vh + (size_t)(k0) * (LD * 2); const char* kt_ = (const char*)Kh + (size_t)(k0) * (LD * 2); \
    sr_[i].vs0 = *(const bf16x8*)(vt_ + goff0); sr_[i].vs1 = *(const bf16x8*)(vt_ + goff1); sr_[i].ks0 = *(const bf16x8*)(kt_ + goff0); sr_[i].ks1 = *(const bf16x8*)(kt_ + goff1); } while (0)
#define SWRITE(b, i) do { *(LAS bf16x8*)(V_lds + (b) * SHM_V + vst0) = sr_[i].vs0;          \
    *(LAS bf16x8*)(V_lds + (b) * SHM_V + vst1) = sr_[i].vs1; const int kc = sc * 2;               \
    *(LAS bf16x8*)(K_lds + (b) * SHM_K + KSWZ(sr, kc)) = sr_[i].ks0;                       \
    *(LAS bf16x8*)(K_lds + (b) * SHM_K + KSWZ(32 + sr, kc)) = sr_[i].ks1; } while (0)
#define SWAIT() asm volatile("s_waitcnt vmcnt(0)" ::: "memory")
#define RESC(al) do { if (__any((al) < 1.f)) { if (hi == 0) al_l[r32] = (al); asm volatile("s_waitcnt lgkmcnt(0)" ::: "memory"); \
    _Pragma("unroll") for (int d = 0; d < 4; ++d) _Pragma("unroll") for (int r = 0; r < 16; ++r) o[d][r] *= al_l[crow(r, hi)]; } } while (0)
    f32x16 pA0, pA1, pB0, pB1; float mnA, mnB, alA, alB; bf16x8 pa0, pa1, pa2, pa3; const int NT = 4 * (qb + 1);
    float yl; bool dg; int dl;
    constexpr int SE = 0, SO = 0;
    SLOAD(SE, 0); asm volatile("s_waitcnt vmcnt(0)" ::: "memory"); SWRITE(0, SE); __syncthreads();
    qkt(pA0, pA1, K_lds, qr, r32, hi); TILE_PARAMS(0, yl, dg, dl); partialSM(pA0, pA1, m_reg, mnA, alA, a, yl, dg, dl, hi);
    SLOAD(SO, 64);
    SWAIT(); SWRITE(1, SO); __syncthreads();
    for (int j = 1; j + 1 < NT; j += 2) {
        SBAR(); qkt(pB0, pB1, K_lds + SHM_K, qr, r32, hi);
        finishSM(pA0, pA1, alA, l_reg, pa0, pa1, pa2, pa3); SBAR();
        SLOAD(SO, (j + 1) * 64); SBAR();
        pv_d0(o, vb0, pa0, pa1, pa2, pa3); TILE_PARAMS(j, yl, dg, dl); partialSM(pB0, pB1, m_reg, mnB, alB, a, yl, dg, dl, hi);
        __syncthreads(); SWAIT(); SWRITE(0, SE);
        RESC(alB); __syncthreads();
        SBAR(); qkt(pA0, pA1, K_lds, qr, r32, hi);
        finishSM(pB0, pB1, alB, l_reg, pa0, pa1, pa2, pa3); SBAR();
        SLOAD(SE, (j + 2) * 64); SBAR();
        pv_d0(o, vb0 + (int)SHM_V, pa0, pa1, pa2, pa3); TILE_PARAMS(j + 1, yl, dg, dl); partialSM(pA0, pA1, m_reg, mnA, alA, a, yl, dg, dl, hi);
        __syncthreads(); SWAIT(); SWRITE(1, SO);
        RESC(alA); __syncthreads();
    }
    SBAR(); qkt(pB0, pB1, K_lds + SHM_K, qr, r32, hi);
    finishSM(pA0, pA1, alA, l_reg, pa0, pa1, pa2, pa3); SBAR();
    pv_d0(o, vb0, pa0, pa1, pa2, pa3); TILE_PARAMS(NT - 1, yl, dg, dl); partialSM(pB0, pB1, m_reg, mnB, alB, a, yl, dg, dl, hi);
    __syncthreads(); RESC(alB);
    finishSM(pB0, pB1, alB, l_reg, pa0, pa1, pa2, pa3); SBAR();
    pv_d0(o, vb0 + (int)SHM_V, pa0, pa1, pa2, pa3);
    if (hi == 0) li_l[r32] = l_reg; asm volatile("s_waitcnt lgkmcnt(0)" ::: "memory");
    asm volatile("" : "+v"(tid));
    float rli[16];
#pragma unroll
    for (int r = 0; r < 16; ++r) rli[r] = __builtin_amdgcn_rcpf(li_l[crow(r, hi)]);
    { const int hi2 = (tid >> 5) & 1; bf16* Ow = Ob + (size_t)(wid * 32) * LD + (tid & 31);
#pragma unroll
    for (int r = 0; r < 16; ++r) { const int orow = crow(r, hi2);
#pragma unroll
        for (int d0 = 0; d0 < 4; ++d0) Ow[(size_t)orow * LD + d0 * 32] = (bf16)f2bf(o[d0][r] * rli[r]); } }
    __syncthreads();
#undef SLOAD
#undef SWRITE
#undef SWAIT
#undef RESC
#undef TILE_PARAMS
}
#undef KSWZ
#undef SBAR
}

__device__ __forceinline__ void kvnorm_item(int item, const bf16* KRAW, const float* k_norm, bf16* KNB, float* KMP, int lane) {
    const int part = item & 3, n = (item >> 2) & 7, h = (item >> 5) & 15, b = item >> 9;
    const int tk = lane >> 4, c8 = (lane & 15) * 8;
    const f32x4 g0 = *(const f32x4*)(k_norm + c8), g1 = *(const f32x4*)(k_norm + c8 + 4);
    float acc[8];
#pragma unroll
    for (int i = 0; i < 8; ++i) acc[i] = 0.f;
    for (int it = 0; it < 16; ++it) {
        const size_t off = ((size_t)b * S + n * BLK + part * 64 + it * 4 + tk) * D + h * DH + c8;
        const v4u raw = *(const v4u*)(KRAW + off);
        float v[8] = {bflo(raw.x), bfhi(raw.x), bflo(raw.y), bfhi(raw.y), bflo(raw.z), bfhi(raw.z), bflo(raw.w), bfhi(raw.w)};
        float ss = 0.f;
#pragma unroll
        for (int i = 0; i < 8; ++i) ss = fmaf(v[i], v[i], ss);
        ss = sum16(ss);
        const float r = rsqrtf(ss * (1.0f / DH) + EPS);
        v[0] *= r * g0.x; v[1] *= r * g0.y; v[2] *= r * g0.z; v[3] *= r * g0.w; v[4] *= r * g1.x; v[5] *= r * g1.y; v[6] *= r * g1.z; v[7] *= r * g1.w;
#pragma unroll
        for (int i = 0; i < 8; ++i) acc[i] += v[i];
        v4u o; o.x = pk2(v[0], v[1]); o.y = pk2(v[2], v[3]); o.z = pk2(v[4], v[5]); o.w = pk2(v[6], v[7]);
        *(v4u*)(KNB + off) = o;
    }
#pragma unroll
    for (int i = 0; i < 8; ++i) { acc[i] += swz_xor<16>(acc[i]); acc[i] = half_sum(acc[i]); }
    if (lane < 16) { float* p = KMP + (size_t)item * 128 + c8; *(f32x4*)p = (f32x4){acc[0], acc[1], acc[2], acc[3]}; *(f32x4*)(p + 4) = (f32x4){acc[4], acc[5], acc[6], acc[7]}; }
}

__global__ void __launch_bounds__(NWAVES * 64, 2) fwd(Args args) {
    extern __shared__ __attribute__((aligned(16))) unsigned char lds_raw[];
    LAS unsigned char* lds = (LAS unsigned char*)lds_raw;
    volatile LAS unsigned* MISC = (volatile LAS unsigned*)(lds + MISC_OFF);
    const int tid0 = threadIdx.x, wave = __builtin_amdgcn_readfirstlane(tid0 >> 6);
    const int G = gridDim.x;
    unsigned char* ws = args.ws;
    gu32* ctl = (gu32*)(ws + WS_CTL);
    for (int u = tid0; u < (LDS_BYTES - LDSCTL_OFF) / 4; u += NWAVES * 64) ((LAS unsigned*)(lds + LDSCTL_OFF))[u] = 0u;
    __syncthreads();
    XcdBarrier bar = xcd_barrier_post((unsigned*)(ctl + CW_BAR) + args.li * XCD_BAR_WORDS, MISC + 8);

#define WT   ((bf16*)(wsp + WS_WT))
#define HB   ((bf16*)(wsp + WS_XN))
#define PSUM ((float*)(wsp + WS_OF + 2 * MiB))
#define RSL  ((LAS float*)(lds + LDSCTL_OFF + 1024))
#define QS   ((bf16*)(wsp + WS_QS))
#define KS   ((bf16*)(wsp + WS_KS))
#define VS   ((bf16*)(wsp + WS_VS))
#define GT   ((bf16*)(wsp + WS_GT))
#define GS   ((float*)(wsp + WS_GS))
#define OG   ((bf16*)(wsp + WS_OG))
#define U    ((bf16*)(wsp + WS_U))
#define KRAW ((bf16*)(wsp + WS_KRAW))
#define VV   ((bf16*)(wsp + WS_VV))
#define QRAW ((bf16*)(wsp + WS_QRAW))
#define LBS  ((float*)(wsp + WS_SMALL + SM_LBS))
#define KNORMC ((float*)(wsp + WS_SMALL + SM_KNORM))
#define QNORMC ((float*)(wsp + WS_SMALL + SM_QNORM))
#define KNB  ((bf16*)(wsp + WS_KN))
#define KMP  ((float*)(wsp + WS_OF))
    float* hres = args.out;
    const int lo = args.ph_lo, hi = args.ph_hi;
    const int NGW = G * NWAVES;
    bool any = false;
#define PHASE_BEGIN(p) if (lo <= (p) && (p) < hi) { if (any) xcd_barrier(bar); any = true; GAS unsigned char* wsp = (GAS unsigned char*)args.ws; asm volatile("" : "+s"(wsp)); int bx = blockIdx.x; asm volatile("" : "+s"(bx)); (void)bx; int tz_ = threadIdx.x; asm volatile("" : "+v"(tz_)); const int tid = tz_, lane = tz_ & 63; (void)tid; (void)lane;
#define PHASE_END() }

    PHASE_BEGIN(0)
        {
            const int d = bx * (NWAVES * 64) + tid;
            if (d < D) { const float a = in_ptr(I_LB)[d], b = in_ptr(I_LB)[D + d], mx = fmaxf(a, b), ea = expf(a - mx), eb = expf(b - mx), sm = ea + eb, p0 = ea / sm, p1 = eb / sm;
                LBS[d] = 0.f; LBS[D + d] = (p0 + p1) - p0; }
            if (d < 128) KNORMC[d] = in_ptr(I_KNORM)[d];
            if (d < 256) QNORMC[d] = in_ptr(I_BQNORM)[d];
        }
        for (int m = bx * NWAVES + wave; m < M; m += NGW) intake_row(in_ptr(I_X) + (size_t)m * D, HB + (size_t)m * D, PSUM + (size_t)m * 32, lane);
        {
            LAS float* scr = (LAS float*)(lds + RING_OFF + wave * 16384);
            convert_weights(WT, 0, 1, bx * NWAVES + wave, NGW, scr, lane);
        }
    PHASE_END()

    for (int l = 0; l < 4; ++l) {
        const int pb = 1 + 9 * l;
        if (l < 2) {
            PHASE_BEGIN(pb + 1)
                pg8::Gemm g = pg8::gemm_rowmajor(HB, WT + WE_WIN + (size_t)l * D * 4 * D, M, 4 * D, D); pg8::StaticOrder So; So.init(M, 4 * D, G, bx);
                pg8::EpiHgrn E{QS, (size_t)(WS_KS - WS_QS) / 2, GS, LBS + l * D, RSL}; pg8::row_scale_table(PSUM, RSL, So, tid);
                pg8::gemm_phase<pg8::EpiHgrn, pg8::StaticOrder, true, true>(lds + RING_OFF, g, So, E);
            PHASE_END()
        } else {
            PHASE_BEGIN(pb + 1)
                const bool first = (l == 2);
                pg8::Gemm g = pg8::gemm_rowmajor(HB, first ? WT + WE_KVQ : WT + WE_Q1, M, first ? 3 * D : D, D); pg8::StaticOrder So; So.init(M, first ? 3 * D : D, G, bx);
                pg8::EpiSplit E{KRAW, (size_t)(WS_VV - WS_KRAW) / 2, first ? 0 : 2, RSL}; pg8::row_scale_table(PSUM, RSL, So, tid);
                pg8::gemm_phase<pg8::EpiSplit, pg8::StaticOrder, true, true>(lds + RING_OFF, g, So, E);
            PHASE_END()
        }
        if (l < 2) {
            PHASE_BEGIN(pb + 2)
                if (bx < NB * H) gla_seq(bx, QS, KS, VS, GS, GT, OG, lds + RING_OFF, tid);
                else if (G > NB * H) convert_weights(WT, l == 0 ? 1 : 8, l == 0 ? 8 : 17, (bx - NB * H) * NWAVES + wave, (G - NB * H) * NWAVES, (LAS float*)(lds + RING_OFF + wave * 16384), lane);
            PHASE_END()
        } else {
            if (l == 2) {
                PHASE_BEGIN(pb + 2)
                    for (int it = bx * NWAVES + wave; it < NB * H * NBLK * 4; it += NGW) kvnorm_item(it, KRAW, KNORMC, KNB, KMP, lane);
                PHASE_END()
            }
            PHASE_BEGIN(pb + 4)
                for (int pi = bx; pi < 256; pi += G) {
                    const int bh = pi & 63, pr = pi >> 6, b = bh >> 4, h = bh & 15;
                    for (int u = 0; u < 2; ++u) {
                        const int qb = u == 0 ? 7 - pr : pr;
                        const size_t qoff = ((size_t)b * S + 256 * qb) * D + h * DH, koff = (size_t)b * S * D + h * DH;
                        moba::unit(QRAW + qoff, KNB + koff, VV + koff, OG + qoff, QNORMC + (size_t)(l - 2) * DH, KMP + (size_t)bh * 4096, qb, h, (LAS char*)(lds + RING_OFF), tid);
                    }
                }
            PHASE_END()
        }
        PHASE_BEGIN(pb + 5)
            pg8::Gemm g = pg8::gemm_rowmajor(OG, l < 2 ? WT + WE_WOUT + (size_t)l * D * D : WT + WE_WO + (size_t)(l - 2) * D * D, M, D, D); pg8::StaticOrder So; So.init(M, D, G, bx);
            pg8::EpiRes<false> E{HB, PSUM, nullptr, D};
            pg8::gemm_phase<pg8::EpiRes<false>, pg8::StaticOrder, true, true>(lds + RING_OFF, g, So, E);
        PHASE_END()
        PHASE_BEGIN(pb + 7)
            pg8::Gemm g = pg8::gemm_rowmajor(HB, WT + WE_W1 + (size_t)l * D * FF, M, FF, D); pg8::StaticOrder So; So.init(M, FF, G, bx);
            pg8::EpiRelu2 E{U, FF, RSL}; pg8::row_scale_table(PSUM, RSL, So, tid);
            pg8::gemm_phase<pg8::EpiRelu2, pg8::StaticOrder, true, true>(lds + RING_OFF, g, So, E);
        PHASE_END()
        PHASE_BEGIN(pb + 8)
            pg8::Gemm g{U, WT + WE_W2 + (size_t)l * FF * D, M, D, FF, 64, 64, 32768, 32768, (size_t)(FF / 64) * 32768, (size_t)(FF / 64) * 32768};     pg8::StaticOrder So; So.init(M, D, G, bx);
            if (l == 3) { pg8::EpiRes<true> E{HB, PSUM, hres, D}; pg8::gemm_phase<pg8::EpiRes<true>, pg8::StaticOrder, true, true>(lds + RING_OFF, g, So, E); }
            else { pg8::EpiRes<false> E{HB, PSUM, nullptr, D}; pg8::gemm_phase<pg8::EpiRes<false>, pg8::StaticOrder, true, true>(lds + RING_OFF, g, So, E); }
        PHASE_END()
    }
#undef PHASE_BEGIN
#undef PHASE_END
#undef WT
#undef HB
#undef PSUM
#undef RSL
#undef QS
#undef KS
#undef VS
#undef GT
#undef GS
#undef OG
#undef U
#undef KRAW
#undef VV
#undef QRAW
#undef LBS
#undef KNORMC
#undef QNORMC
#undef KNB
#undef KMP
}

extern "C" void kernel_launch(void* const* d_in, const int* in_sizes, int n_in, void* d_out, int out_size, void* d_ws, size_t ws_size, hipStream_t stream) {
    static int grid = 0;
    if (grid == 0) {
        if (n_in != 16 || out_size != M * D || ws_size < WS_END) { fprintf(stderr, "kernel_launch: unexpected sizes (n_in %d, out %d, ws %zu < %zu); nothing launched\n", n_in, out_size, ws_size, (size_t)WS_END); grid = -1; return; }
        int dev = 0, cus = 0, per_cu = 0;
        if (hipGetDevice(&dev) != hipSuccess || hipDeviceGetAttribute(&cus, hipDeviceAttributeMultiprocessorCount, dev) != hipSuccess) { grid = -1; return; }
        if (hipFuncSetAttribute((const void*)fwd, hipFuncAttributeMaxDynamicSharedMemorySize, LDS_BYTES) != hipSuccess) { fprintf(stderr, "kernel_launch: hipFuncSetAttribute failed\n"); grid = -1; return; }
        if (hipOccupancyMaxActiveBlocksPerMultiprocessor(&per_cu, (const void*)fwd, NWAVES * 64, LDS_BYTES) != hipSuccess || per_cu < 1) { fprintf(stderr, "kernel_launch: occupancy query says %d blocks per CU\n", per_cu); }
        (void)hipGetLastError();
        grid = cus;
    }
    if (grid < 0) return;
    if (hipMemsetAsync((char*)d_ws + WS_CTL, 0, CTL_ZERO_BYTES, stream) != hipSuccess) return;
    Args a{};
    for (int i = 0; i < 16; ++i) a.in[i] = (const float*)d_in[i];
    a.out = (float*)d_out; a.ws = (unsigned char*)d_ws;
    a.ph_lo = 0; a.ph_hi = 37; a.li = 0;
    hipLaunchKernelGGL(fwd, dim3(grid), dim3(NWAVES * 64), LDS_BYTES, stream, a);
}
```

```cpp
#include <hip/hip_runtime.h>
#include <cstdio>
#include <cstdint>

template <int K> __device__ __forceinline__ float swz_xor(float v) { return __builtin_bit_cast(float, __builtin_amdgcn_ds_swizzle(__builtin_bit_cast(int, v), (K << 10) | 0x1f)); }
__device__ __forceinline__ float half_sum(float v) { auto rr = __builtin_amdgcn_permlane32_swap(__float_as_uint(v), __float_as_uint(v), false, false); const unsigned r0 = rr[0], r1 = rr[1]; return __uint_as_float(r0) + __uint_as_float(r1); }
__device__ __forceinline__ float sum16(float v) { v += swz_xor<1>(v); v += swz_xor<2>(v); v += swz_xor<4>(v); v += swz_xor<8>(v); return v; }
__device__ __forceinline__ float wave_sum(float v) { v = sum16(v); v += swz_xor<16>(v); return half_sum(v); }

namespace pg8 {
#define PG8_LAS __attribute__((address_space(3)))
typedef unsigned short bf16_t;
typedef short bf16x8 __attribute__((ext_vector_type(8)));
typedef float f32x4 __attribute__((ext_vector_type(4)));
typedef unsigned u32x4 __attribute__((ext_vector_type(4)));
constexpr int BM = 256, BK = 64, HALF = 128, HTB = HALF * BK * 2  , STAGE_BYTES = 8 * HTB, NXCD = 8, WGM = 8;

__host__ __device__ __forceinline__ int lds_byte(int r, int c) { const int st = (r >> 4) * 2 + (c >> 5), rr = r & 15, cc = c & 31, ob = rr * 64 + cc * 2; return st * 1024 + (ob ^ (((ob >> 9) & 1) << 5)); }
__host__ __device__ __forceinline__ void stage_rc(int b, int& R, int& C) { const int st = b / 1024, sb = b % 1024, swz = sb ^ (((sb >> 9) & 1) << 5); R = (st >> 1) * 16 + swz / 64; C = (st & 1) * 32 + (swz % 64) / 2; }
__host__ __device__ __forceinline__ int perm32(int rho) { const int n = rho >> 4, i = rho & 15; return 8 * (i >> 2) + 4 * n + (i & 3); }

struct Unit { int pm, pn, ord; };
struct Gemm { const bf16_t* A; const bf16_t* Bt; int M, N, K, lda, ldb; size_t ksa, ksb, tsa, tsb; };
__host__ __device__ inline Gemm gemm_rowmajor(const bf16_t* A, const bf16_t* Bt, int M, int N, int K) { return Gemm{A, Bt, M, N, K, K, K, 128, 128, (size_t)256 * K * 2, (size_t)256 * K * 2}; }

struct StaticOrder {
    int nM, nN, nwg, G, c;
    __host__ __device__ void init(int M, int N, int G_, int c_) { nM = M / BM; nN = N / BM; nwg = nM * nN; G = G_; c = c_; }
    __host__ __device__ bool next(int i, Unit& u) const {
        const long L = (long)i * G + c; if (L >= nwg) return false;
        int wgid = (int)L; { const int q = nwg / NXCD, r = nwg % NXCD, xcd = wgid % NXCD, off = wgid / NXCD; wgid = (xcd < r ? xcd * (q + 1) : r * (q + 1) + (xcd - r) * q) + off; }
        const int nig = WGM * nN, gid = wgid / nig, fm = gid * WGM, gsz = (nM - fm) < WGM ? (nM - fm) : WGM;
        u.pm = fm + ((wgid % nig) % gsz); u.pn = (wgid % nig) / gsz; u.ord = i; return true;
    }
    __device__ __forceinline__ void a_ready(const Unit&) const {}
    __device__ __forceinline__ void done(const Unit&) const {}
};

__device__ __forceinline__ unsigned cvt_pk_bf16(float lo, float hi) { unsigned r; asm("v_cvt_pk_bf16_f32 %0, %1, %2" : "=v"(r) : "v"(lo), "v"(hi)); return r; }
typedef float f32x2 __attribute__((ext_vector_type(2)));
template <class Sched> __device__ __forceinline__ void row_scale_table(const float* PS, PG8_LAS float* RS, const Sched& So, int tid) {
#pragma unroll
    for (int pass = 0; pass < 4; ++pass) { Unit uu; const int i = 2 * pass + (tid >> 8);
        if (So.next(i, uu)) { const f32x4* p = (const f32x4*)(PS + (size_t)(uu.pm * BM + (tid & 255)) * 32); f32x4 a = p[0];
#pragma unroll
            for (int k = 1; k < 8; ++k) a = a + p[k];
            RS[i * 256 + (tid & 255)] = rsqrtf(((a[0] + a[1]) + (a[2] + a[3])) * (1.0f / 2048.0f) + 1e-6f); } }
    asm volatile("s_waitcnt vmcnt(0) lgkmcnt(0)" ::: "memory"); __builtin_amdgcn_s_barrier(); asm volatile("" ::: "memory");
}
template <bool LAST>
struct EpiRes {
    static constexpr bool PERM = true, AFTER_DRAIN = false;
    bf16_t* HB; float* PS; float* Fout; int ldc;
    __device__ __forceinline__ void operator()(const f32x4 (&acc)[2][2][4][2], const Unit& u, int wr, int wc, int fr, int fq) const {
        const int row0 = u.pm * BM + wr * 64 + fr, col0 = u.pn * BM + wc * 64 + 8 * fq;
        u32x4 hv[2][4][2];
#pragma unroll
        for (int ai = 0; ai < 2; ++ai)
#pragma unroll
            for (int m = 0; m < 4; ++m)
#pragma unroll
                for (int bj = 0; bj < 2; ++bj) hv[ai][m][bj] = *(const u32x4*)(HB + (size_t)(row0 + ai * HALF + m * 16) * ldc + col0 + bj * 32);
#pragma unroll
        for (int ai = 0; ai < 2; ++ai)
#pragma unroll
            for (int m = 0; m < 4; ++m) { const int row = row0 + ai * HALF + m * 16; float ss = 0.f;
#pragma unroll
                for (int bj = 0; bj < 2; ++bj) { const u32x4 r = hv[ai][m][bj]; const size_t off = (size_t)row * ldc + col0 + bj * 32;
                    const f32x4 h0 = (f32x4){__builtin_bit_cast(float, r.x << 16), __builtin_bit_cast(float, r.x & 0xffff0000u), __builtin_bit_cast(float, r.y << 16), __builtin_bit_cast(float, r.y & 0xffff0000u)} + acc[ai][bj][m][0];
                    const f32x4 h1 = (f32x4){__builtin_bit_cast(float, r.z << 16), __builtin_bit_cast(float, r.z & 0xffff0000u), __builtin_bit_cast(float, r.w << 16), __builtin_bit_cast(float, r.w & 0xffff0000u)} + acc[ai][bj][m][1];
                    if constexpr (LAST) { *(f32x4*)(Fout + off) = h0; *(f32x4*)(Fout + off + 4) = h1; }
                    else { ss += ((h0[0] * h0[0] + h0[1] * h0[1]) + (h0[2] * h0[2] + h0[3] * h0[3])) + ((h1[0] * h1[0] + h1[1] * h1[1]) + (h1[2] * h1[2] + h1[3] * h1[3]));
                        u32x4 w; w.x = cvt_pk_bf16(h0[0], h0[1]); w.y = cvt_pk_bf16(h0[2], h0[3]); w.z = cvt_pk_bf16(h1[0], h1[1]); w.w = cvt_pk_bf16(h1[2], h1[3]);
                        *(u32x4*)(HB + off) = w; } }
                if constexpr (!LAST) { ss += swz_xor<16>(ss); ss = half_sum(ss);
                    if (fq == 0) PS[(size_t)row * 32 + u.pn * 4 + wc] = ss; } }
    }
};
struct EpiRelu2 {
    static constexpr bool PERM = true, AFTER_DRAIN = false;
    bf16_t* O; int ncols; PG8_LAS float* RS;
    __device__ __forceinline__ void operator()(const f32x4 (&acc)[2][2][4][2], const Unit& u, int wr, int wc, int fr, int fq) const {
        bf16_t* tile = O + ((size_t)(u.pm * (ncols / 64) + u.pn * 4 + wc) * 256 + wr * 64 + fr) * 64 + 8 * fq;
#pragma unroll
        for (int ai = 0; ai < 2; ++ai)
#pragma unroll
            for (int m = 0; m < 4; ++m) { bf16_t* rowp = tile + (ai * HALF + m * 16) * 64; const float rs = RS[u.ord * 256 + ai * HALF + wr * 64 + m * 16 + fr], rs2 = rs * rs;
#pragma unroll
                for (int bj = 0; bj < 2; ++bj) { f32x4 v0 = acc[ai][bj][m][0], v1 = acc[ai][bj][m][1];
#pragma unroll
                    for (int j = 0; j < 4; ++j) { const float a = __builtin_amdgcn_fmed3f(v0[j], 0.f, 3.0e38f), b = __builtin_amdgcn_fmed3f(v1[j], 0.f, 3.0e38f); v0[j] = (a * a) * rs2; v1[j] = (b * b) * rs2; }
                    u32x4 w; w.x = cvt_pk_bf16(v0[0], v0[1]); w.y = cvt_pk_bf16(v0[2], v0[3]); w.z = cvt_pk_bf16(v1[0], v1[1]); w.w = cvt_pk_bf16(v1[2], v1[3]);
                    *(u32x4*)(rowp + bj * 32) = w; } }
    }
};
struct EpiSplit {
    static constexpr bool PERM = true, AFTER_DRAIN = false;
    bf16_t* O0; size_t gstride; int g0; PG8_LAS float* RS;
    __device__ __forceinline__ void operator()(const f32x4 (&acc)[2][2][4][2], const Unit& u, int wr, int wc, int fr, int fq) const {
        const int g = g0 + (u.pn >> 3); bf16_t* base = O0 + (size_t)g * gstride;
        const int row0 = u.pm * BM + wr * 64 + fr, col0 = (u.pn & 7) * BM + wc * 64 + 8 * fq;
#pragma unroll
        for (int ai = 0; ai < 2; ++ai)
#pragma unroll
            for (int m = 0; m < 4; ++m) { bf16_t* rowp = base + (size_t)(row0 + ai * HALF + m * 16) * 2048 + col0; const float rs = RS[u.ord * 256 + ai * HALF + wr * 64 + m * 16 + fr];
#pragma unroll
                for (int bj = 0; bj < 2; ++bj) { const f32x4 v0 = acc[ai][bj][m][0] * rs, v1 = acc[ai][bj][m][1] * rs;
                    u32x4 w; w.x = cvt_pk_bf16(v0[0], v0[1]); w.y = cvt_pk_bf16(v0[2], v0[3]); w.z = cvt_pk_bf16(v1[0], v1[1]); w.w = cvt_pk_bf16(v1[2], v1[3]);
                    *(u32x4*)(rowp + bj * 32) = w; } }
    }
};
struct EpiHgrn {
    static constexpr bool PERM = true, AFTER_DRAIN = false;
    bf16_t* Qs; size_t qstride; float* Gs; const float* lb; PG8_LAS float* RS;
    __device__ __forceinline__ void operator()(const f32x4 (&acc)[2][2][4][2], const Unit& u, int wr, int wc, int fr, int fq) const {
        const int quarter = u.pn >> 3;
        const int row0 = u.pm * BM + wr * 64 + fr, col0 = (u.pn & 7) * BM + wc * 64 + 8 * fq;
        if (quarter == 1) {
            f32x4 lbv[2][2];
#pragma unroll
            for (int bj = 0; bj < 2; ++bj)
#pragma unroll
                for (int n = 0; n < 2; ++n) lbv[bj][n] = *(const f32x4*)(lb + col0 + bj * 32 + 4 * n);
#pragma unroll
            for (int ai = 0; ai < 2; ++ai)
#pragma unroll
                for (int m = 0; m < 4; ++m) { const size_t ro = (size_t)(row0 + ai * HALF + m * 16) * 2048 + col0; const float rs = RS[u.ord * 256 + ai * HALF + wr * 64 + m * 16 + fr];
#pragma unroll
                    for (int bj = 0; bj < 2; ++bj) { f32x4 lf[2];
#pragma unroll
                        for (int n = 0; n < 2; ++n)
#pragma unroll
                            for (int j = 0; j < 4; ++j) { const float x = fmaxf(acc[ai][bj][m][n][j] * rs, -80.f), e = __expf(-x), r = __builtin_amdgcn_rcpf(1.f + e);
                                const float l0 = lbv[bj][n][j], om = 1.f - l0; lf[n][j] = __log2f(fmaf(om, r, l0)); }
                        *(f32x4*)(Gs + ro + bj * 32) = lf[0]; *(f32x4*)(Gs + ro + bj * 32 + 4) = lf[1]; } }
        } else {
            bf16_t* base = Qs + (size_t)quarter * qstride;
            const bool act = quarter != 2;
#pragma unroll
            for (int ai = 0; ai < 2; ++ai)
#pragma unroll
                for (int m = 0; m < 4; ++m) { bf16_t* rowp = base + (size_t)(row0 + ai * HALF + m * 16) * 2048 + col0; const float rs = RS[u.ord * 256 + ai * HALF + wr * 64 + m * 16 + fr];
#pragma unroll
                    for (int bj = 0; bj < 2; ++bj) { f32x4 v0 = acc[ai][bj][m][0] * rs, v1 = acc[ai][bj][m][1] * rs;
                        if (act) {
#pragma unroll
                            for (int j = 0; j < 4; ++j) { const float a = fmaxf(v0[j], -80.f), b = fmaxf(v1[j], -80.f);
                                v0[j] = a * __builtin_amdgcn_rcpf(1.f + __expf(-a)); v1[j] = b * __builtin_amdgcn_rcpf(1.f + __expf(-b)); } }
                        u32x4 w; w.x = cvt_pk_bf16(v0[0], v0[1]); w.y = cvt_pk_bf16(v0[2], v0[3]); w.z = cvt_pk_bf16(v1[0], v1[1]); w.w = cvt_pk_bf16(v1[2], v1[3]);
                        *(u32x4*)(rowp + bj * 32) = w; } }
        }
    }
};


template <class Epi, class Sched, bool ALIGN_EPI = false, bool SP2 = false>
__device__ __forceinline__ void gemm_phase(PG8_LAS unsigned char* lds, const Gemm g, const Sched& S, const Epi& E) {
    int tid_ = threadIdx.x; asm volatile("" : "+v"(tid_));
    const int tid = tid_, wid = __builtin_amdgcn_readfirstlane(tid >> 6), lane = tid & 63, wr = wid >> 2, wc = wid & 3, fr = lane & 15, fq = lane >> 4;
    const int K = g.K, nt = K / BK;
    unsigned voffA[2], voffB[2];
#pragma unroll
    for (int i = 0; i < 2; ++i) { int R, C; stage_rc(tid * 16 + i * 8192, R, C); const int Rb = Epi::PERM ? (2 * (R & ~31) + perm32(R & 31)) : R;
        voffA[i] = (unsigned)(R * g.lda + C) * 2u; voffB[i] = (unsigned)(Rb * g.ldb + C) * 2u; }
    const size_t kstepA = g.ksa, kstepB = g.ksb;
    const size_t hstepA = (size_t)HALF * g.lda * 2, hstepB = (size_t)(Epi::PERM ? 32 : HALF) * g.ldb * 2;
    const size_t tstepA = g.tsa, tstepB = g.tsb;
    const unsigned ldsw = (unsigned)wid * 1024u;
    const int aoff = lds_byte(wr * 64 + fr, fq * 8), boff = lds_byte(wc * 32 + fr, fq * 8);
#define PG8_SA(b, h) (((b) * 2 + (h)) * HTB)
#define PG8_SB(b, h) ((4 + (b) * 2 + (h)) * HTB)
#define PG8_STAGE(bufoff, gbase, voff) do { _Pragma("unroll") for (int _i = 0; _i < 2; ++_i) \
        __builtin_amdgcn_global_load_lds((const unsigned*)((const char*)(gbase) + (voff)[_i]), (PG8_LAS unsigned*)(lds + (bufoff) + ldsw + _i * 8192), 16, 0, 0); } while (0)
#define PG8_LDA(dst, b, h) do { _Pragma("unroll") for (int m = 0; m < 4; ++m) _Pragma("unroll") for (int k = 0; k < 2; ++k) dst[m][k] = *(const PG8_LAS bf16x8*)(lds + PG8_SA(b, h) + aoff + m * 2048 + k * 1024); } while (0)
#define PG8_LDB(dst, b, h) do { _Pragma("unroll") for (int n = 0; n < 2; ++n) _Pragma("unroll") for (int k = 0; k < 2; ++k) dst[n][k] = *(const PG8_LAS bf16x8*)(lds + PG8_SB(b, h) + boff + n * 2048 + k * 1024); } while (0)
#define PG8_MMA(ai, bj, At, Bt) do { __builtin_amdgcn_s_setprio(1); _Pragma("unroll") for (int m = 0; m < 4; ++m) _Pragma("unroll") for (int n = 0; n < 2; ++n) _Pragma("unroll") for (int k = 0; k < 2; ++k) \
        acc[ai][bj][m][n] = __builtin_amdgcn_mfma_f32_16x16x32_bf16(Bt[n][k], At[m][k], acc[ai][bj][m][n], 0, 0, 0); __builtin_amdgcn_s_setprio(0); } while (0)
#define PG8_WAIT_V(n) asm volatile("s_waitcnt vmcnt(" #n ")" ::: "memory")
#define PG8_WAIT_L(n) asm volatile("s_waitcnt lgkmcnt(" #n ")" ::: "memory")
#define PG8_BAR __builtin_amdgcn_s_barrier()
#define PG8_SCHED __builtin_amdgcn_sched_barrier(0)
    Unit cur, nxt; int ui = 0;
    if (!S.next(0, cur)) return;
    f32x4 acc[2][2][4][2];
#pragma unroll
    for (int a = 0; a < 2; ++a)
#pragma unroll
        for (int b = 0; b < 2; ++b)
#pragma unroll
            for (int m = 0; m < 4; ++m)
#pragma unroll
                for (int n = 0; n < 2; ++n) acc[a][b][m][n] = (f32x4){0.f, 0.f, 0.f, 0.f};
    bf16x8 At[4][2], B0[2][2], B1[2][2];
    const char* cA = (const char*)g.A + (size_t)cur.pm * tstepA; const char* cB = (const char*)g.Bt + (size_t)cur.pn * tstepB;
    S.a_ready(cur);
    if constexpr (SP2) {
        PG8_STAGE(PG8_SB(0, 0), cB, voffB); PG8_STAGE(PG8_SB(0, 1), cB + hstepB, voffB); PG8_STAGE(PG8_SA(0, 0), cA, voffA); PG8_STAGE(PG8_SA(0, 1), cA + hstepA, voffA);
        if (wr == 1) PG8_BAR;
        PG8_WAIT_V(2); PG8_BAR;
        PG8_STAGE(PG8_SB(1, 0), cB + kstepB, voffB); PG8_STAGE(PG8_SA(1, 0), cA + kstepA, voffA); PG8_STAGE(PG8_SB(1, 1), cB + hstepB + kstepB, voffB);
        PG8_WAIT_V(6); PG8_BAR;
    } else {
        PG8_STAGE(PG8_SB(0, 0), cB, voffB); PG8_STAGE(PG8_SA(0, 0), cA, voffA); PG8_STAGE(PG8_SB(0, 1), cB + hstepB, voffB); PG8_STAGE(PG8_SA(0, 1), cA + hstepA, voffA);
        if (wr == 1) PG8_BAR;
        PG8_WAIT_V(4); PG8_BAR;
        PG8_STAGE(PG8_SB(1, 0), cB + kstepB, voffB); PG8_STAGE(PG8_SA(1, 0), cA + kstepA, voffA); PG8_STAGE(PG8_SB(1, 1), cB + hstepB + kstepB, voffB);
        PG8_WAIT_V(6); PG8_BAR;
    }
    for (;;) {
        const bool has_next = S.next(ui + 1, nxt);
        const char* nA = has_next ? (const char*)g.A + (size_t)nxt.pm * tstepA : cA; const char* nB = has_next ? (const char*)g.Bt + (size_t)nxt.pn * tstepB : cB;
        for (int t = 0; t < nt; t += 2) {
            const bool last = (t == nt - 2);
            const char* a1 = cA + (size_t)(t + 1) * kstepA;
            const char* a2 = last ? nA : cA + (size_t)(t + 2) * kstepA; const char* b2 = last ? nB : cB + (size_t)(t + 2) * kstepB;
            const char* a3 = a2 + kstepA; const char* b3 = b2 + kstepB;
            if (last && has_next) S.a_ready(nxt);
            if constexpr (SP2) {
            PG8_LDB(B0, 0, 0); PG8_LDB(B1, 0, 1); PG8_SCHED; PG8_LDA(At, 0, 0); PG8_STAGE(PG8_SA(1, 1), a1 + hstepA, voffA);
            PG8_WAIT_V(8); PG8_WAIT_L(0); PG8_BAR; PG8_MMA(0, 0, At, B0); PG8_MMA(0, 1, At, B1); PG8_BAR; PG8_SCHED;
            PG8_LDA(At, 0, 1); PG8_STAGE(PG8_SB(0, 0), b2, voffB); PG8_STAGE(PG8_SB(0, 1), b2 + hstepB, voffB); PG8_STAGE(PG8_SA(0, 0), a2, voffA);
            PG8_WAIT_V(8); PG8_WAIT_L(0); PG8_BAR; PG8_MMA(1, 0, At, B0); PG8_MMA(1, 1, At, B1); PG8_BAR; PG8_SCHED;
            PG8_LDB(B0, 1, 0); PG8_LDB(B1, 1, 1); PG8_SCHED; PG8_LDA(At, 1, 0); PG8_STAGE(PG8_SA(0, 1), a2 + hstepA, voffA);
            PG8_WAIT_V(8); PG8_WAIT_L(0); PG8_BAR; PG8_MMA(0, 0, At, B0); PG8_MMA(0, 1, At, B1); PG8_BAR; PG8_SCHED;
            PG8_LDA(At, 1, 1); PG8_STAGE(PG8_SB(1, 0), b3, voffB); PG8_STAGE(PG8_SB(1, 1), b3 + hstepB, voffB); PG8_STAGE(PG8_SA(1, 0), a3, voffA);
            PG8_WAIT_V(8); PG8_WAIT_L(0); PG8_BAR; PG8_MMA(1, 0, At, B0); PG8_MMA(1, 1, At, B1); PG8_BAR; PG8_SCHED;
            } else {
            PG8_LDB(B0, 0, 0); PG8_SCHED; PG8_LDA(At, 0, 0); PG8_STAGE(PG8_SA(1, 1), a1 + hstepA, voffA);
            PG8_WAIT_L(8); PG8_BAR; PG8_WAIT_L(0); PG8_MMA(0, 0, At, B0); PG8_BAR; PG8_SCHED;
            PG8_LDB(B1, 0, 1); PG8_STAGE(PG8_SB(0, 0), b2, voffB);
            PG8_BAR; PG8_WAIT_L(0); PG8_MMA(0, 1, At, B1); PG8_BAR;
            PG8_LDA(At, 0, 1); PG8_STAGE(PG8_SA(0, 0), a2, voffA);
            PG8_BAR; PG8_WAIT_L(0); PG8_MMA(1, 0, At, B0); PG8_BAR; PG8_SCHED;
            PG8_STAGE(PG8_SB(0, 1), b2 + hstepB, voffB);
            PG8_WAIT_V(6); PG8_BAR; PG8_MMA(1, 1, At, B1); PG8_BAR;
            PG8_LDB(B0, 1, 0); PG8_SCHED; PG8_LDA(At, 1, 0); PG8_STAGE(PG8_SA(0, 1), a2 + hstepA, voffA);
            PG8_WAIT_L(8); PG8_BAR; PG8_WAIT_L(0); PG8_MMA(0, 0, At, B0); PG8_BAR; PG8_SCHED;
            PG8_LDB(B1, 1, 1); PG8_STAGE(PG8_SB(1, 0), b3, voffB);
            PG8_BAR; PG8_WAIT_L(0); PG8_MMA(0, 1, At, B1); PG8_BAR;
            PG8_LDA(At, 1, 1); PG8_STAGE(PG8_SA(1, 0), a3, voffA);
            PG8_BAR; PG8_WAIT_L(0); PG8_MMA(1, 0, At, B0); PG8_BAR; PG8_SCHED;
            PG8_STAGE(PG8_SB(1, 1), b3 + hstepB, voffB);
            PG8_WAIT_V(6); PG8_BAR; PG8_MMA(1, 1, At, B1); PG8_BAR;
            }
        }
        if constexpr (ALIGN_EPI) { if (wr == 0) PG8_BAR; }
        if constexpr (!Epi::AFTER_DRAIN) { E(acc, cur, wr, wc, fr, fq); S.done(cur); }
        if (!has_next) break;
#pragma unroll
        for (int a = 0; a < 2; ++a)
#pragma unroll
            for (int b = 0; b < 2; ++b)
#pragma unroll
                for (int m = 0; m < 4; ++m)
#pragma unroll
                    for (int n = 0; n < 2; ++n) acc[a][b][m][n] = (f32x4){0.f, 0.f, 0.f, 0.f};
        cur = nxt; cA = nA; cB = nB; ++ui;
        if constexpr (ALIGN_EPI) { if (wr == 1) PG8_BAR; }
    }
    PG8_WAIT_V(0);
    if constexpr (!ALIGN_EPI) { if (wr == 0) PG8_BAR; }
    PG8_BAR;
    if constexpr (Epi::AFTER_DRAIN) { E.fused(acc, cur, wr, wc, fr, fq, lds, wid, lane); S.done(cur); }
#undef PG8_SA
#undef PG8_SB
#undef PG8_STAGE
#undef PG8_LDA
#undef PG8_LDB
#undef PG8_MMA
#undef PG8_WAIT_V
#undef PG8_WAIT_L
#undef PG8_BAR
#undef PG8_SCHED
}
}

constexpr int D = 2048, NB = 4, S = 2048, M = NB * S, FF = 8192, H = 16, DH = 128, NBLK = 8, BLK = 256;
constexpr float EPS = 1e-6f;
constexpr int NWAVES = 8;
constexpr size_t MiB = 1u << 20;
constexpr size_t WS_CTL = 0, CTL_ZERO_BYTES = 32768;
constexpr size_t WS_WT = 1 * MiB;
constexpr size_t WE_WIN = 0, WE_WOUT = 33554432, WE_KVQ = 41943040, WE_Q1 = 54525952, WE_WO = 58720256, WE_W1 = 67108864, WE_W2 = 134217728, WE_END = 201326592;
constexpr size_t WS_XN = 385 * MiB, WS_QS = 417 * MiB, WS_KS = 449 * MiB, WS_VS = 481 * MiB, WS_GT = 513 * MiB, WS_GS = 545 * MiB, WS_OG = 609 * MiB, WS_U = 641 * MiB;
constexpr size_t WS_KRAW = 769 * MiB, WS_VV = 801 * MiB, WS_QRAW = 833 * MiB, WS_OF = 865 * MiB, WS_KN = 929 * MiB, WS_SMALL = 993 * MiB, WS_END = 994 * MiB;
constexpr size_t SM_LBS = 0, SM_KNORM = 16384, SM_QNORM = 16384 + 512, SM_KMEAN = 65536;
static_assert((4096 + 3456) * 4 <= 32768, "barrier words inside the memset");
constexpr int CW_BAR = 4096;
constexpr int RING_OFF = 0, RING_BYTES = 131072;
constexpr int LDSCTL_OFF = RING_BYTES, MISC_OFF = LDSCTL_OFF + 320;
constexpr int LDS_BYTES = 147456;

#define GAS __attribute__((address_space(1)))
#define LAS __attribute__((address_space(3)))
typedef unsigned short bf16;
typedef unsigned v4u __attribute__((ext_vector_type(4)));
typedef unsigned v2u __attribute__((ext_vector_type(2)));
typedef float f32x2 __attribute__((ext_vector_type(2)));
typedef float f32x4 __attribute__((ext_vector_type(4)));
typedef short bf16x8 __attribute__((ext_vector_type(8)));
typedef GAS unsigned gu32;
#define RLX_AGENT __ATOMIC_RELAXED, __HIP_MEMORY_SCOPE_AGENT
#define LDS_WAIT() asm volatile("s_waitcnt lgkmcnt(0)" ::: "memory")
#define VM_WAIT() asm volatile("s_waitcnt vmcnt(0)" ::: "memory")
__device__ __forceinline__ unsigned f2bf(float f) { unsigned u = __builtin_bit_cast(unsigned, f); return (u + 0x7fffu + ((u >> 16) & 1u)) >> 16; }
__device__ __forceinline__ unsigned pk2(float lo, float hi) { return f2bf(lo) | (f2bf(hi) << 16); }
__device__ __forceinline__ float bf2f(unsigned short b) { return __builtin_bit_cast(float, (unsigned)b << 16); }
__device__ __forceinline__ float bflo(unsigned w) { return __builtin_bit_cast(float, w << 16); }
__device__ __forceinline__ float bfhi(unsigned w) { return __builtin_bit_cast(float, w & 0xffff0000u); }
static_assert(WS_VS - WS_KS == WS_KS - WS_QS && WS_GT - WS_VS == WS_KS - WS_QS && WS_QRAW - WS_VV == WS_VV - WS_KRAW, "strided tensor groups");
#define XB_TMO      128
#define XB_XCNT(j)  (256  + 64 * (j))
#define XB_XSUB(j)  (1280 + 64 * (j))
#define XB_XGEN(j)  (2304 + 64 * (j))
#define XB_TOP      3328
#define XB_TOPGEN   3392
#define XCD_BAR_WORDS 3456
#define XB_SPIN_CAP (1u << 18)

__device__ __forceinline__ unsigned xb_ld(unsigned* p)              { return __hip_atomic_load(p, __ATOMIC_RELAXED, __HIP_MEMORY_SCOPE_AGENT); }
__device__ __forceinline__ unsigned xb_add(unsigned* p, unsigned v) { return __hip_atomic_fetch_add(p, v, __ATOMIC_RELAXED, __HIP_MEMORY_SCOPE_AGENT); }
__device__ __forceinline__ unsigned xb_xcc_id() { return (unsigned)__builtin_amdgcn_s_getreg((3 << 11) | 20) & 0xFu; }
#define XB_SPIN(cond, bar) do { unsigned _sp = 0; while (cond) { __builtin_amdgcn_s_sleep(1); \
    if ((++_sp & 255u) == 0u) { if (xb_ld(&(bar)[XB_TMO])) break; if (_sp > XB_SPIN_CAP) { atomicAdd(&(bar)[XB_TMO], 1u); break; } } } } while (0)

struct XcdBarrier {
    unsigned* bar; unsigned x;
    volatile LAS unsigned* st;
};

__device__ __forceinline__ XcdBarrier xcd_barrier_post(unsigned* bar, volatile LAS unsigned* st) {
    XcdBarrier b; b.bar = bar; b.x = xb_xcc_id(); b.st = st;
    if (threadIdx.x == 0) (void)xb_add(&bar[XB_XCNT(b.x)], 1u);
    return b;
}
__device__ __forceinline__ void xcd_barrier_complete(unsigned* bar, unsigned x, unsigned& nloc, unsigned& nx) {
    const unsigned G = gridDim.x * gridDim.y * gridDim.z;
    unsigned sum, cnt, mine, sp = 0u;
    for (;;) {
        sum = 0u; cnt = 0u; mine = 0u;
#pragma unroll
        for (unsigned j = 0; j < 16; ++j) { const unsigned c = xb_ld(&bar[XB_XCNT(j)]); sum += c; cnt += (c > 0u) ? 1u : 0u; mine = (j == x) ? c : mine; }
        if (sum == G) break;
        __builtin_amdgcn_s_sleep(1);
        if ((++sp & 255u) == 0u) { if (xb_ld(&bar[XB_TMO])) break; if (sp > XB_SPIN_CAP) { atomicAdd(&bar[XB_TMO], 1u); break; } }
    }
    nloc = mine > 0u ? mine : 1u; nx = cnt > 0u ? cnt : 1u;
}

__device__ __forceinline__ void xcd_barrier(const XcdBarrier& b) {
    asm volatile("s_waitcnt vmcnt(0)" ::: "memory");
    __syncthreads();
    if (threadIdx.x == 0) {
        unsigned* bar = b.bar;
        __builtin_amdgcn_s_waitcnt(0);
        unsigned nloc = b.st[0], nx = b.st[1];
        if (nloc == 0u) { xcd_barrier_complete(bar, b.x, nloc, nx); b.st[0] = nloc; b.st[1] = nx; }
        const unsigned old = xb_add(&bar[XB_XSUB(b.x)], 1u);
        const unsigned gen = old / nloc;
        if (old + 1u == (gen + 1u) * nloc) {
            __builtin_amdgcn_fence(__ATOMIC_RELEASE, "agent");
            asm volatile("s_waitcnt vmcnt(0)" ::: "memory");
            const unsigned og = xb_add(&bar[XB_TOP], 1u);
            const unsigned tg = og / nx;
            if (og + 1u == (tg + 1u) * nx) xb_add(&bar[XB_TOPGEN], 1u);
            else XB_SPIN(xb_ld(&bar[XB_TOPGEN]) == tg, bar);
            __builtin_amdgcn_fence(__ATOMIC_ACQUIRE, "agent");
            xb_add(&bar[XB_XGEN(b.x)], 1u);
            asm volatile("s_waitcnt vmcnt(0)" ::: "memory");
        } else {
            XB_SPIN(xb_ld(&bar[XB_XGEN(b.x)]) == gen, bar);
            __builtin_amdgcn_fence(__ATOMIC_ACQUIRE, "agent");
            asm volatile("s_waitcnt vmcnt(0)" ::: "memory");
        }
    }
    __syncthreads();
}


struct Args { const float* in[16]; float* out; unsigned char* ws; int ph_lo, ph_hi, li, pad; };
enum InIdx { I_X = 0, I_ANORM, I_AWIN, I_AHEAD, I_AWOUT, I_LB, I_KVNORM, I_WKV, I_KNORM, I_BNORM, I_BWQ, I_BQNORM, I_BWO, I_MLPNORM, I_W1, I_W2 };
__device__ __forceinline__ const float* in_ptr(int i) {
    const __attribute__((address_space(4))) unsigned char* ka = (const __attribute__((address_space(4))) unsigned char*)__builtin_amdgcn_kernarg_segment_ptr();
    int off = i * 8; asm volatile("" : "+s"(off));
    const float* p = *(const float* const __attribute__((address_space(4)))*)(ka + off);
    return (const float*)(const GAS float*)p;
}

__device__ __forceinline__ void transpose_item(const float* W, const float* gain, int K, int N, bf16* WT, LAS float* scr, int item, int lane, int tiled) {
    const int nblk = N / 32, kb = item / nblk, nb = item % nblk, k0 = 64 * kb, n0 = 32 * nb;
    const int ks = lane >> 3, n4 = (lane & 7) * 4, c = lane & 7;
    f32x4 v[8];
#pragma unroll
    for (int i = 0; i < 8; ++i) v[i] = *(const GAS f32x4*)(W + (size_t)(k0 + ks + 8 * i) * N + n0 + n4);
    f32x4 g0 = (f32x4){1.f, 1.f, 1.f, 1.f}, g1 = g0;
    if (gain) { g0 = *(const GAS f32x4*)(gain + k0 + 8 * c); g1 = *(const GAS f32x4*)(gain + k0 + 8 * c + 4); }
#pragma unroll
    for (int i = 0; i < 8; ++i) { LAS float* d = scr + (ks + 8 * i) * 33 + n4; d[0] = v[i].x; d[1] = v[i].y; d[2] = v[i].z; d[3] = v[i].w; }
    LDS_WAIT(); asm volatile("" ::: "memory");
#pragma unroll
    for (int j = 0; j < 4; ++j) { const int n = (lane >> 3) + 8 * j; const LAS float* s = scr + (8 * c) * 33 + n;
        v4u o; o.x = pk2(s[0 * 33] * g0.x, s[1 * 33] * g0.y); o.y = pk2(s[2 * 33] * g0.z, s[3 * 33] * g0.w); o.z = pk2(s[4 * 33] * g1.x, s[5 * 33] * g1.y); o.w = pk2(s[6 * 33] * g1.z, s[7 * 33] * g1.w);
        bf16* dst = tiled ? WT + (((size_t)((n0 + n) >> 8) * (K / 64) + kb) * 256 + ((n0 + n) & 255)) * 64 + 8 * c
                          : WT + (size_t)(n0 + n) * K + k0 + 8 * c;
        *(GAS v4u*)dst = o; }
    LDS_WAIT(); asm volatile("" ::: "memory");
}
struct MatDesc { const float* src; const float* gain; bf16* dst; int K, N, items, tiled; };
__device__ __forceinline__ MatDesc mat_desc(bf16* WT, int id) {
    MatDesc m; int kind, l;
    if (id < 4)        { kind = id; l = 0; }
    else if (id < 8)   { kind = id - 4; l = 1; }
    else if (id == 8)  { kind = 4; l = 0; }
    else if (id == 9)  { kind = 5; l = 0; }
    else if (id == 10) { kind = 6; l = 0; }
    else if (id == 11) { kind = 2; l = 2; }
    else if (id == 12) { kind = 3; l = 2; }
    else if (id == 13) { kind = 5; l = 1; }
    else if (id == 14) { kind = 6; l = 1; }
    else if (id == 15) { kind = 2; l = 3; }
    else               { kind = 3; l = 3; }
    if (kind == 0)      { m.src = in_ptr(I_AWIN) + (size_t)l * D * 4 * D; m.gain = in_ptr(I_ANORM) + l * D; m.dst = WT + WE_WIN + (size_t)l * D * 4 * D; m.K = D; m.N = 4 * D; }
    else if (kind == 1) { m.src = in_ptr(I_AWOUT) + (size_t)l * D * D; m.gain = in_ptr(I_AHEAD) + l * D; m.dst = WT + WE_WOUT + (size_t)l * D * D; m.K = D; m.N = D; }
    else if (kind == 2) { m.src = in_ptr(I_W1) + (size_t)l * D * FF; m.gain = in_ptr(I_MLPNORM) + l * D; m.dst = WT + WE_W1 + (size_t)l * D * FF; m.K = D; m.N = FF; }
    else if (kind == 3) { m.src = in_ptr(I_W2) + (size_t)l * FF * D; m.gain = nullptr; m.dst = WT + WE_W2 + (size_t)l * FF * D; m.K = FF; m.N = D; }
    else if (kind == 4) { m.src = in_ptr(I_WKV); m.gain = in_ptr(I_KVNORM); m.dst = WT + WE_KVQ; m.K = D; m.N = 2 * D; }
    else if (kind == 5) { m.src = in_ptr(I_BWQ) + (size_t)l * D * D; m.gain = in_ptr(I_BNORM) + l * D; m.dst = l == 0 ? WT + WE_KVQ + (size_t)2 * D * D : WT + WE_Q1; m.K = D; m.N = D; }
    else                { m.src = in_ptr(I_BWO) + (size_t)l * D * D; m.gain = nullptr; m.dst = WT + WE_WO + (size_t)l * D * D; m.K = D; m.N = D; }
    m.items = (m.K / 64) * (m.N / 32); m.tiled = (kind == 3) ? 1 : 0;
    return m;
}
__device__ __forceinline__ void convert_weights(bf16* WT, int id_lo, int id_hi, int wv, int nwv, LAS float* scr, int lane) {
    int id = id_lo; MatDesc md = mat_desc(WT, id); int base = 0;
    for (int it = wv; ; it += nwv) {
        while (it >= base + md.items) { base += md.items; ++id; if (id >= id_hi) return; md = mat_desc(WT, id); }
        transpose_item(md.src, md.gain, md.K, md.N, md.dst, scr, it - base, lane, md.tiled);
    }
}
__device__ __forceinline__ void intake_row(const float* xrow, bf16* hbrow, float* psrow, int lane) {
    const GAS f32x4* xr = (const GAS f32x4*)xrow + lane;
    f32x4 v[8]; float s = 0.f;
#pragma unroll
    for (int j = 0; j < 8; ++j) { v[j] = xr[64 * j]; s += (v[j].x * v[j].x + v[j].y * v[j].y) + (v[j].z * v[j].z + v[j].w * v[j].w); }
    s = wave_sum(s);
    GAS v2u* o8 = (GAS v2u*)hbrow + lane;
#pragma unroll
    for (int j = 0; j < 8; ++j) { v2u w; w.x = pk2(v[j].x, v[j].y); w.y = pk2(v[j].z, v[j].w); o8[64 * j] = w; }
    if (lane < 32) psrow[lane] = (lane == 0) ? s : 0.f;
}

constexpr int GC = 64, NCH = S / GC;
constexpr int GQ_PT = 0, GQ_SS = 4096, GQ_QT = 5120, GQ_KT = GQ_QT + 64 * 272, GQ_VT = GQ_KT + 64 * 272, GQ_AM = GQ_VT + 128 * 144, GQ_SX = 67584, GQ_KDT = GQ_SX + 128 * 272;
static_assert(GQ_AM + 64 * 144 <= GQ_SX && GQ_KDT + 128 * 144 <= RING_BYTES, "GLA LDS map");
__device__ __forceinline__ bf16x8 lds_frag(LAS const unsigned char* base, int stride_bytes, int row0, int k0, int lane) {
    return *(const LAS bf16x8*)(base + (row0 + (lane & 15)) * stride_bytes + (k0 + 8 * (lane >> 4)) * 2);
}
__device__ __forceinline__ unsigned cvtpk_bf16(float lo, float hi) { unsigned r; asm("v_cvt_pk_bf16_f32 %0, %1, %2" : "=v"(r) : "v"(lo), "v"(hi)); return r; }
__device__ __forceinline__ void gla_seq(int bh, const bf16* QS, const bf16* KS, const bf16* VS, const float* GS, const bf16* GT, bf16* OG, LAS unsigned char* L, int tid) {
    const int b = bh >> 4, h = bh & 15;
    const int lane = tid & 63, w = __builtin_amdgcn_readfirstlane(tid >> 6);
    const int tt = w >> 1, sh = w & 1, g4 = 4 * (lane >> 4), l15 = lane & 15;
    LAS float* PT = (LAS float*)(L + GQ_PT); LAS float* SS = (LAS float*)(L + GQ_SS);
    const size_t ebase = (size_t)b * S * D + h * DH;
    const __amdgpu_buffer_rsrc_t rq = __builtin_amdgcn_make_buffer_rsrc((void*)(QS + ebase), 0, S * D * 2, 0x00020000), rk = __builtin_amdgcn_make_buffer_rsrc((void*)(KS + ebase), 0, S * D * 2, 0x00020000);
    const __amdgpu_buffer_rsrc_t rv = __builtin_amdgcn_make_buffer_rsrc((void*)(VS + ebase), 0, S * D * 2, 0x00020000), rg = __builtin_amdgcn_make_buffer_rsrc((void*)(GS + ebase), 0, S * D * 4, 0x00020000);
    const __amdgpu_buffer_rsrc_t rt = __builtin_amdgcn_make_buffer_rsrc((void*)(GT + ebase), 0, S * D * 2, 0x00020000), ro = __builtin_amdgcn_make_buffer_rsrc((void*)(OG + ebase), 0, S * D * 2, 0x00020000);
    const unsigned vo2 = (unsigned)((w * 8) * D + 2 * lane) * 2u, vo4 = vo2 * 2u;
    const unsigned vog = (unsigned)(g4 * D + l15) * 2u;
    f32x4 st[8];
#pragma unroll
    for (int j = 0; j < 8; ++j) st[j] = (f32x4){0.f, 0.f, 0.f, 0.f};
    f32x2 cs[8], gr[8]; unsigned qq[8], vv[8];
#define GLA_LOAD(c) do { const int so_ = (c) * GC * D * 2; f32x2 run_ = (f32x2){0.f, 0.f}; \
        _Pragma("unroll") for (int i = 0; i < 8; ++i) { const v2u g_ = __builtin_amdgcn_raw_buffer_load_b64(rg, vo4, 2 * (so_ + i * D * 2), 0); gr[i] = (f32x2){__uint_as_float(g_.x), __uint_as_float(g_.y)}; run_ += gr[i]; cs[i] = run_; \
            qq[i] = __builtin_amdgcn_raw_buffer_load_b32(rq, vo2, so_ + i * D * 2, 0); } \
        _Pragma("unroll") for (int i = 0; i < 8; ++i) vv[i] = __builtin_amdgcn_raw_buffer_load_b32(rv, vo2, so_ + i * D * 2, 0); } while (0)
#define GLA_BAR() do { asm volatile("s_waitcnt lgkmcnt(0)" ::: "memory"); __builtin_amdgcn_s_barrier(); asm volatile("" ::: "memory"); } while (0)
    GLA_LOAD(0);
    for (int c = 0; c < NCH; ++c) {
        *(LAS f32x2*)(PT + w * 128 + 2 * lane) = cs[7];
        GLA_BAR();
        {
            f32x2 offs = (f32x2){0.f, 0.f}, bref = offs, tot = offs;
#pragma unroll
            for (int p = 0; p < 8; ++p) { const f32x2 x = *(const LAS f32x2*)(PT + p * 128 + 2 * lane); tot += x; if (p < 4) bref += x; if (p < w) offs += x; }
            const f32x2 fdec = (f32x2){__builtin_amdgcn_exp2f(tot.x - bref.x), __builtin_amdgcn_exp2f(tot.y - bref.y)};
            offs -= bref;
            unsigned kd0[4], kd1[4]; f32x2 kdp;
#pragma unroll
            for (int i = 0; i < 8; ++i) { const f32x2 x = offs + cs[i];
                const f32x2 e1 = (f32x2){__builtin_amdgcn_exp2f(x.x), __builtin_amdgcn_exp2f(x.y)}, e2 = (f32x2){__builtin_amdgcn_exp2f(-x.x), __builtin_amdgcn_exp2f(-x.y)};
                const f32x2 qf = (f32x2){__uint_as_float(qq[i] << 16), __uint_as_float(qq[i] & 0xffff0000u)} * e1, kf = ((f32x2){1.f, 1.f} - (f32x2){__builtin_amdgcn_exp2f(gr[i].x), __builtin_amdgcn_exp2f(gr[i].y)}) * e2;
                *(LAS unsigned*)(L + GQ_QT + (w * 8 + i) * 272 + lane * 4) = cvtpk_bf16(qf.x, qf.y);
                *(LAS unsigned*)(L + GQ_KT + (w * 8 + i) * 272 + lane * 4) = cvtpk_bf16(kf.x, kf.y);
                const f32x2 kd = kf * fdec;
                if (i & 1) { kd0[i >> 1] = cvtpk_bf16(kdp.x, kd.x); kd1[i >> 1] = cvtpk_bf16(kdp.y, kd.y); } else kdp = kd; }
            *(LAS v4u*)(L + GQ_KDT + (2 * lane) * 144 + w * 16) = (v4u){kd0[0], kd0[1], kd0[2], kd0[3]};
            *(LAS v4u*)(L + GQ_KDT + (2 * lane + 1) * 144 + w * 16) = (v4u){kd1[0], kd1[1], kd1[2], kd1[3]};
            *(LAS v4u*)(L + GQ_VT + (2 * lane) * 144 + w * 16) = (v4u){(vv[0] & 0xffffu) | (vv[1] << 16), (vv[2] & 0xffffu) | (vv[3] << 16), (vv[4] & 0xffffu) | (vv[5] << 16), (vv[6] & 0xffffu) | (vv[7] << 16)};
            *(LAS v4u*)(L + GQ_VT + (2 * lane + 1) * 144 + w * 16) = (v4u){(vv[0] >> 16) | (vv[1] & 0xffff0000u), (vv[2] >> 16) | (vv[3] & 0xffff0000u), (vv[4] >> 16) | (vv[5] & 0xffff0000u), (vv[6] >> 16) | (vv[7] & 0xffff0000u)};
        }
        f32x4 dr;
        {
            const int d0 = 16 * w + g4;
            const f32x4 pa = (*(const LAS f32x4*)(PT + d0) + *(const LAS f32x4*)(PT + 128 + d0)) + (*(const LAS f32x4*)(PT + 256 + d0) + *(const LAS f32x4*)(PT + 384 + d0));
            const f32x4 pb = (*(const LAS f32x4*)(PT + 512 + d0) + *(const LAS f32x4*)(PT + 640 + d0)) + (*(const LAS f32x4*)(PT + 768 + d0) + *(const LAS f32x4*)(PT + 896 + d0));
            f32x4 er;
#pragma unroll
            for (int r = 0; r < 4; ++r) { er[r] = __builtin_amdgcn_exp2f(pa[r]); dr[r] = __builtin_amdgcn_exp2f(pa[r] + pb[r]); }
#pragma unroll
            for (int j = 0; j < 8; ++j) { v2u o; o.x = cvtpk_bf16(st[j][0] * er[0], st[j][1] * er[1]); o.y = cvtpk_bf16(st[j][2] * er[2], st[j][3] * er[3]);
                *(LAS v2u*)(L + GQ_SX + (16 * j + l15) * 272 + d0 * 2) = o; }
        }
        { const int cn = (c + 1 < NCH) ? c + 1 : c; GLA_LOAD(cn); }
        const int so_out = ((c * GC + 16 * tt) * D + 64 * sh) * 2;
        unsigned short gt[4][4];
#pragma unroll
        for (int r = 0; r < 4; ++r)
#pragma unroll
            for (int j = 0; j < 4; ++j) gt[r][j] = (unsigned short)__builtin_amdgcn_raw_buffer_load_b16(rt, vog, so_out + (r * D + 16 * j) * 2, 0);
        GLA_BAR();
#pragma unroll
        for (int u = 0; u < 2; ++u) { const int stl = 2 * sh + u; f32x4 a = (f32x4){0.f, 0.f, 0.f, 0.f};
            if (stl <= tt) {
#pragma unroll
                for (int ks = 0; ks < 4; ++ks) a = __builtin_amdgcn_mfma_f32_16x16x32_bf16(lds_frag(L + GQ_QT, 272, 16 * tt, 32 * ks, lane), lds_frag(L + GQ_KT, 272, 16 * stl, 32 * ks, lane), a, 0, 0, 0);
            }
            const int s_ = 16 * stl + l15, t0 = 16 * tt + g4;
            const unsigned w01 = cvtpk_bf16(s_ <= t0 ? a[0] : 0.f, s_ <= t0 + 1 ? a[1] : 0.f), w23 = cvtpk_bf16(s_ <= t0 + 2 ? a[2] : 0.f, s_ <= t0 + 3 ? a[3] : 0.f);
            *(LAS unsigned short*)(L + GQ_AM + (t0 + 0) * 144 + s_ * 2) = (unsigned short)w01; *(LAS unsigned short*)(L + GQ_AM + (t0 + 1) * 144 + s_ * 2) = (unsigned short)(w01 >> 16);
            *(LAS unsigned short*)(L + GQ_AM + (t0 + 2) * 144 + s_ * 2) = (unsigned short)w23; *(LAS unsigned short*)(L + GQ_AM + (t0 + 3) * 144 + s_ * 2) = (unsigned short)(w23 >> 16); }
#pragma unroll
        for (int j = 0; j < 8; ++j) st[j] = st[j] * dr;
#pragma unroll
        for (int ks = 0; ks < 2; ++ks) { const bf16x8 a = lds_frag(L + GQ_KDT, 144, 16 * w, 32 * ks, lane);
#pragma unroll
            for (int j = 0; j < 8; ++j) st[j] = __builtin_amdgcn_mfma_f32_16x16x32_bf16(a, lds_frag(L + GQ_VT, 144, 16 * j, 32 * ks, lane), st[j], 0, 0, 0); }
        GLA_BAR();
        f32x4 acc[4];
#pragma unroll
        for (int j = 0; j < 4; ++j) acc[j] = (f32x4){0.f, 0.f, 0.f, 0.f};
#pragma unroll
        for (int ks = 0; ks < 4; ++ks) { const bf16x8 a = lds_frag(L + GQ_QT, 272, 16 * tt, 32 * ks, lane);
#pragma unroll
            for (int j = 0; j < 4; ++j) acc[j] = __builtin_amdgcn_mfma_f32_16x16x32_bf16(a, lds_frag(L + GQ_SX, 272, 16 * (4 * sh + j), 32 * ks, lane), acc[j], 0, 0, 0); }
#pragma unroll
        for (int ks = 0; ks < 2; ++ks) { const bf16x8 a = lds_frag(L + GQ_AM, 144, 16 * tt, 32 * ks, lane);
#pragma unroll
            for (int j = 0; j < 4; ++j) acc[j] = __builtin_amdgcn_mfma_f32_16x16x32_bf16(a, lds_frag(L + GQ_VT, 144, 16 * (4 * sh + j), 32 * ks, lane), acc[j], 0, 0, 0); }
        float ssq[4];
#pragma unroll
        for (int r = 0; r < 4; ++r) { float x = 0.f;
#pragma unroll
            for (int j = 0; j < 4; ++j) x += acc[j][r] * acc[j][r];
            ssq[r] = sum16(x); }
        if (l15 == 0) {
#pragma unroll
            for (int r = 0; r < 4; ++r) SS[(16 * tt + g4 + r) * 2 + sh] = ssq[r]; }
        GLA_BAR();
#pragma unroll
        for (int r = 0; r < 4; ++r) { const int t = 16 * tt + g4 + r;
            const float rn = rsqrtf((SS[t * 2] + SS[t * 2 + 1]) * (1.0f / DH) + EPS);
            const unsigned w01 = cvtpk_bf16(acc[0][r] * rn * bf2f(gt[r][0]), acc[1][r] * rn * bf2f(gt[r][1])), w23 = cvtpk_bf16(acc[2][r] * rn * bf2f(gt[r][2]), acc[3][r] * rn * bf2f(gt[r][3]));
            __builtin_amdgcn_raw_buffer_store_b16((unsigned short)w01, ro, vog, so_out + (r * D + 0) * 2, 0); __builtin_amdgcn_raw_buffer_store_b16((unsigned short)(w01 >> 16), ro, vog, so_out + (r * D + 16) * 2, 0);
            __builtin_amdgcn_raw_buffer_store_b16((unsigned short)w23, ro, vog, so_out + (r * D + 32) * 2, 0); __builtin_amdgcn_raw_buffer_store_b16((unsigned short)(w23 >> 16), ro, vog, so_out + (r * D + 48) * 2, 0); }
    }
#undef GLA_LOAD
#undef GLA_BAR
}


namespace moba {
using f32x16 = __attribute__((ext_vector_type(16))) float;
using s16x4  = __attribute__((ext_vector_type(4))) short;
using u32x4  = __attribute__((ext_vector_type(4))) unsigned;
constexpr int LD = 2048;
constexpr float SCALE = 0.088388347648318440f;
constexpr float C2 = SCALE * 1.4426950408889634f;
constexpr float THR_RAW = 8.0f / SCALE;
constexpr size_t SHM_V = 64 * 128 * 2, SHM_K = 64 * 128 * 2;
constexpr int OFF_WS = 2 * SHM_V + 2 * SHM_K, OFF_KM = OFF_WS + 8 * 64 * 4, ATT_LDS = OFF_KM + 8 * 128 * 4;
#define KSWZ(row, colB) ((row) * 256 + ((colB) ^ (((row) & 7) << 4)))
#define SBAR() __builtin_amdgcn_sched_barrier(0)
__device__ __forceinline__ int crow(int r, int hi) { return (r & 3) + 8 * (r >> 2) + 4 * hi; }
__device__ __forceinline__ unsigned cvtpk(float lo, float hi) { unsigned r; asm volatile("v_cvt_pk_bf16_f32 %0, %1, %2" : "=v"(r) : "v"(lo), "v"(hi)); return r; }
__device__ __forceinline__ void partialSM(f32x16& p0, f32x16& p1, float& m_reg, float& mn, float& alpha, float a, float yl, bool diag, int dlim, int hi) {
    const float NINF = -__builtin_inff();
    const float a3 = 3.f * a, a8 = 8.f * a, a24 = 24.f * a, a32 = 32.f * a;
#pragma unroll
    for (int r = 0; r < 16; ++r) { const int i = r & 3, k = r >> 2; float x = p0[r], z = p1[r];
        if (i == 1) { x += a; z += a; } else if (i == 2) { x = fmaf(a, 2.f, x); z = fmaf(a, 2.f, z); } else if (i == 3) { x += a3; z += a3; }
        if (k == 1) { x += a8; z += a8; } else if (k == 2) { x = fmaf(a8, 2.f, x); z = fmaf(a8, 2.f, z); } else if (k == 3) { x += a24; z += a24; }
        p0[r] = x; p1[r] = z; }
    if (diag) {
#pragma unroll
        for (int r = 0; r < 16; ++r) { const int k0 = (r & 3) + 8 * (r >> 2); p0[r] = (k0 > dlim) ? NINF : p0[r]; p1[r] = (32 + k0 > dlim) ? NINF : p1[r]; }
    }
    float pmax = p0[0], pmax1 = p1[0];
#pragma unroll
    for (int r = 1; r < 16; ++r) { pmax = fmaxf(pmax, p0[r]); pmax1 = fmaxf(pmax1, p1[r]); }
    pmax = fmaxf(pmax, pmax1 + a32) + yl;
    { auto rr = __builtin_amdgcn_permlane32_swap(__float_as_uint(pmax), __float_as_uint(pmax), false, false);
      pmax = fmaxf(__uint_as_float(rr[0]), __uint_as_float(rr[1])); }
    if (__builtin_expect(__all(pmax - m_reg <= THR_RAW), 1)) { mn = m_reg; alpha = 1.f; }
    else { mn = fmaxf(m_reg, pmax); alpha = __builtin_amdgcn_exp2f((m_reg - mn) * C2); m_reg = mn; }
    const float mnC = (yl - mn) * C2, mnC1 = (yl - mn + a32) * C2;
#pragma unroll
    for (int r = 0; r < 16; ++r) { p0[r] = fmaf(p0[r], C2, mnC); p1[r] = fmaf(p1[r], C2, mnC1); }
#pragma unroll
    for (int r = 0; r < 16; ++r) p0[r] = __builtin_amdgcn_exp2f(p0[r]);
}
__device__ __forceinline__ void finishSM(f32x16& p0, f32x16& p1, float alpha, float& l_reg, bf16x8& pa0, bf16x8& pa1, bf16x8& pa2, bf16x8& pa3) {
#pragma unroll
    for (int r = 0; r < 16; ++r) p1[r] = __builtin_amdgcn_exp2f(p1[r]);
    float ps = 0.f;
#pragma unroll
    for (int r = 0; r < 16; ++r) ps += p0[r];
#pragma unroll
    for (int r = 0; r < 16; ++r) ps += p1[r];
    { auto rr = __builtin_amdgcn_permlane32_swap(__float_as_uint(ps), __float_as_uint(ps), false, false);
      ps = __uint_as_float(rr[0]) + __uint_as_float(rr[1]); }
    l_reg = l_reg * alpha + ps;
#define PK4(P, BASE, OUT) do { unsigned a0 = cvtpk(P[BASE + 0], P[BASE + 1]), a1 = cvtpk(P[BASE + 2], P[BASE + 3]);   \
    unsigned b0 = cvtpk(P[BASE + 4], P[BASE + 5]), b1 = cvtpk(P[BASE + 6], P[BASE + 7]);                              \
    auto r0 = __builtin_amdgcn_permlane32_swap(a0, b0, false, false); auto r1 = __builtin_amdgcn_permlane32_swap(a1, b1, false, false); \
    u32x4 w = {r0[0], r1[0], r0[1], r1[1]}; OUT = *reinterpret_cast<bf16x8*>(&w); } while (0)
    PK4(p0, 0, pa0); PK4(p0, 8, pa1); PK4(p1, 0, pa2); PK4(p1, 8, pa3);
#undef PK4
}
__device__ __forceinline__ void qkt(f32x16& p0, f32x16& p1, const LAS char* Ks, const bf16x8* qr, int r32, int hi) {
    p0 = f32x16{}; p1 = f32x16{};
#pragma unroll
    for (int d0 = 0; d0 < 8; ++d0) { const int cb = (d0 * 16 + hi * 8) * 2;
        const bf16x8 b0 = *(const LAS bf16x8*)(Ks + KSWZ(r32, cb));
        const bf16x8 b1 = *(const LAS bf16x8*)(Ks + KSWZ(32 + r32, cb));
        p0 = __builtin_amdgcn_mfma_f32_32x32x16_bf16(b0, qr[d0], p0, 0, 0, 0);
        p1 = __builtin_amdgcn_mfma_f32_32x32x16_bf16(b1, qr[d0], p1, 0, 0, 0); }
}
__device__ __forceinline__ int v_st(int k, int c) { const int kk = (k & ~0xC) | ((k & 4) << 1) | ((k & 8) >> 1); return ((kk >> 3) * 4 + (c >> 5)) * 512 + ((kk & 7) * 32 + (c & 31)) * 2; }
__device__ __forceinline__ int v_rd_base(int lane) { return ((lane & 3) << 3) | (((lane >> 2) & 3) << 6) | (((lane >> 4) & 1) << 5) | (((lane >> 5) & 1) << 8); }
constexpr int v_rd_off(int d0, int ks, int half) { return d0 * 512 + ks * 4096 + half * 2048; }
template <int OFF> __device__ __forceinline__ s16x4 tr_read(int vb) {
    s16x4 r; asm volatile("ds_read_b64_tr_b16 %0, %1 offset:%2" : "=&v"(r) : "v"(vb), "i"(OFF) : "memory"); return r;
}
template <int D0> __device__ __forceinline__ void pv_one(f32x16& od, int vb, bf16x8 pa0, bf16x8 pa1, bf16x8 pa2, bf16x8 pa3) {
    const s16x4 l0 = tr_read<v_rd_off(D0, 0, 0)>(vb), h0 = tr_read<v_rd_off(D0, 0, 1)>(vb), l1 = tr_read<v_rd_off(D0, 1, 0)>(vb), h1 = tr_read<v_rd_off(D0, 1, 1)>(vb);
    const s16x4 l2 = tr_read<v_rd_off(D0, 2, 0)>(vb), h2 = tr_read<v_rd_off(D0, 2, 1)>(vb), l3 = tr_read<v_rd_off(D0, 3, 0)>(vb), h3 = tr_read<v_rd_off(D0, 3, 1)>(vb);
    asm volatile("s_waitcnt lgkmcnt(0)" ::: "memory"); SBAR();
#define PK(L, H) (bf16x8){L[0], L[1], L[2], L[3], H[0], H[1], H[2], H[3]}
    od = __builtin_amdgcn_mfma_f32_32x32x16_bf16(pa0, PK(l0, h0), od, 0, 0, 0);
    od = __builtin_amdgcn_mfma_f32_32x32x16_bf16(pa1, PK(l1, h1), od, 0, 0, 0);
    od = __builtin_amdgcn_mfma_f32_32x32x16_bf16(pa2, PK(l2, h2), od, 0, 0, 0);
    od = __builtin_amdgcn_mfma_f32_32x32x16_bf16(pa3, PK(l3, h3), od, 0, 0, 0);
#undef PK
}
__device__ __forceinline__ void pv_d0(f32x16* o, int vb, bf16x8 pa0, bf16x8 pa1, bf16x8 pa2, bf16x8 pa3) {
    pv_one<0>(o[0], vb, pa0, pa1, pa2, pa3); pv_one<1>(o[1], vb, pa0, pa1, pa2, pa3); pv_one<2>(o[2], vb, pa0, pa1, pa2, pa3); pv_one<3>(o[3], vb, pa0, pa1, pa2, pa3);
}
__device__ __forceinline__ void unit(const bf16* __restrict__ Qb, const bf16* __restrict__ Kh, const bf16* __restrict__ Vh, bf16* __restrict__ Ob,
                                     const float* __restrict__ qn, const float* __restrict__ kmp, int qb, int h, LAS char* lds, int tid_in) {
    int tid = tid_in;
    const int wid = __builtin_amdgcn_readfirstlane(tid >> 6), lane = tid & 63, r32 = lane & 31, hi = lane >> 5;
    LAS char* V_lds = lds; LAS char* K_lds = lds + 2 * SHM_V;
    LAS float* wsf = (LAS float*)(lds + OFF_WS) + wid * 64; LAS float* li_l = wsf; LAS float* al_l = wsf + 32;
    LAS float* KM = (LAS float*)(lds + OFF_KM);
    for (int i = tid; i < 8 * 128; i += 512) { const int n = i >> 7, d = i & 127; const float* p = kmp + (size_t)n * 512 + d; KM[i] = ((p[0] + p[128]) + (p[256] + p[384])) * (1.0f / 256.0f); }
    __syncthreads();
    float m_reg = -1e30f, l_reg = 0.f; bf16x8 qr[8];
    unsigned selmask;
    {
        const bf16* Qw = Qb + (size_t)(wid * 32 + r32) * LD + hi * 8;
        v4u raw[8]; float ss = 0.f;
#pragma unroll
        for (int d0 = 0; d0 < 8; ++d0) { raw[d0] = *(const v4u*)(Qw + d0 * 16);
            const float x0 = bflo(raw[d0].x), x1 = bfhi(raw[d0].x), x2 = bflo(raw[d0].y), x3 = bfhi(raw[d0].y), x4 = bflo(raw[d0].z), x5 = bfhi(raw[d0].z), x6 = bflo(raw[d0].w), x7 = bfhi(raw[d0].w);
            ss += (x0 * x0 + x1 * x1) + (x2 * x2 + x3 * x3) + (x4 * x4 + x5 * x5) + (x6 * x6 + x7 * x7); }
        ss = half_sum(ss);
        const float rinv = rsqrtf(ss * (1.0f / 128.0f) + EPS);
        float gate[8];
#pragma unroll
        for (int n = 0; n < 8; ++n) gate[n] = 0.f;
#pragma unroll
        for (int d0 = 0; d0 < 8; ++d0) { const f32x4 g0 = *(const f32x4*)(qn + d0 * 16 + hi * 8), g1 = *(const f32x4*)(qn + d0 * 16 + hi * 8 + 4);
            const float q0 = bflo(raw[d0].x) * rinv * g0.x, q1 = bfhi(raw[d0].x) * rinv * g0.y, q2 = bflo(raw[d0].y) * rinv * g0.z, q3 = bfhi(raw[d0].y) * rinv * g0.w;
            const float q4 = bflo(raw[d0].z) * rinv * g1.x, q5 = bfhi(raw[d0].z) * rinv * g1.y, q6 = bflo(raw[d0].w) * rinv * g1.z, q7 = bfhi(raw[d0].w) * rinv * g1.w;
            if (qb > 3) {
#pragma unroll
                for (int n = 0; n < 8; ++n) { const f32x4 k0 = *(const LAS f32x4*)(KM + n * 128 + d0 * 16 + hi * 8), k1 = *(const LAS f32x4*)(KM + n * 128 + d0 * 16 + hi * 8 + 4);
                    gate[n] += (q0 * k0.x + q1 * k0.y) + (q2 * k0.z + q3 * k0.w) + (q4 * k1.x + q5 * k1.y) + (q6 * k1.z + q7 * k1.w); } }
            u32x4 w = {cvtpk(q0, q1), cvtpk(q2, q3), cvtpk(q4, q5), cvtpk(q6, q7)};
            qr[d0] = *reinterpret_cast<bf16x8*>(&w); }
        selmask = 0u;
        if (qb <= 3) selmask = (1u << qb) - 1u;
        else {
#pragma unroll
            for (int n = 0; n < 8; ++n) { gate[n] = half_sum(gate[n]); gate[n] = (n < qb) ? gate[n] : -3e38f; }
#pragma unroll
            for (int it = 0; it < 3; ++it) { float best = -3e38f; int bi = 0;
#pragma unroll
                for (int n = 0; n < 8; ++n) { const bool ok = (n < qb) && !((selmask >> n) & 1u); if (ok && gate[n] > best) { best = gate[n]; bi = n; } }
                selmask |= 1u << bi; }
        }
        selmask |= 1u << qb;
    }
    asm volatile("" : "+v"(tid));
    f32x16 o[4] = {};
    float a = exp2f(-0.5f * (float)(h + 1)) * (1.0f / SCALE);
    asm volatile("" : "+v"(a));
    const float NINF = -__builtin_inff();
    const int trow = wid * 32 + r32;
#define TILE_PARAMS(j, yl, dg, dl) do { const int n_ = (j) >> 2, jj_ = (j) & 3; const float yb_ = a * (float)(64 * (j) - 256 * qb + 4 * hi); \
        if (n_ < qb) { yl = ((selmask >> n_) & 1u) ? yb_ : NINF; dg = false; dl = 0; } \
        else if (64 * jj_ + 63 <= 32 * wid) { yl = yb_; dg = false; dl = 0; } \
        else if (64 * jj_ > 32 * wid + 31) { yl = NINF; dg = false; dl = 0; } \
        else { yl = yb_; dg = true; dl = trow - 64 * jj_ - 4 * hi; } } while (0)
    const int sr = tid >> 4, sc = (tid & 15) * 8, vst0 = v_st(sr, sc), vst1 = v_st(32 + sr, sc);
    const int vb0 = (int)(uintptr_t)V_lds + v_rd_base(tid & 63);
    const unsigned goff0 = (unsigned)(sr * LD + sc) * 2u, goff1 = goff0 + 32u * LD * 2u;
    struct { bf16x8 vs0, vs1, ks0, ks1; } sr_[1];
#define SLOAD(i, k0) do { const char* vt_ = (const char*)Vh + (size_t)(k0) * (LD * 2); const char* kt_ = (const char*)Kh + (size_t)(k0) * (LD * 2); \
    sr_[i].vs0 = *(const bf16x8*)(vt_ + goff0); sr_[i].vs1 = *(const bf16x8*)(vt_ + goff1); sr_[i].ks0 = *(const bf16x8*)(kt_ + goff0); sr_[i].ks1 = *(const bf16x8*)(kt_ + goff1); } while (0)
#define SWRITE(b, i) do { *(LAS bf16x8*)(V_lds + (b) * SHM_V + vst0) = sr_[i].vs0;          \
    *(LAS bf16x8*)(V_lds + (b) * SHM_V + vst1) = sr_[i].vs1; const int kc = sc * 2;               \
    *(LAS bf16x8*)(K_lds + (b) * SHM_K + KSWZ(sr, kc)) = sr_[i].ks0;                       \
    *(LAS bf16x8*)(K_lds + (b) * SHM_K + KSWZ(32 + sr, kc)) = sr_[i].ks1; } while (0)
#define SWAIT() asm volatile("s_waitcnt vmcnt(0)" ::: "memory")
#define RESC(al) do { if (__any((al) < 1.f)) { if (hi == 0) al_l[r32] = (al); asm volatile("s_waitcnt lgkmcnt(0)" ::: "memory"); \
    _Pragma("unroll") for (int d = 0; d < 4; ++d) _Pragma("unroll") for (int r = 0; r < 16; ++r) o[d][r] *= al_l[crow(r, hi)]; } } while (0)
    f32x16 pA0, pA1, pB0, pB1; float mnA, mnB, alA, alB; bf16x8 pa0, pa1, pa2, pa3; const int NT = 4 * (qb + 1);
    float yl; bool dg; int dl;
    constexpr int SE = 0, SO = 0;
    SLOAD(SE, 0); asm volatile("s_waitcnt vmcnt(0)" ::: "memory"); SWRITE(0, SE); __syncthreads();
    qkt(pA0, pA1, K_lds, qr, r32, hi); TILE_PARAMS(0, yl, dg, dl); partialSM(pA0, pA1, m_reg, mnA, alA, a, yl, dg, dl, hi);
    SLOAD(SO, 64);
    SWAIT(); SWRITE(1, SO); __syncthreads();
    for (int j = 1; j + 1 < NT; j += 2) {
        SBAR(); qkt(pB0, pB1, K_lds + SHM_K, qr, r32, hi);
        finishSM(pA0, pA1, alA, l_reg, pa0, pa1, pa2, pa3); SBAR();
        SLOAD(SO, (j + 1) * 64); SBAR();
        pv_d0(o, vb0, pa0, pa1, pa2, pa3); TILE_PARAMS(j, yl, dg, dl); partialSM(pB0, pB1, m_reg, mnB, alB, a, yl, dg, dl, hi);
        __syncthreads(); SWAIT(); SWRITE(0, SE);
        RESC(alB); __syncthreads();
        SBAR(); qkt(pA0, pA1, K_lds, qr, r32, hi);
        finishSM(pB0, pB1, alB, l_reg, pa0, pa1, pa2, pa3); SBAR();
        SLOAD(SE, (j + 2) * 64); SBAR();
        pv_d0(o, vb0 + (int)SHM_V, pa0, pa1, pa2, pa3); TILE_PARAMS(j + 1, yl, dg, dl); partialSM(pA0, pA1, m_reg, mnA, alA, a, yl, dg, dl, hi);
        __syncthreads(); SWAIT(); SWRITE(1, SO);
        RESC(alA); __syncthreads();
    }
    SBAR(); qkt(pB0, pB1, K_lds + SHM_K, qr, r32, hi);
    finishSM(pA0, pA1, alA, l_reg, pa0, pa1, pa2, pa3); SBAR();
    pv_d0(o, vb0, pa0, pa1, pa2, pa3); TILE_PARAMS(NT - 1, yl, dg, dl); partialSM(pB0, pB1, m_reg, mnB, alB, a, yl, dg, dl, hi);
    __syncthreads(); RESC(alB);
    finishSM(pB0, pB1, alB, l_reg, pa0, pa1, pa2, pa3); SBAR();
    pv_d0(o, vb0 + (int)SHM_V, pa0, pa1, pa2, pa3);
    if (hi == 0) li_l[r32] = l_reg; asm volatile("s_waitcnt lgkmcnt(0)" ::: "memory");
    asm volatile("" : "+v"(tid));
    float rli[16];
#pragma unroll
    for (int r = 0; r < 16; ++r) rli[r] = __builtin_amdgcn_rcpf(li_l[crow(r, hi)]);
    { const int hi2 = (tid >> 5) & 1; bf16* Ow = Ob + (size_t)(wid * 32) * LD + (tid & 31);
#pragma unroll
    for (int r = 0; r < 16; ++r) { const int orow = crow(r, hi2);
#pragma unroll
        for (int d0 = 0; d0 < 4; ++d0) Ow[(size_t)orow * LD + d0 * 32] = (bf16)f2bf(o[d0][r] * rli[r]); } }
    __syncthreads();
#undef SLOAD
#undef SWRITE
#undef SWAIT
#undef RESC
#undef TILE_PARAMS
}
#undef KSWZ
#undef SBAR
}

__device__ __forceinline__ void kvnorm_item(int item, const bf16* KRAW, const float* k_norm, bf16* KNB, float* KMP, int lane) {
    const int part = item & 3, n = (item >> 2) & 7, h = (item >> 5) & 15, b = item >> 9;
    const int tk = lane >> 4, c8 = (lane & 15) * 8;
    const f32x4 g0 = *(const f32x4*)(k_norm + c8), g1 = *(const f32x4*)(k_norm + c8 + 4);
    float acc[8];
#pragma unroll
    for (int i = 0; i < 8; ++i) acc[i] = 0.f;
    for (int it = 0; it < 16; ++it) {
        const size_t off = ((size_t)b * S + n * BLK + part * 64 + it * 4 + tk) * D + h * DH + c8;
        const v4u raw = *(const v4u*)(KRAW + off);
        float v[8] = {bflo(raw.x), bfhi(raw.x), bflo(raw.y), bfhi(raw.y), bflo(raw.z), bfhi(raw.z), bflo(raw.w), bfhi(raw.w)};
        float ss = 0.f;
#pragma unroll
        for (int i = 0; i < 8; ++i) ss = fmaf(v[i], v[i], ss);
        ss = sum16(ss);
        const float r = rsqrtf(ss * (1.0f / DH) + EPS);
        v[0] *= r * g0.x; v[1] *= r * g0.y; v[2] *= r * g0.z; v[3] *= r * g0.w; v[4] *= r * g1.x; v[5] *= r * g1.y; v[6] *= r * g1.z; v[7] *= r * g1.w;
#pragma unroll
        for (int i = 0; i < 8; ++i) acc[i] += v[i];
        v4u o; o.x = pk2(v[0], v[1]); o.y = pk2(v[2], v[3]); o.z = pk2(v[4], v[5]); o.w = pk2(v[6], v[7]);
        *(v4u*)(KNB + off) = o;
    }
#pragma unroll
    for (int i = 0; i < 8; ++i) { acc[i] += swz_xor<16>(acc[i]); acc[i] = half_sum(acc[i]); }
    if (lane < 16) { float* p = KMP + (size_t)item * 128 + c8; *(f32x4*)p = (f32x4){acc[0], acc[1], acc[2], acc[3]}; *(f32x4*)(p + 4) = (f32x4){acc[4], acc[5], acc[6], acc[7]}; }
}

__global__ void __launch_bounds__(NWAVES * 64, 2) fwd(Args args) {
    extern __shared__ __attribute__((aligned(16))) unsigned char lds_raw[];
    LAS unsigned char* lds = (LAS unsigned char*)lds_raw;
    volatile LAS unsigned* MISC = (volatile LAS unsigned*)(lds + MISC_OFF);
    const int tid0 = threadIdx.x, wave = __builtin_amdgcn_readfirstlane(tid0 >> 6);
    const int G = gridDim.x;
    unsigned char* ws = args.ws;
    gu32* ctl = (gu32*)(ws + WS_CTL);
    for (int u = tid0; u < (LDS_BYTES - LDSCTL_OFF) / 4; u += NWAVES * 64) ((LAS unsigned*)(lds + LDSCTL_OFF))[u] = 0u;
    __syncthreads();
    XcdBarrier bar = xcd_barrier_post((unsigned*)(ctl + CW_BAR) + args.li * XCD_BAR_WORDS, MISC + 8);

#define WT   ((bf16*)(wsp + WS_WT))
#define HB   ((bf16*)(wsp + WS_XN))
#define PSUM ((float*)(wsp + WS_OF + 2 * MiB))
#define RSL  ((LAS float*)(lds + LDSCTL_OFF + 1024))
#define QS   ((bf16*)(wsp + WS_QS))
#define KS   ((bf16*)(wsp + WS_KS))
#define VS   ((bf16*)(wsp + WS_VS))
#define GT   ((bf16*)(wsp + WS_GT))
#define GS   ((float*)(wsp + WS_GS))
#define OG   ((bf16*)(wsp + WS_OG))
#define U    ((bf16*)(wsp + WS_U))
#define KRAW ((bf16*)(wsp + WS_KRAW))
#define VV   ((bf16*)(wsp + WS_VV))
#define QRAW ((bf16*)(wsp + WS_QRAW))
#define LBS  ((float*)(wsp + WS_SMALL + SM_LBS))
#define KNORMC ((float*)(wsp + WS_SMALL + SM_KNORM))
#define QNORMC ((float*)(wsp + WS_SMALL + SM_QNORM))
#define KNB  ((bf16*)(wsp + WS_KN))
#define KMP  ((float*)(wsp + WS_OF))
    float* hres = args.out;
    const int lo = args.ph_lo, hi = args.ph_hi;
    const int NGW = G * NWAVES;
    bool any = false;
#define PHASE_BEGIN(p) if (lo <= (p) && (p) < hi) { if (any) xcd_barrier(bar); any = true; GAS unsigned char* wsp = (GAS unsigned char*)args.ws; asm volatile("" : "+s"(wsp)); int bx = blockIdx.x; asm volatile("" : "+s"(bx)); (void)bx; int tz_ = threadIdx.x; asm volatile("" : "+v"(tz_)); const int tid = tz_, lane = tz_ & 63; (void)tid; (void)lane;
#define PHASE_END() }

    PHASE_BEGIN(0)
        {
            const int d = bx * (NWAVES * 64) + tid;
            if (d < D) { const float a = in_ptr(I_LB)[d], b = in_ptr(I_LB)[D + d], mx = fmaxf(a, b), ea = expf(a - mx), eb = expf(b - mx), sm = ea + eb, p0 = ea / sm, p1 = eb / sm;
                LBS[d] = 0.f; LBS[D + d] = (p0 + p1) - p0; }
            if (d < 128) KNORMC[d] = in_ptr(I_KNORM)[d];
            if (d < 256) QNORMC[d] = in_ptr(I_BQNORM)[d];
        }
        for (int m = bx * NWAVES + wave; m < M; m += NGW) intake_row(in_ptr(I_X) + (size_t)m * D, HB + (size_t)m * D, PSUM + (size_t)m * 32, lane);
        {
            LAS float* scr = (LAS float*)(lds + RING_OFF + wave * 16384);
            convert_weights(WT, 0, 1, bx * NWAVES + wave, NGW, scr, lane);
        }
    PHASE_END()

    for (int l = 0; l < 4; ++l) {
        const int pb = 1 + 9 * l;
        if (l < 2) {
            PHASE_BEGIN(pb + 1)
                pg8::Gemm g = pg8::gemm_rowmajor(HB, WT + WE_WIN + (size_t)l * D * 4 * D, M, 4 * D, D); pg8::StaticOrder So; So.init(M, 4 * D, G, bx);
                pg8::EpiHgrn E{QS, (size_t)(WS_KS - WS_QS) / 2, GS, LBS + l * D, RSL}; pg8::row_scale_table(PSUM, RSL, So, tid);
                pg8::gemm_phase<pg8::EpiHgrn, pg8::StaticOrder, true, true>(lds + RING_OFF, g, So, E);
            PHASE_END()
        } else {
            PHASE_BEGIN(pb + 1)
                const bool first = (l == 2);
                pg8::Gemm g = pg8::gemm_rowmajor(HB, first ? WT + WE_KVQ : WT + WE_Q1, M, first ? 3 * D : D, D); pg8::StaticOrder So; So.init(M, first ? 3 * D : D, G, bx);
                pg8::EpiSplit E{KRAW, (size_t)(WS_VV - WS_KRAW) / 2, first ? 0 : 2, RSL}; pg8::row_scale_table(PSUM, RSL, So, tid);
                pg8::gemm_phase<pg8::EpiSplit, pg8::StaticOrder, true, true>(lds + RING_OFF, g, So, E);
            PHASE_END()
        }
        if (l < 2) {
            PHASE_BEGIN(pb + 2)
                if (bx < NB * H) gla_seq(bx, QS, KS, VS, GS, GT, OG, lds + RING_OFF, tid);
                else if (G > NB * H) convert_weights(WT, l == 0 ? 1 : 8, l == 0 ? 8 : 17, (bx - NB * H) * NWAVES + wave, (G - NB * H) * NWAVES, (LAS float*)(lds + RING_OFF + wave * 16384), lane);
            PHASE_END()
        } else {
            if (l == 2) {
                PHASE_BEGIN(pb + 2)
                    for (int it = bx * NWAVES + wave; it < NB * H * NBLK * 4; it += NGW) kvnorm_item(it, KRAW, KNORMC, KNB, KMP, lane);
                PHASE_END()
            }
            PHASE_BEGIN(pb + 4)
                for (int pi = bx; pi < 256; pi += G) {
                    const int bh = pi & 63, pr = pi >> 6, b = bh >> 4, h = bh & 15;
                    for (int u = 0; u < 2; ++u) {
                        const int qb = u == 0 ? 7 - pr : pr;
                        const size_t qoff = ((size_t)b * S + 256 * qb) * D + h * DH, koff = (size_t)b * S * D + h * DH;
                        moba::unit(QRAW + qoff, KNB + koff, VV + koff, OG + qoff, QNORMC + (size_t)(l - 2) * DH, KMP + (size_t)bh * 4096, qb, h, (LAS char*)(lds + RING_OFF), tid);
                    }
                }
            PHASE_END()
        }
        PHASE_BEGIN(pb + 5)
            pg8::Gemm g = pg8::gemm_rowmajor(OG, l < 2 ? WT + WE_WOUT + (size_t)l * D * D : WT + WE_WO + (size_t)(l - 2) * D * D, M, D, D); pg8::StaticOrder So; So.init(M, D, G, bx);
            pg8::EpiRes<false> E{HB, PSUM, nullptr, D};
            pg8::gemm_phase<pg8::EpiRes<false>, pg8::StaticOrder, true, true>(lds + RING_OFF, g, So, E);
        PHASE_END()
        PHASE_BEGIN(pb + 7)
            pg8::Gemm g = pg8::gemm_rowmajor(HB, WT + WE_W1 + (size_t)l * D * FF, M, FF, D); pg8::StaticOrder So; So.init(M, FF, G, bx);
            pg8::EpiRelu2 E{U, FF, RSL}; pg8::row_scale_table(PSUM, RSL, So, tid);
            pg8::gemm_phase<pg8::EpiRelu2, pg8::StaticOrder, true, true>(lds + RING_OFF, g, So, E);
        PHASE_END()
        PHASE_BEGIN(pb + 8)
            pg8::Gemm g{U, WT + WE_W2 + (size_t)l * FF * D, M, D, FF, 64, 64, 32768, 32768, (size_t)(FF / 64) * 32768, (size_t)(FF / 64) * 32768};     pg8::StaticOrder So; So.init(M, D, G, bx);
            if (l == 3) { pg8::EpiRes<true> E{HB, PSUM, hres, D}; pg8::gemm_phase<pg8::EpiRes<true>, pg8::StaticOrder, true, true>(lds + RING_OFF, g, So, E); }
            else { pg8::EpiRes<false> E{HB, PSUM, nullptr, D}; pg8::gemm_phase<pg8::EpiRes<false>, pg8::StaticOrder, true, true>(lds + RING_OFF, g, So, E); }
        PHASE_END()
    }
#undef PHASE_BEGIN
#undef PHASE_END
#undef WT
#undef HB
#undef PSUM
#undef RSL
#undef QS
#undef KS
#undef VS
#undef GT
#undef GS
#undef OG
#undef U
#undef KRAW
#undef VV
#undef QRAW
#undef LBS
#undef KNORMC
#undef QNORMC
#undef KNB
#undef KMP
}

extern "C" void kernel_launch(void* const* d_in, const int* in_sizes, int n_in, void* d_out, int out_size, void* d_ws, size_t ws_size, hipStream_t stream) {
    static int grid = 0;
    if (grid == 0) {
        if (n_in != 16 || out_size != M * D || ws_size < WS_END) { fprintf(stderr, "kernel_launch: unexpected sizes (n_in %d, out %d, ws %zu < %zu); nothing launched\n", n_in, out_size, ws_size, (size_t)WS_END); grid = -1; return; }
        int dev = 0, cus = 0, per_cu = 0;
        if (hipGetDevice(&dev) != hipSuccess || hipDeviceGetAttribute(&cus, hipDeviceAttributeMultiprocessorCount, dev) != hipSuccess) { grid = -1; return; }
        if (hipFuncSetAttribute((const void*)fwd, hipFuncAttributeMaxDynamicSharedMemorySize, LDS_BYTES) != hipSuccess) { fprintf(stderr, "kernel_launch: hipFuncSetAttribute failed\n"); grid = -1; return; }
        if (hipOccupancyMaxActiveBlocksPerMultiprocessor(&per_cu, (const void*)fwd, NWAVES * 64, LDS_BYTES) != hipSuccess || per_cu < 1) { fprintf(stderr, "kernel_launch: occupancy query says %d blocks per CU\n", per_cu); }
        (void)hipGetLastError();
        grid = cus;
    }
    if (grid < 0) return;
    if (hipMemsetAsync((char*)d_ws + WS_CTL, 0, CTL_ZERO_BYTES, stream) != hipSuccess) return;
    Args a{};
    for (int i = 0; i < 16; ++i) a.in[i] = (const float*)d_in[i];
    a.out = (float*)d_out; a.ws = (unsigned char*)d_ws;
    a.ph_lo = 0; a.ph_hi = 37; a.li = 0;
    hipLaunchKernelGGL(fwd, dim3(grid), dim3(NWAVES * 64), LDS_BYTES, stream, a);
}
```

```cpp
#include <hip/hip_runtime.h>
#include <cstdio>
#include <cstdint>

template <int K> __device__ __forceinline__ float swz_xor(float v) { return __builtin_bit_cast(float, __builtin_amdgcn_ds_swizzle(__builtin_bit_cast(int, v), (K << 10) | 0x1f)); }
__device__ __forceinline__ float half_sum(float v) { auto rr = __builtin_amdgcn_permlane32_swap(__float_as_uint(v), __float_as_uint(v), false, false); const unsigned r0 = rr[0], r1 = rr[1]; return __uint_as_float(r0) + __uint_as_float(r1); }
__device__ __forceinline__ float sum16(float v) { v += swz_xor<1>(v); v += swz_xor<2>(v); v += swz_xor<4>(v); v += swz_xor<8>(v); return v; }
__device__ __forceinline__ float wave_sum(float v) { v = sum16(v); v += swz_xor<16>(v); return half_sum(v); }

namespace pg8 {
#define PG8_LAS __attribute__((address_space(3)))
typedef unsigned short bf16_t;
typedef short bf16x8 __attribute__((ext_vector_type(8)));
typedef float f32x4 __attribute__((ext_vector_type(4)));
typedef unsigned u32x4 __attribute__((ext_vector_type(4)));
constexpr int BM = 256, BK = 64, HALF = 128, HTB = HALF * BK * 2  , STAGE_BYTES = 8 * HTB, NXCD = 8, WGM = 8;

__host__ __device__ __forceinline__ int lds_byte(int r, int c) { const int st = (r >> 4) * 2 + (c >> 5), rr = r & 15, cc = c & 31, ob = rr * 64 + cc * 2; return st * 1024 + (ob ^ (((ob >> 9) & 1) << 5)); }
__host__ __device__ __forceinline__ void stage_rc(int b, int& R, int& C) { const int st = b / 1024, sb = b % 1024, swz = sb ^ (((sb >> 9) & 1) << 5); R = (st >> 1) * 16 + swz / 64; C = (st & 1) * 32 + (swz % 64) / 2; }
__host__ __device__ __forceinline__ int perm32(int rho) { const int n = rho >> 4, i = rho & 15; return 8 * (i >> 2) + 4 * n + (i & 3); }

struct Unit { int pm, pn, ord; };
struct Gemm { const bf16_t* A; const bf16_t* Bt; int M, N, K, lda, ldb; size_t ksa, ksb, tsa, tsb; };
__host__ __device__ inline Gemm gemm_rowmajor(const bf16_t* A, const bf16_t* Bt, int M, int N, int K) { return Gemm{A, Bt, M, N, K, K, K, 128, 128, (size_t)256 * K * 2, (size_t)256 * K * 2}; }

struct StaticOrder {
    int nM, nN, nwg, G, c;
    __host__ __device__ void init(int M, int N, int G_, int c_) { nM = M / BM; nN = N / BM; nwg = nM * nN; G = G_; c = c_; }
    __host__ __device__ bool next(int i, Unit& u) const {
        const long L = (long)i * G + c; if (L >= nwg) return false;
        int wgid = (int)L; { const int q = nwg / NXCD, r = nwg % NXCD, xcd = wgid % NXCD, off = wgid / NXCD; wgid = (xcd < r ? xcd * (q + 1) : r * (q + 1) + (xcd - r) * q) + off; }
        const int nig = WGM * nN, gid = wgid / nig, fm = gid * WGM, gsz = (nM - fm) < WGM ? (nM - fm) : WGM;
        u.pm = fm + ((wgid % nig) % gsz); u.pn = (wgid % nig) / gsz; u.ord = i; return true;
    }
    __device__ __forceinline__ void a_ready(const Unit&) const {}
    __device__ __forceinline__ void done(const Unit&) const {}
};

__device__ __forceinline__ unsigned cvt_pk_bf16(float lo, float hi) { unsigned r; asm("v_cvt_pk_bf16_f32 %0, %1, %2" : "=v"(r) : "v"(lo), "v"(hi)); return r; }
typedef float f32x2 __attribute__((ext_vector_type(2)));
template <class Sched> __device__ __forceinline__ void row_scale_table(const float* PS, PG8_LAS float* RS, const Sched& So, int tid) {
#pragma unroll
    for (int pass = 0; pass < 4; ++pass) { Unit uu; const int i = 2 * pass + (tid >> 8);
        if (So.next(i, uu)) { const f32x4* p = (const f32x4*)(PS + (size_t)(uu.pm * BM + (tid & 255)) * 32); f32x4 a = p[0];
#pragma unroll
            for (int k = 1; k < 8; ++k) a = a + p[k];
            RS[i * 256 + (tid & 255)] = rsqrtf(((a[0] + a[1]) + (a[2] + a[3])) * (1.0f / 2048.0f) + 1e-6f); } }
    asm volatile("s_waitcnt vmcnt(0) lgkmcnt(0)" ::: "memory"); __builtin_amdgcn_s_barrier(); asm volatile("" ::: "memory");
}
template <bool LAST>
struct EpiRes {
    static constexpr bool PERM = true, AFTER_DRAIN = false;
    bf16_t* HB; float* PS; float* Fout; int ldc;
    __device__ __forceinline__ void operator()(const f32x4 (&acc)[2][2][4][2], const Unit& u, int wr, int wc, int fr, int fq) const {
        const int row0 = u.pm * BM + wr * 64 + fr, col0 = u.pn * BM + wc * 64 + 8 * fq;
        u32x4 hv[2][4][2];
#pragma unroll
        for (int ai = 0; ai < 2; ++ai)
#pragma unroll
            for (int m = 0; m < 4; ++m)
#pragma unroll
                for (int bj = 0; bj < 2; ++bj) hv[ai][m][bj] = *(const u32x4*)(HB + (size_t)(row0 + ai * HALF + m * 16) * ldc + col0 + bj * 32);
#pragma unroll
        for (int ai = 0; ai < 2; ++ai)
#pragma unroll
            for (int m = 0; m < 4; ++m) { const int row = row0 + ai * HALF + m * 16; float ss = 0.f;
#pragma unroll
                for (int bj = 0; bj < 2; ++bj) { const u32x4 r = hv[ai][m][bj]; const size_t off = (size_t)row * ldc + col0 + bj * 32;
                    const f32x4 h0 = (f32x4){__builtin_bit_cast(float, r.x << 16), __builtin_bit_cast(float, r.x & 0xffff0000u), __builtin_bit_cast(float, r.y << 16), __builtin_bit_cast(float, r.y & 0xffff0000u)} + acc[ai][bj][m][0];
                    const f32x4 h1 = (f32x4){__builtin_bit_cast(float, r.z << 16), __builtin_bit_cast(float, r.z & 0xffff0000u), __builtin_bit_cast(float, r.w << 16), __builtin_bit_cast(float, r.w & 0xffff0000u)} + acc[ai][bj][m][1];
                    if constexpr (LAST) { *(f32x4*)(Fout + off) = h0; *(f32x4*)(Fout + off + 4) = h1; }
                    else { ss += ((h0[0] * h0[0] + h0[1] * h0[1]) + (h0[2] * h0[2] + h0[3] * h0[3])) + ((h1[0] * h1[0] + h1[1] * h1[1]) + (h1[2] * h1[2] + h1[3] * h1[3]));
                        u32x4 w; w.x = cvt_pk_bf16(h0[0], h0[1]); w.y = cvt_pk_bf16(h0[2], h0[3]); w.z = cvt_pk_bf16(h1[0], h1[1]); w.w = cvt_pk_bf16(h1[2], h1[3]);
                        *(u32x4*)(HB + off) = w; } }
                if constexpr (!LAST) { ss += swz_xor<16>(ss); ss = half_sum(ss);
                    if (fq == 0) PS[(size_t)row * 32 + u.pn * 4 + wc] = ss; } }
    }
};
struct EpiRelu2 {
    static constexpr bool PERM = true, AFTER_DRAIN = false;
    bf16_t* O; int ncols; PG8_LAS float* RS;
    __device__ __forceinline__ void operator()(const f32x4 (&acc)[2][2][4][2], const Unit& u, int wr, int wc, int fr, int fq) const {
        bf16_t* tile = O + ((size_t)(u.pm * (ncols / 64) + u.pn * 4 + wc) * 256 + wr * 64 + fr) * 64 + 8 * fq;
#pragma unroll
        for (int ai = 0; ai < 2; ++ai)
#pragma unroll
            for (int m = 0; m < 4; ++m) { bf16_t* rowp = tile + (ai * HALF + m * 16) * 64; const float rs = RS[u.ord * 256 + ai * HALF + wr * 64 + m * 16 + fr], rs2 = rs * rs;
#pragma unroll
                for (int bj = 0; bj < 2; ++bj) { f32x4 v0 = acc[ai][bj][m][0], v1 = acc[ai][bj][m][1];
#pragma unroll
                    for (int j = 0; j < 4; ++j) { const float a = __builtin_amdgcn_fmed3f(v0[j], 0.f, 3.0e38f), b = __builtin_amdgcn_fmed3f(v1[j], 0.f, 3.0e38f); v0[j] = (a * a) * rs2; v1[j] = (b * b) * rs2; }
                    u32x4 w; w.x = cvt_pk_bf16(v0[0], v0[1]); w.y = cvt_pk_bf16(v0[2], v0[3]); w.z = cvt_pk_bf16(v1[0], v1[1]); w.w = cvt_pk_bf16(v1[2], v1[3]);
                    *(u32x4*)(rowp + bj * 32) = w; } }
    }
};
struct EpiSplit {
    static constexpr bool PERM = true, AFTER_DRAIN = false;
    bf16_t* O0; size_t gstride; int g0; PG8_LAS float* RS;
    __device__ __forceinline__ void operator()(const f32x4 (&acc)[2][2][4][2], const Unit& u, int wr, int wc, int fr, int fq) const {
        const int g = g0 + (u.pn >> 3); bf16_t* base = O0 + (size_t)g * gstride;
        const int row0 = u.pm * BM + wr * 64 + fr, col0 = (u.pn & 7) * BM + wc * 64 + 8 * fq;
#pragma unroll
        for (int ai = 0; ai < 2; ++ai)
#pragma unroll
            for (int m = 0; m < 4; ++m) { bf16_t* rowp = base + (size_t)(row0 + ai * HALF + m * 16) * 2048 + col0; const float rs = RS[u.ord * 256 + ai * HALF + wr * 64 + m * 16 + fr];
#pragma unroll
                for (int bj = 0; bj < 2; ++bj) { const f32x4 v0 = acc[ai][bj][m][0] * rs, v1 = acc[ai][bj][m][1] * rs;
                    u32x4 w; w.x = cvt_pk_bf16(v0[0], v0[1]); w.y = cvt_pk_bf16(v0[2], v0[3]); w.z = cvt_pk_bf16(v1[0], v1[1]); w.w = cvt_pk_bf16(v1[2], v1[3]);
                    *(u32x4*)(rowp + bj * 32) = w; } }
    }
};
struct EpiHgrn {
    static constexpr bool PERM = true, AFTER_DRAIN = false;
    bf16_t* Qs; size_t qstride; float* Gs; const float* lb; PG8_LAS float* RS;
    __device__ __forceinline__ void operator()(const f32x4 (&acc)[2][2][4][2], const Unit& u, int wr, int wc, int fr, int fq) const {
        const int quarter = u.pn >> 3;
        const int row0 = u.pm * BM + wr * 64 + fr, col0 = (u.pn & 7) * BM + wc * 64 + 8 * fq;
        if (quarter == 1) {
            f32x4 lbv[2][2];
#pragma unroll
            for (int bj = 0; bj < 2; ++bj)
#pragma unroll
                for (int n = 0; n < 2; ++n) lbv[bj][n] = *(const f32x4*)(lb + col0 + bj * 32 + 4 * n);
#pragma unroll
            for (int ai = 0; ai < 2; ++ai)
#pragma unroll
                for (int m = 0; m < 4; ++m) { const size_t ro = (size_t)(row0 + ai * HALF + m * 16) * 2048 + col0; const float rs = RS[u.ord * 256 + ai * HALF + wr * 64 + m * 16 + fr];
#pragma unroll
                    for (int bj = 0; bj < 2; ++bj) { f32x4 lf[2];
#pragma unroll
                        for (int n = 0; n < 2; ++n)
#pragma unroll
                            for (int j = 0; j < 4; ++j) { const float x = fmaxf(acc[ai][bj][m][n][j] * rs, -80.f), e = __expf(-x), r = __builtin_amdgcn_rcpf(1.f + e);
                                const float l0 = lbv[bj][n][j], om = 1.f - l0; lf[n][j] = __log2f(fmaf(om, r, l0)); }
                        *(f32x4*)(Gs + ro + bj * 32) = lf[0]; *(f32x4*)(Gs + ro + bj * 32 + 4) = lf[1]; } }
        } else {
            bf16_t* base = Qs + (size_t)quarter * qstride;
            const bool act = quarter != 2;
#pragma unroll
            for (int ai = 0; ai < 2; ++ai)
#pragma unroll
                for (int m = 0; m < 4; ++m) { bf16_t* rowp = base + (size_t)(row0 + ai * HALF + m * 16) * 2048 + col0; const float rs = RS[u.ord * 256 + ai * HALF + wr * 64 + m * 16 + fr];
#pragma unroll
                    for (int bj = 0; bj < 2; ++bj) { f32x4 v0 = acc[ai][bj][m][0] * rs, v1 = acc[ai][bj][m][1] * rs;
                        if (act) {
#pragma unroll
                            for (int j = 0; j < 4; ++j) { const float a = fmaxf(v0[j], -80.f), b = fmaxf(v1[j], -80.f);
                                v0[j] = a * __builtin_amdgcn_rcpf(1.f + __expf(-a)); v1[j] = b * __builtin_amdgcn_rcpf(1.f + __expf(-b)); } }
                        u32x4 w; w.x = cvt_pk_bf16(v0[0], v0[1]); w.y = cvt_pk_bf16(v0[2], v0[3]); w.z = cvt_pk_bf16(v1[0], v1[1]); w.w = cvt_pk_bf16(v1[2], v1[3]);
                        *(u32x4*)(rowp + bj * 32) = w; } }
        }
    }
};


template <class Epi, class Sched, bool ALIGN_EPI = false, bool SP2 = false>
__device__ __forceinline__ void gemm_phase(PG8_LAS unsigned char* lds, const Gemm g, const Sched& S, const Epi& E) {
    int tid_ = threadIdx.x; asm volatile("" : "+v"(tid_));
    const int tid = tid_, wid = __builtin_amdgcn_readfirstlane(tid >> 6), lane = tid & 63, wr = wid >> 2, wc = wid & 3, fr = lane & 15, fq = lane >> 4;
    const int K = g.K, nt = K / BK;
    unsigned voffA[2], voffB[2];
#pragma unroll
    for (int i = 0; i < 2; ++i) { int R, C; stage_rc(tid * 16 + i * 8192, R, C); const int Rb = Epi::PERM ? (2 * (R & ~31) + perm32(R & 31)) : R;
        voffA[i] = (unsigned)(R * g.lda + C) * 2u; voffB[i] = (unsigned)(Rb * g.ldb + C) * 2u; }
    const size_t kstepA = g.ksa, kstepB = g.ksb;
    const size_t hstepA = (size_t)HALF * g.lda * 2, hstepB = (size_t)(Epi::PERM ? 32 : HALF) * g.ldb * 2;
    const size_t tstepA = g.tsa, tstepB = g.tsb;
    const unsigned ldsw = (unsigned)wid * 1024u;
    const int aoff = lds_byte(wr * 64 + fr, fq * 8), boff = lds_byte(wc * 32 + fr, fq * 8);
#define PG8_SA(b, h) (((b) * 2 + (h)) * HTB)
#define PG8_SB(b, h) ((4 + (b) * 2 + (h)) * HTB)
#define PG8_STAGE(bufoff, gbase, voff) do { _Pragma("unroll") for (int _i = 0; _i < 2; ++_i) \
        __builtin_amdgcn_global_load_lds((const unsigned*)((const char*)(gbase) + (voff)[_i]), (PG8_LAS unsigned*)(lds + (bufoff) + ldsw + _i * 8192), 16, 0, 0); } while (0)
#define PG8_LDA(dst, b, h) do { _Pragma("unroll") for (int m = 0; m < 4; ++m) _Pragma("unroll") for (int k = 0; k < 2; ++k) dst[m][k] = *(const PG8_LAS bf16x8*)(lds + PG8_SA(b, h) + aoff + m * 2048 + k * 1024); } while (0)
#define PG8_LDB(dst, b, h) do { _Pragma("unroll") for (int n = 0; n < 2; ++n) _Pragma("unroll") for (int k = 0; k < 2; ++k) dst[n][k] = *(const PG8_LAS bf16x8*)(lds + PG8_SB(b, h) + boff + n * 2048 + k * 1024); } while (0)
#define PG8_MMA(ai, bj, At, Bt) do { __builtin_amdgcn_s_setprio(1); _Pragma("unroll") for (int m = 0; m < 4; ++m) _Pragma("unroll") for (int n = 0; n < 2; ++n) _Pragma("unroll") for (int k = 0; k < 2; ++k) \
        acc[ai][bj][m][n] = __builtin_amdgcn_mfma_f32_16x16x32_bf16(Bt[n][k], At[m][k], acc[ai][bj][m][n], 0, 0, 0); __builtin_amdgcn_s_setprio(0); } while (0)
#define PG8_WAIT_V(n) asm volatile("s_waitcnt vmcnt(" #n ")" ::: "memory")
#define PG8_WAIT_L(n) asm volatile("s_waitcnt lgkmcnt(" #n ")" ::: "memory")
#define PG8_BAR __builtin_amdgcn_s_barrier()
#define PG8_SCHED __builtin_amdgcn_sched_barrier(0)
    Unit cur, nxt; int ui = 0;
    if (!S.next(0, cur)) return;
    f32x4 acc[2][2][4][2];
#pragma unroll
    for (int a = 0; a < 2; ++a)
#pragma unroll
        for (int b = 0; b < 2; ++b)
#pragma unroll
            for (int m = 0; m < 4; ++m)
#pragma unroll
                for (int n = 0; n < 2; ++n) acc[a][b][m][n] = (f32x4){0.f, 0.f, 0.f, 0.f};
    bf16x8 At[4][2], B0[2][2], B1[2][2];
    const char* cA = (const char*)g.A + (size_t)cur.pm * tstepA; const char* cB = (const char*)g.Bt + (size_t)cur.pn * tstepB;
    S.a_ready(cur);
    if constexpr (SP2) {
        PG8_STAGE(PG8_SB(0, 0), cB, voffB); PG8_STAGE(PG8_SB(0, 1), cB + hstepB, voffB); PG8_STAGE(PG8_SA(0, 0), cA, voffA); PG8_STAGE(PG8_SA(0, 1), cA + hstepA, voffA);
        if (wr == 1) PG8_BAR;
        PG8_WAIT_V(2); PG8_BAR;
        PG8_STAGE(PG8_SB(1, 0), cB + kstepB, voffB); PG8_STAGE(PG8_SA(1, 0), cA + kstepA, voffA); PG8_STAGE(PG8_SB(1, 1), cB + hstepB + kstepB, voffB);
        PG8_WAIT_V(6); PG8_BAR;
    } else {
        PG8_STAGE(PG8_SB(0, 0), cB, voffB); PG8_STAGE(PG8_SA(0, 0), cA, voffA); PG8_STAGE(PG8_SB(0, 1), cB + hstepB, voffB); PG8_STAGE(PG8_SA(0, 1), cA + hstepA, voffA);
        if (wr == 1) PG8_BAR;
        PG8_WAIT_V(4); PG8_BAR;
        PG8_STAGE(PG8_SB(1, 0), cB + kstepB, voffB); PG8_STAGE(PG8_SA(1, 0), cA + kstepA, voffA); PG8_STAGE(PG8_SB(1, 1), cB + hstepB + kstepB, voffB);
        PG8_WAIT_V(6); PG8_BAR;
    }
    for (;;) {
        const bool has_next = S.next(ui + 1, nxt);
        const char* nA = has_next ? (const char*)g.A + (size_t)nxt.pm * tstepA : cA; const char* nB = has_next ? (const char*)g.Bt + (size_t)nxt.pn * tstepB : cB;
        for (int t = 0; t < nt; t += 2) {
            const bool last = (t == nt - 2);
            const char* a1 = cA + (size_t)(t + 1) * kstepA;
            const char* a2 = last ? nA : cA + (size_t)(t + 2) * kstepA; const char* b2 = last ? nB : cB + (size_t)(t + 2) * kstepB;
            const char* a3 = a2 + kstepA; const char* b3 = b2 + kstepB;
            if (last && has_next) S.a_ready(nxt);
            if constexpr (SP2) {
            PG8_LDB(B0, 0, 0); PG8_LDB(B1, 0, 1); PG8_SCHED; PG8_LDA(At, 0, 0); PG8_STAGE(PG8_SA(1, 1), a1 + hstepA, voffA);
            PG8_WAIT_V(8); PG8_WAIT_L(0); PG8_BAR; PG8_MMA(0, 0, At, B0); PG8_MMA(0, 1, At, B1); PG8_BAR; PG8_SCHED;
            PG8_LDA(At, 0, 1); PG8_STAGE(PG8_SB(0, 0), b2, voffB); PG8_STAGE(PG8_SB(0, 1), b2 + hstepB, voffB); PG8_STAGE(PG8_SA(0, 0), a2, voffA);
            PG8_WAIT_V(8); PG8_WAIT_L(0); PG8_BAR; PG8_MMA(1, 0, At, B0); PG8_MMA(1, 1, At, B1); PG8_BAR; PG8_SCHED;
            PG8_LDB(B0, 1, 0); PG8_LDB(B1, 1, 1); PG8_SCHED; PG8_LDA(At, 1, 0); PG8_STAGE(PG8_SA(0, 1), a2 + hstepA, voffA);
            PG8_WAIT_V(8); PG8_WAIT_L(0); PG8_BAR; PG8_MMA(0, 0, At, B0); PG8_MMA(0, 1, At, B1); PG8_BAR; PG8_SCHED;
            PG8_LDA(At, 1, 1); PG8_STAGE(PG8_SB(1, 0), b3, voffB); PG8_STAGE(PG8_SB(1, 1), b3 + hstepB, voffB); PG8_STAGE(PG8_SA(1, 0), a3, voffA);
            PG8_WAIT_V(8); PG8_WAIT_L(0); PG8_BAR; PG8_MMA(1, 0, At, B0); PG8_MMA(1, 1, At, B1); PG8_BAR; PG8_SCHED;
            } else {
            PG8_LDB(B0, 0, 0); PG8_SCHED; PG8_LDA(At, 0, 0); PG8_STAGE(PG8_SA(1, 1), a1 + hstepA, voffA);
            PG8_WAIT_L(8); PG8_BAR; PG8_WAIT_L(0); PG8_MMA(0, 0, At, B0); PG8_BAR; PG8_SCHED;
            PG8_LDB(B1, 0, 1); PG8_STAGE(PG8_SB(0, 0), b2, voffB);
            PG8_BAR; PG8_WAIT_L(0); PG8_MMA(0, 1, At, B1); PG8_BAR;
            PG8_LDA(At, 0, 1); PG8_STAGE(PG8_SA(0, 0), a2, voffA);
            PG8_BAR; PG8_WAIT_L(0); PG8_MMA(1, 0, At, B0); PG8_BAR; PG8_SCHED;
            PG8_STAGE(PG8_SB(0, 1), b2 + hstepB, voffB);
            PG8_WAIT_V(6); PG8_BAR; PG8_MMA(1, 1, At, B1); PG8_BAR;
            PG8_LDB(B0, 1, 0); PG8_SCHED; PG8_LDA(At, 1, 0); PG8_STAGE(PG8_SA(0, 1), a2 + hstepA, voffA);
            PG8_WAIT_L(8); PG8_BAR; PG8_WAIT_L(0); PG8_MMA(0, 0, At, B0); PG8_BAR; PG8_SCHED;
            PG8_LDB(B1, 1, 1); PG8_STAGE(PG8_SB(1, 0), b3, voffB);
            PG8_BAR; PG8_WAIT_L(0); PG8_MMA(0, 1, At, B1); PG8_BAR;
            PG8_LDA(At, 1, 1); PG8_STAGE(PG8_SA(1, 0), a3, voffA);
            PG8_BAR; PG8_WAIT_L(0); PG8_MMA(1, 0, At, B0); PG8_BAR; PG8_SCHED;
            PG8_STAGE(PG8_SB(1, 1), b3 + hstepB, voffB);
            PG8_WAIT_V(6); PG8_BAR; PG8_MMA(1, 1, At, B1); PG8_BAR;
            }
        }
        if constexpr (ALIGN_EPI) { if (wr == 0) PG8_BAR; }
        if constexpr (!Epi::AFTER_DRAIN) { E(acc, cur, wr, wc, fr, fq); S.done(cur); }
        if (!has_next) break;
#pragma unroll
        for (int a = 0; a < 2; ++a)
#pragma unroll
            for (int b = 0; b < 2; ++b)
#pragma unroll
                for (int m = 0; m < 4; ++m)
#pragma unroll
                    for (int n = 0; n < 2; ++n) acc[a][b][m][n] = (f32x4){0.f, 0.f, 0.f, 0.f};
        cur = nxt; cA = nA; cB = nB; ++ui;
        if constexpr (ALIGN_EPI) { if (wr == 1) PG8_BAR; }
    }
    PG8_WAIT_V(0);
    if constexpr (!ALIGN_EPI) { if (wr == 0) PG8_BAR; }
    PG8_BAR;
    if constexpr (Epi::AFTER_DRAIN) { E.fused(acc, cur, wr, wc, fr, fq, lds, wid, lane); S.done(cur); }
#undef PG8_SA
#undef PG8_SB
#undef PG8_STAGE
#undef PG8_LDA
#undef PG8_LDB
#undef PG8_MMA
#undef PG8_WAIT_V
#undef PG8_WAIT_L
#undef PG8_BAR
#undef PG8_SCHED
}
}

constexpr int D = 2048, NB = 4, S = 2048, M = NB * S, FF = 8192, H = 16, DH = 128, NBLK = 8, BLK = 256;
constexpr float EPS = 1e-6f;
constexpr int NWAVES = 8;
constexpr size_t MiB = 1u << 20;
constexpr size_t WS_CTL = 0, CTL_ZERO_BYTES = 32768;
constexpr size_t WS_WT = 1 * MiB;
constexpr size_t WE_WIN = 0, WE_WOUT = 33554432, WE_KVQ = 41943040, WE_Q1 = 54525952, WE_WO = 58720256, WE_W1 = 67108864, WE_W2 = 134217728, WE_END = 201326592;
constexpr size_t WS_XN = 385 * MiB, WS_QS = 417 * MiB, WS_KS = 449 * MiB, WS_VS = 481 * MiB, WS_GT = 513 * MiB, WS_GS = 545 * MiB, WS_OG = 609 * MiB, WS_U = 641 * MiB;
constexpr size_t WS_KRAW = 769 * MiB, WS_VV = 801 * MiB, WS_QRAW = 833 * MiB, WS_OF = 865 * MiB, WS_KN = 929 * MiB, WS_SMALL = 993 * MiB, WS_END = 994 * MiB;
constexpr size_t SM_LBS = 0, SM_KNORM = 16384, SM_QNORM = 16384 + 512, SM_KMEAN = 65536;
static_assert((4096 + 3456) * 4 <= 32768, "barrier words inside the memset");
constexpr int CW_BAR = 4096;
constexpr int RING_OFF = 0, RING_BYTES = 131072;
constexpr int LDSCTL_OFF = RING_BYTES, MISC_OFF = LDSCTL_OFF + 320;
constexpr int LDS_BYTES = 147456;

#define GAS __attribute__((address_space(1)))
#define LAS __attribute__((address_space(3)))
typedef unsigned short bf16;
typedef unsigned v4u __attribute__((ext_vector_type(4)));
typedef unsigned v2u __attribute__((ext_vector_type(2)));
typedef float f32x2 __attribute__((ext_vector_type(2)));
typedef float f32x4 __attribute__((ext_vector_type(4)));
typedef short bf16x8 __attribute__((ext_vector_type(8)));
typedef GAS unsigned gu32;
#define RLX_AGENT __ATOMIC_RELAXED, __HIP_MEMORY_SCOPE_AGENT
#define LDS_WAIT() asm volatile("s_waitcnt lgkmcnt(0)" ::: "memory")
#define VM_WAIT() asm volatile("s_waitcnt vmcnt(0)" ::: "memory")
__device__ __forceinline__ unsigned f2bf(float f) { unsigned u = __builtin_bit_cast(unsigned, f); return (u + 0x7fffu + ((u >> 16) & 1u)) >> 16; }
__device__ __forceinline__ unsigned pk2(float lo, float hi) { return f2bf(lo) | (f2bf(hi) << 16); }
__device__ __forceinline__ float bf2f(unsigned short b) { return __builtin_bit_cast(float, (unsigned)b << 16); }
__device__ __forceinline__ float bflo(unsigned w) { return __builtin_bit_cast(float, w << 16); }
__device__ __forceinline__ float bfhi(unsigned w) { return __builtin_bit_cast(float, w & 0xffff0000u); }
static_assert(WS_VS - WS_KS == WS_KS - WS_QS && WS_GT - WS_VS == WS_KS - WS_QS && WS_QRAW - WS_VV == WS_VV - WS_KRAW, "strided tensor groups");
#define XB_TMO      128
#define XB_XCNT(j)  (256  + 64 * (j))
#define XB_XSUB(j)  (1280 + 64 * (j))
#define XB_XGEN(j)  (2304 + 64 * (j))
#define XB_TOP      3328
#define XB_TOPGEN   3392
#define XCD_BAR_WORDS 3456
#define XB_SPIN_CAP (1u << 18)

__device__ __forceinline__ unsigned xb_ld(unsigned* p)              { return __hip_atomic_load(p, __ATOMIC_RELAXED, __HIP_MEMORY_SCOPE_AGENT); }
__device__ __forceinline__ unsigned xb_add(unsigned* p, unsigned v) { return __hip_atomic_fetch_add(p, v, __ATOMIC_RELAXED, __HIP_MEMORY_SCOPE_AGENT); }
__device__ __forceinline__ unsigned xb_xcc_id() { return (unsigned)__builtin_amdgcn_s_getreg((3 << 11) | 20) & 0xFu; }
#define XB_SPIN(cond, bar) do { unsigned _sp = 0; while (cond) { __builtin_amdgcn_s_sleep(1); \
    if ((++_sp & 255u) == 0u) { if (xb_ld(&(bar)[XB_TMO])) break; if (_sp > XB_SPIN_CAP) { atomicAdd(&(bar)[XB_TMO], 1u); break; } } } } while (0)

struct XcdBarrier {
    unsigned* bar; unsigned x;
    volatile LAS unsigned* st;
};

__device__ __forceinline__ XcdBarrier xcd_barrier_post(unsigned* bar, volatile LAS unsigned* st) {
    XcdBarrier b; b.bar = bar; b.x = xb_xcc_id(); b.st = st;
    if (threadIdx.x == 0) (void)xb_add(&bar[XB_XCNT(b.x)], 1u);
    return b;
}
__device__ __forceinline__ void xcd_barrier_complete(unsigned* bar, unsigned x, unsigned& nloc, unsigned& nx) {
    const unsigned G = gridDim.x * gridDim.y * gridDim.z;
    unsigned sum, cnt, mine, sp = 0u;
    for (;;) {
        sum = 0u; cnt = 0u; mine = 0u;
#pragma unroll
        for (unsigned j = 0; j < 16; ++j) { const unsigned c = xb_ld(&bar[XB_XCNT(j)]); sum += c; cnt += (c > 0u) ? 1u : 0u; mine = (j == x) ? c : mine; }
        if (sum == G) break;
        __builtin_amdgcn_s_sleep(1);
        if ((++sp & 255u) == 0u) { if (xb_ld(&bar[XB_TMO])) break; if (sp > XB_SPIN_CAP) { atomicAdd(&bar[XB_TMO], 1u); break; } }
    }
    nloc = mine > 0u ? mine : 1u; nx = cnt > 0u ? cnt : 1u;
}

__device__ __forceinline__ void xcd_barrier(const XcdBarrier& b) {
    asm volatile("s_waitcnt vmcnt(0)" ::: "memory");
    __syncthreads();
    if (threadIdx.x == 0) {
        unsigned* bar = b.bar;
        __builtin_amdgcn_s_waitcnt(0);
        unsigned nloc = b.st[0], nx = b.st[1];
        if (nloc == 0u) { xcd_barrier_complete(bar, b.x, nloc, nx); b.st[0] = nloc; b.st[1] = nx; }
        const unsigned old = xb_add(&bar[XB_XSUB(b.x)], 1u);
        const unsigned gen = old / nloc;
        if (old + 1u == (gen + 1u) * nloc) {
            __builtin_amdgcn_fence(__ATOMIC_RELEASE, "agent");
            asm volatile("s_waitcnt vmcnt(0)" ::: "memory");
            const unsigned og = xb_add(&bar[XB_TOP], 1u);
            const unsigned tg = og / nx;
            if (og + 1u == (tg + 1u) * nx) xb_add(&bar[XB_TOPGEN], 1u);
            else XB_SPIN(xb_ld(&bar[XB_TOPGEN]) == tg, bar);
            __builtin_amdgcn_fence(__ATOMIC_ACQUIRE, "agent");
            xb_add(&bar[XB_XGEN(b.x)], 1u);
            asm volatile("s_waitcnt vmcnt(0)" ::: "memory");
        } else {
            XB_SPIN(xb_ld(&bar[XB_XGEN(b.x)]) == gen, bar);
            __builtin_amdgcn_fence(__ATOMIC_ACQUIRE, "agent");
            asm volatile("s_waitcnt vmcnt(0)" ::: "memory");
        }
    }
    __syncthreads();
}


struct Args { const float* in[16]; float* out; unsigned char* ws; int ph_lo, ph_hi, li, pad; };
enum InIdx { I_X = 0, I_ANORM, I_AWIN, I_AHEAD, I_AWOUT, I_LB, I_KVNORM, I_WKV, I_KNORM, I_BNORM, I_BWQ, I_BQNORM, I_BWO, I_MLPNORM, I_W1, I_W2 };
__device__ __forceinline__ const float* in_ptr(int i) {
    const __attribute__((address_space(4))) unsigned char* ka = (const __attribute__((address_space(4))) unsigned char*)__builtin_amdgcn_kernarg_segment_ptr();
    int off = i * 8; asm volatile("" : "+s"(off));
    const float* p = *(const float* const __attribute__((address_space(4)))*)(ka + off);
    return (const float*)(const GAS float*)p;
}

__device__ __forceinline__ void transpose_item(const float* W, const float* gain, int K, int N, bf16* WT, LAS float* scr, int item, int lane, int tiled) {
    const int nblk = N / 32, kb = item / nblk, nb = item % nblk, k0 = 64 * kb, n0 = 32 * nb;
    const int ks = lane >> 3, n4 = (lane & 7) * 4, c = lane & 7;
    f32x4 v[8];
#pragma unroll
    for (int i = 0; i < 8; ++i) v[i] = __builtin_nontemporal_load((const GAS f32x4*)(W + (size_t)(k0 + ks + 8 * i) * N + n0 + n4));
    f32x4 g0 = (f32x4){1.f, 1.f, 1.f, 1.f}, g1 = g0;
    if (gain) { g0 = *(const GAS f32x4*)(gain + k0 + 8 * c); g1 = *(const GAS f32x4*)(gain + k0 + 8 * c + 4); }
#pragma unroll
    for (int i = 0; i < 8; ++i) { LAS float* d = scr + (ks + 8 * i) * 33 + n4; d[0] = v[i].x; d[1] = v[i].y; d[2] = v[i].z; d[3] = v[i].w; }
    LDS_WAIT(); asm volatile("" ::: "memory");
#pragma unroll
    for (int j = 0; j < 4; ++j) { const int n = (lane >> 3) + 8 * j; const LAS float* s = scr + (8 * c) * 33 + n;
        v4u o; o.x = pk2(s[0 * 33] * g0.x, s[1 * 33] * g0.y); o.y = pk2(s[2 * 33] * g0.z, s[3 * 33] * g0.w); o.z = pk2(s[4 * 33] * g1.x, s[5 * 33] * g1.y); o.w = pk2(s[6 * 33] * g1.z, s[7 * 33] * g1.w);
        bf16* dst = tiled ? WT + (((size_t)((n0 + n) >> 8) * (K / 64) + kb) * 256 + ((n0 + n) & 255)) * 64 + 8 * c
                          : WT + (size_t)(n0 + n) * K + k0 + 8 * c;
        __builtin_nontemporal_store(o, (GAS v4u*)dst); }
    LDS_WAIT(); asm volatile("" ::: "memory");
}
struct MatDesc { const float* src; const float* gain; bf16* dst; int K, N, items, tiled; };
__device__ __forceinline__ MatDesc mat_desc(bf16* WT, int id) {
    MatDesc m; int kind, l;
    if (id < 4)        { kind = id; l = 0; }
    else if (id < 8)   { kind = id - 4; l = 1; }
    else if (id == 8)  { kind = 4; l = 0; }
    else if (id == 9)  { kind = 5; l = 0; }
    else if (id == 10) { kind = 6; l = 0; }
    else if (id == 11) { kind = 2; l = 2; }
    else if (id == 12) { kind = 3; l = 2; }
    else if (id == 13) { kind = 5; l = 1; }
    else if (id == 14) { kind = 6; l = 1; }
    else if (id == 15) { kind = 2; l = 3; }
    else               { kind = 3; l = 3; }
    if (kind == 0)      { m.src = in_ptr(I_AWIN) + (size_t)l * D * 4 * D; m.gain = in_ptr(I_ANORM) + l * D; m.dst = WT + WE_WIN + (size_t)l * D * 4 * D; m.K = D; m.N = 4 * D; }
    else if (kind == 1) { m.src = in_ptr(I_AWOUT) + (size_t)l * D * D; m.gain = in_ptr(I_AHEAD) + l * D; m.dst = WT + WE_WOUT + (size_t)l * D * D; m.K = D; m.N = D; }
    else if (kind == 2) { m.src = in_ptr(I_W1) + (size_t)l * D * FF; m.gain = in_ptr(I_MLPNORM) + l * D; m.dst = WT + WE_W1 + (size_t)l * D * FF; m.K = D; m.N = FF; }
    else if (kind == 3) { m.src = in_ptr(I_W2) + (size_t)l * FF * D; m.gain = nullptr; m.dst = WT + WE_W2 + (size_t)l * FF * D; m.K = FF; m.N = D; }
    else if (kind == 4) { m.src = in_ptr(I_WKV); m.gain = in_ptr(I_KVNORM); m.dst = WT + WE_KVQ; m.K = D; m.N = 2 * D; }
    else if (kind == 5) { m.src = in_ptr(I_BWQ) + (size_t)l * D * D; m.gain = in_ptr(I_BNORM) + l * D; m.dst = l == 0 ? WT + WE_KVQ + (size_t)2 * D * D : WT + WE_Q1; m.K = D; m.N = D; }
    else                { m.src = in_ptr(I_BWO) + (size_t)l * D * D; m.gain = nullptr; m.dst = WT + WE_WO + (size_t)l * D * D; m.K = D; m.N = D; }
    m.items = (m.K / 64) * (m.N / 32); m.tiled = (kind == 3) ? 1 : 0;
    return m;
}
__device__ __forceinline__ void convert_weights(bf16* WT, int id_lo, int id_hi, int wv, int nwv, LAS float* scr, int lane) {
    int id = id_lo; MatDesc md = mat_desc(WT, id); int base = 0;
    for (int it = wv; ; it += nwv) {
        while (it >= base + md.items) { base += md.items; ++id; if (id >= id_hi) return; md = mat_desc(WT, id); }
        transpose_item(md.src, md.gain, md.K, md.N, md.dst, scr, it - base, lane, md.tiled);
    }
}
__device__ __forceinline__ void intake_row(const float* xrow, bf16* hbrow, float* psrow, int lane) {
    const GAS f32x4* xr = (const GAS f32x4*)xrow + lane;
    f32x4 v[8]; float s = 0.f;
#pragma unroll
    for (int j = 0; j < 8; ++j) { v[j] = xr[64 * j]; s += (v[j].x * v[j].x + v[j].y * v[j].y) + (v[j].z * v[j].z + v[j].w * v[j].w); }
    s = wave_sum(s);
    GAS v2u* o8 = (GAS v2u*)hbrow + lane;
#pragma unroll
    for (int j = 0; j < 8; ++j) { v2u w; w.x = pk2(v[j].x, v[j].y); w.y = pk2(v[j].z, v[j].w); o8[64 * j] = w; }
    if (lane < 32) psrow[lane] = (lane == 0) ? s : 0.f;
}

constexpr int GC = 64, NCH = S / GC;
constexpr int GQ_PT = 0, GQ_SS = 4096, GQ_QT = 5120, GQ_KT = GQ_QT + 64 * 272, GQ_VT = GQ_KT + 64 * 272, GQ_AM = GQ_VT + 128 * 144, GQ_SX = 67584, GQ_KDT = GQ_SX + 128 * 272;
static_assert(GQ_AM + 64 * 144 <= GQ_SX && GQ_KDT + 128 * 144 <= RING_BYTES, "GLA LDS map");
__device__ __forceinline__ bf16x8 lds_frag(LAS const unsigned char* base, int stride_bytes, int row0, int k0, int lane) {
    return *(const LAS bf16x8*)(base + (row0 + (lane & 15)) * stride_bytes + (k0 + 8 * (lane >> 4)) * 2);
}
__device__ __forceinline__ unsigned cvtpk_bf16(float lo, float hi) { unsigned r; asm("v_cvt_pk_bf16_f32 %0, %1, %2" : "=v"(r) : "v"(lo), "v"(hi)); return r; }
__device__ __forceinline__ void gla_seq(int bh, const bf16* QS, const bf16* KS, const bf16* VS, const float* GS, const bf16* GT, bf16* OG, LAS unsigned char* L, int tid) {
    const int b = bh >> 4, h = bh & 15;
    const int lane = tid & 63, w = __builtin_amdgcn_readfirstlane(tid >> 6);
    const int tt = w >> 1, sh = w & 1, g4 = 4 * (lane >> 4), l15 = lane & 15;
    LAS float* PT = (LAS float*)(L + GQ_PT); LAS float* SS = (LAS float*)(L + GQ_SS);
    const size_t ebase = (size_t)b * S * D + h * DH;
    const __amdgpu_buffer_rsrc_t rq = __builtin_amdgcn_make_buffer_rsrc((void*)(QS + ebase), 0, S * D * 2, 0x00020000), rk = __builtin_amdgcn_make_buffer_rsrc((void*)(KS + ebase), 0, S * D * 2, 0x00020000);
    const __amdgpu_buffer_rsrc_t rv = __builtin_amdgcn_make_buffer_rsrc((void*)(VS + ebase), 0, S * D * 2, 0x00020000), rg = __builtin_amdgcn_make_buffer_rsrc((void*)(GS + ebase), 0, S * D * 4, 0x00020000);
    const __amdgpu_buffer_rsrc_t rt = __builtin_amdgcn_make_buffer_rsrc((void*)(GT + ebase), 0, S * D * 2, 0x00020000), ro = __builtin_amdgcn_make_buffer_rsrc((void*)(OG + ebase), 0, S * D * 2, 0x00020000);
    const unsigned vo2 = (unsigned)((w * 8) * D + 2 * lane) * 2u, vo4 = vo2 * 2u;
    const unsigned vrow = (unsigned)((lane >> 2) * D + 16 * (lane & 3)) * 2u;
    f32x4 st[8];
#pragma unroll
    for (int j = 0; j < 8; ++j) st[j] = (f32x4){0.f, 0.f, 0.f, 0.f};
    f32x2 cs[8], gr[8]; unsigned qq[8], vv[8];
#define GLA_LOAD(c) do { const int so_ = (c) * GC * D * 2; f32x2 run_ = (f32x2){0.f, 0.f}; \
        _Pragma("unroll") for (int i = 0; i < 8; ++i) { const v2u g_ = __builtin_amdgcn_raw_buffer_load_b64(rg, vo4, 2 * (so_ + i * D * 2), 0); gr[i] = (f32x2){__uint_as_float(g_.x), __uint_as_float(g_.y)}; run_ += gr[i]; cs[i] = run_; \
            qq[i] = __builtin_amdgcn_raw_buffer_load_b32(rq, vo2, so_ + i * D * 2, 0); } \
        _Pragma("unroll") for (int i = 0; i < 8; ++i) vv[i] = __builtin_amdgcn_raw_buffer_load_b32(rv, vo2, so_ + i * D * 2, 0); } while (0)
#define GLA_BAR() do { asm volatile("s_waitcnt lgkmcnt(0)" ::: "memory"); __builtin_amdgcn_s_barrier(); asm volatile("" ::: "memory"); } while (0)
    GLA_LOAD(0);
    for (int c = 0; c < NCH; ++c) {
        *(LAS f32x2*)(PT + w * 128 + 2 * lane) = cs[7];
        GLA_BAR();
        {
            f32x2 offs = (f32x2){0.f, 0.f}, bref = offs, tot = offs;
#pragma unroll
            for (int p = 0; p < 8; ++p) { const f32x2 x = *(const LAS f32x2*)(PT + p * 128 + 2 * lane); tot += x; if (p < 4) bref += x; if (p < w) offs += x; }
            const f32x2 fdec = (f32x2){__builtin_amdgcn_exp2f(tot.x - bref.x), __builtin_amdgcn_exp2f(tot.y - bref.y)};
            offs -= bref;
            unsigned kd0[4], kd1[4]; f32x2 kdp;
#pragma unroll
            for (int i = 0; i < 8; ++i) { const f32x2 x = offs + cs[i];
                const f32x2 e1 = (f32x2){__builtin_amdgcn_exp2f(x.x), __builtin_amdgcn_exp2f(x.y)}, e2 = (f32x2){__builtin_amdgcn_exp2f(-x.x), __builtin_amdgcn_exp2f(-x.y)};
                const f32x2 qf = (f32x2){__uint_as_float(qq[i] << 16), __uint_as_float(qq[i] & 0xffff0000u)} * e1, kf = ((f32x2){1.f, 1.f} - (f32x2){__builtin_amdgcn_exp2f(gr[i].x), __builtin_amdgcn_exp2f(gr[i].y)}) * e2;
                *(LAS unsigned*)(L + GQ_QT + (w * 8 + i) * 272 + lane * 4) = cvtpk_bf16(qf.x, qf.y);
                *(LAS unsigned*)(L + GQ_KT + (w * 8 + i) * 272 + lane * 4) = cvtpk_bf16(kf.x, kf.y);
                const f32x2 kd = kf * fdec;
                if (i & 1) { kd0[i >> 1] = cvtpk_bf16(kdp.x, kd.x); kd1[i >> 1] = cvtpk_bf16(kdp.y, kd.y); } else kdp = kd; }
            *(LAS v4u*)(L + GQ_KDT + (2 * lane) * 144 + w * 16) = (v4u){kd0[0], kd0[1], kd0[2], kd0[3]};
            *(LAS v4u*)(L + GQ_KDT + (2 * lane + 1) * 144 + w * 16) = (v4u){kd1[0], kd1[1], kd1[2], kd1[3]};
            *(LAS v4u*)(L + GQ_VT + (2 * lane) * 144 + w * 16) = (v4u){(vv[0] & 0xffffu) | (vv[1] << 16), (vv[2] & 0xffffu) | (vv[3] << 16), (vv[4] & 0xffffu) | (vv[5] << 16), (vv[6] & 0xffffu) | (vv[7] << 16)};
            *(LAS v4u*)(L + GQ_VT + (2 * lane + 1) * 144 + w * 16) = (v4u){(vv[0] >> 16) | (vv[1] & 0xffff0000u), (vv[2] >> 16) | (vv[3] & 0xffff0000u), (vv[4] >> 16) | (vv[5] & 0xffff0000u), (vv[6] >> 16) | (vv[7] & 0xffff0000u)};
        }
        f32x4 dr;
        {
            const int d0 = 16 * w + g4;
            const f32x4 pa = (*(const LAS f32x4*)(PT + d0) + *(const LAS f32x4*)(PT + 128 + d0)) + (*(const LAS f32x4*)(PT + 256 + d0) + *(const LAS f32x4*)(PT + 384 + d0));
            const f32x4 pb = (*(const LAS f32x4*)(PT + 512 + d0) + *(const LAS f32x4*)(PT + 640 + d0)) + (*(const LAS f32x4*)(PT + 768 + d0) + *(const LAS f32x4*)(PT + 896 + d0));
            f32x4 er;
#pragma unroll
            for (int r = 0; r < 4; ++r) { er[r] = __builtin_amdgcn_exp2f(pa[r]); dr[r] = __builtin_amdgcn_exp2f(pa[r] + pb[r]); }
#pragma unroll
            for (int j = 0; j < 8; ++j) { v2u o; o.x = cvtpk_bf16(st[j][0] * er[0], st[j][1] * er[1]); o.y = cvtpk_bf16(st[j][2] * er[2], st[j][3] * er[3]);
                *(LAS v2u*)(L + GQ_SX + (16 * j + l15) * 272 + d0 * 2) = o; }
        }
        { const int cn = (c + 1 < NCH) ? c + 1 : c; GLA_LOAD(cn); }
        const int so_out = ((c * GC + 16 * tt) * D + 64 * sh) * 2;
        const v4u gta = __builtin_amdgcn_raw_buffer_load_b128(rt, vrow, so_out, 0), gtb = __builtin_amdgcn_raw_buffer_load_b128(rt, vrow, so_out + 16, 0);
        GLA_BAR();
#pragma unroll
        for (int u = 0; u < 2; ++u) { const int stl = 2 * sh + u; f32x4 a = (f32x4){0.f, 0.f, 0.f, 0.f};
            if (stl <= tt) {
#pragma unroll
                for (int ks = 0; ks < 4; ++ks) a = __builtin_amdgcn_mfma_f32_16x16x32_bf16(lds_frag(L + GQ_QT, 272, 16 * tt, 32 * ks, lane), lds_frag(L + GQ_KT, 272, 16 * stl, 32 * ks, lane), a, 0, 0, 0);
            }
            const int s_ = 16 * stl + l15, t0 = 16 * tt + g4;
            const unsigned w01 = cvtpk_bf16(s_ <= t0 ? a[0] : 0.f, s_ <= t0 + 1 ? a[1] : 0.f), w23 = cvtpk_bf16(s_ <= t0 + 2 ? a[2] : 0.f, s_ <= t0 + 3 ? a[3] : 0.f);
            *(LAS unsigned short*)(L + GQ_AM + (t0 + 0) * 144 + s_ * 2) = (unsigned short)w01; *(LAS unsigned short*)(L + GQ_AM + (t0 + 1) * 144 + s_ * 2) = (unsigned short)(w01 >> 16);
            *(LAS unsigned short*)(L + GQ_AM + (t0 + 2) * 144 + s_ * 2) = (unsigned short)w23; *(LAS unsigned short*)(L + GQ_AM + (t0 + 3) * 144 + s_ * 2) = (unsigned short)(w23 >> 16); }
#pragma unroll
        for (int j = 0; j < 8; ++j) st[j] = st[j] * dr;
#pragma unroll
        for (int ks = 0; ks < 2; ++ks) { const bf16x8 a = lds_frag(L + GQ_KDT, 144, 16 * w, 32 * ks, lane);
#pragma unroll
            for (int j = 0; j < 8; ++j) st[j] = __builtin_amdgcn_mfma_f32_16x16x32_bf16(a, lds_frag(L + GQ_VT, 144, 16 * j, 32 * ks, lane), st[j], 0, 0, 0); }
        GLA_BAR();
        f32x4 acc[4];
#pragma unroll
        for (int j = 0; j < 4; ++j) acc[j] = (f32x4){0.f, 0.f, 0.f, 0.f};
#pragma unroll
        for (int ks = 0; ks < 4; ++ks) { const bf16x8 a = lds_frag(L + GQ_QT, 272, 16 * tt, 32 * ks, lane);
#pragma unroll
            for (int j = 0; j < 4; ++j) acc[j] = __builtin_amdgcn_mfma_f32_16x16x32_bf16(a, lds_frag(L + GQ_SX, 272, 16 * (4 * sh + j), 32 * ks, lane), acc[j], 0, 0, 0); }
#pragma unroll
        for (int ks = 0; ks < 2; ++ks) { const bf16x8 a = lds_frag(L + GQ_AM, 144, 16 * tt, 32 * ks, lane);
#pragma unroll
            for (int j = 0; j < 4; ++j) acc[j] = __builtin_amdgcn_mfma_f32_16x16x32_bf16(a, lds_frag(L + GQ_VT, 144, 16 * (4 * sh + j), 32 * ks, lane), acc[j], 0, 0, 0); }
        float ssq[4];
#pragma unroll
        for (int r = 0; r < 4; ++r) { float x = 0.f;
#pragma unroll
            for (int j = 0; j < 4; ++j) x += acc[j][r] * acc[j][r];
            ssq[r] = sum16(x); }
        if (l15 == 0) {
#pragma unroll
            for (int r = 0; r < 4; ++r) SS[(16 * tt + g4 + r) * 2 + sh] = ssq[r]; }
        GLA_BAR();
        {
            LAS unsigned char* scr = L + GQ_SX + w * 4352;
#pragma unroll
            for (int r = 0; r < 4; ++r) { const int t = 16 * tt + g4 + r;
                const float rn = rsqrtf((SS[t * 2] + SS[t * 2 + 1]) * (1.0f / DH) + EPS);
#pragma unroll
                for (int j = 0; j < 4; ++j) *(LAS float*)(scr + (g4 + r) * 272 + (16 * j + l15) * 4) = acc[j][r] * rn; }
            asm volatile("s_waitcnt lgkmcnt(0)" ::: "memory");
            const LAS unsigned char* rp = scr + (lane >> 2) * 272 + (lane & 3) * 64;
            const f32x4 o0 = *(const LAS f32x4*)(rp), o1 = *(const LAS f32x4*)(rp + 16), o2 = *(const LAS f32x4*)(rp + 32), o3 = *(const LAS f32x4*)(rp + 48);
#define GMUL(o, gw) cvtpk_bf16(o[0] * __uint_as_float(gw.x << 16), o[1] * __uint_as_float(gw.x & 0xffff0000u)), cvtpk_bf16(o[2] * __uint_as_float(gw.y << 16), o[3] * __uint_as_float(gw.y & 0xffff0000u))
            const v2u ga0 = (v2u){gta.x, gta.y}, ga1 = (v2u){gta.z, gta.w}, gb0 = (v2u){gtb.x, gtb.y}, gb1 = (v2u){gtb.z, gtb.w};
            const v4u wa = (v4u){GMUL(o0, ga0), GMUL(o1, ga1)}, wb = (v4u){GMUL(o2, gb0), GMUL(o3, gb1)};
#undef GMUL
            __builtin_amdgcn_raw_buffer_store_b128(wa, ro, vrow, so_out, 0); __builtin_amdgcn_raw_buffer_store_b128(wb, ro, vrow, so_out + 16, 0);
        }
    }
#undef GLA_LOAD
#undef GLA_BAR
}


namespace moba {
using f32x16 = __attribute__((ext_vector_type(16))) float;
using s16x4  = __attribute__((ext_vector_type(4))) short;
using u32x4  = __attribute__((ext_vector_type(4))) unsigned;
constexpr int LD = 2048;
constexpr float SCALE = 0.088388347648318440f;
constexpr float C2 = SCALE * 1.4426950408889634f;
constexpr float THR_RAW = 8.0f / SCALE;
constexpr size_t SHM_V = 64 * 128 * 2, SHM_K = 64 * 128 * 2;
constexpr int OFF_WS = 2 * SHM_V + 2 * SHM_K, OFF_KM = OFF_WS + 8 * 64 * 4, ATT_LDS = OFF_KM + 8 * 128 * 4;
#define KSWZ(row, colB) ((row) * 256 + ((colB) ^ (((row) & 7) << 4)))
#define SBAR() __builtin_amdgcn_sched_barrier(0)
__device__ __forceinline__ int crow(int r, int hi) { return (r & 3) + 8 * (r >> 2) + 4 * hi; }
__device__ __forceinline__ unsigned cvtpk(float lo, float hi) { unsigned r; asm volatile("v_cvt_pk_bf16_f32 %0, %1, %2" : "=v"(r) : "v"(lo), "v"(hi)); return r; }
__device__ __forceinline__ void partialSM(f32x16& p0, f32x16& p1, float& m_reg, float& mn, float& alpha, float a, float yl, bool diag, int dlim, int hi) {
    const float NINF = -__builtin_inff();
    const float a3 = 3.f * a, a8 = 8.f * a, a24 = 24.f * a, a32 = 32.f * a;
#pragma unroll
    for (int r = 0; r < 16; ++r) { const int i = r & 3, k = r >> 2; float x = p0[r], z = p1[r];
        if (i == 1) { x += a; z += a; } else if (i == 2) { x = fmaf(a, 2.f, x); z = fmaf(a, 2.f, z); } else if (i == 3) { x += a3; z += a3; }
        if (k == 1) { x += a8; z += a8; } else if (k == 2) { x = fmaf(a8, 2.f, x); z = fmaf(a8, 2.f, z); } else if (k == 3) { x += a24; z += a24; }
        p0[r] = x; p1[r] = z; }
    if (diag) {
#pragma unroll
        for (int r = 0; r < 16; ++r) { const int k0 = (r & 3) + 8 * (r >> 2); p0[r] = (k0 > dlim) ? NINF : p0[r]; p1[r] = (32 + k0 > dlim) ? NINF : p1[r]; }
    }
    float pmax = p0[0], pmax1 = p1[0];
#pragma unroll
    for (int r = 1; r < 16; ++r) { pmax = fmaxf(pmax, p0[r]); pmax1 = fmaxf(pmax1, p1[r]); }
    pmax = fmaxf(pmax, pmax1 + a32) + yl;
    { auto rr = __builtin_amdgcn_permlane32_swap(__float_as_uint(pmax), __float_as_uint(pmax), false, false);
      pmax = fmaxf(__uint_as_float(rr[0]), __uint_as_float(rr[1])); }
    if (__builtin_expect(__all(pmax - m_reg <= THR_RAW), 1)) { mn = m_reg; alpha = 1.f; }
    else { mn = fmaxf(m_reg, pmax); alpha = __builtin_amdgcn_exp2f((m_reg - mn) * C2); m_reg = mn; }
    const float mnC = (yl - mn) * C2, mnC1 = (yl - mn + a32) * C2;
#pragma unroll
    for (int r = 0; r < 16; ++r) { p0[r] = fmaf(p0[r], C2, mnC); p1[r] = fmaf(p1[r], C2, mnC1); }
#pragma unroll
    for (int r = 0; r < 16; ++r) p0[r] = __builtin_amdgcn_exp2f(p0[r]);
}
__device__ __forceinline__ void finishSM(f32x16& p0, f32x16& p1, float alpha, float& l_reg, bf16x8& pa0, bf16x8& pa1, bf16x8& pa2, bf16x8& pa3) {
#pragma unroll
    for (int r = 0; r < 16; ++r) p1[r] = __builtin_amdgcn_exp2f(p1[r]);
    float ps = 0.f;
#pragma unroll
    for (int r = 0; r < 16; ++r) ps += p0[r];
#pragma unroll
    for (int r = 0; r < 16; ++r) ps += p1[r];
    { auto rr = __builtin_amdgcn_permlane32_swap(__float_as_uint(ps), __float_as_uint(ps), false, false);
      ps = __uint_as_float(rr[0]) + __uint_as_float(rr[1]); }
    l_reg = l_reg * alpha + ps;
#define PK4(P, BASE, OUT) do { unsigned a0 = cvtpk(P[BASE + 0], P[BASE + 1]), a1 = cvtpk(P[BASE + 2], P[BASE + 3]);   \
    unsigned b0 = cvtpk(P[BASE + 4], P[BASE + 5]), b1 = cvtpk(P[BASE + 6], P[BASE + 7]);                              \
    auto r0 = __builtin_amdgcn_permlane32_swap(a0, b0, false, false); auto r1 = __builtin_amdgcn_permlane32_swap(a1, b1, false, false); \
    u32x4 w = {r0[0], r1[0], r0[1], r1[1]}; OUT = *reinterpret_cast<bf16x8*>(&w); } while (0)
    PK4(p0, 0, pa0); PK4(p0, 8, pa1); PK4(p1, 0, pa2); PK4(p1, 8, pa3);
#undef PK4
}
__device__ __forceinline__ void qkt(f32x16& p0, f32x16& p1, const LAS char* Ks, const bf16x8* qr, int r32, int hi) {
    p0 = f32x16{}; p1 = f32x16{};
#pragma unroll
    for (int d0 = 0; d0 < 8; ++d0) { const int cb = (d0 * 16 + hi * 8) * 2;
        const bf16x8 b0 = *(const LAS bf16x8*)(Ks + KSWZ(r32, cb));
        const bf16x8 b1 = *(const LAS bf16x8*)(Ks + KSWZ(32 + r32, cb));
        p0 = __builtin_amdgcn_mfma_f32_32x32x16_bf16(b0, qr[d0], p0, 0, 0, 0);
        p1 = __builtin_amdgcn_mfma_f32_32x32x16_bf16(b1, qr[d0], p1, 0, 0, 0); }
}
__device__ __forceinline__ int v_st(int k, int c) { const int kk = (k & ~0xC) | ((k & 4) << 1) | ((k & 8) >> 1); return ((kk >> 3) * 4 + (c >> 5)) * 512 + ((kk & 7) * 32 + (c & 31)) * 2; }
__device__ __forceinline__ int v_rd_base(int lane) { return ((lane & 3) << 3) | (((lane >> 2) & 3) << 6) | (((lane >> 4) & 1) << 5) | (((lane >> 5) & 1) << 8); }
constexpr int v_rd_off(int d0, int ks, int half) { return d0 * 512 + ks * 4096 + half * 2048; }
template <int OFF> __device__ __forceinline__ s16x4 tr_read(int vb) {
    s16x4 r; asm volatile("ds_read_b64_tr_b16 %0, %1 offset:%2" : "=&v"(r) : "v"(vb), "i"(OFF) : "memory"); return r;
}
template <int D0> __device__ __forceinline__ void pv_one(f32x16& od, int vb, bf16x8 pa0, bf16x8 pa1, bf16x8 pa2, bf16x8 pa3) {
    const s16x4 l0 = tr_read<v_rd_off(D0, 0, 0)>(vb), h0 = tr_read<v_rd_off(D0, 0, 1)>(vb), l1 = tr_read<v_rd_off(D0, 1, 0)>(vb), h1 = tr_read<v_rd_off(D0, 1, 1)>(vb);
    const s16x4 l2 = tr_read<v_rd_off(D0, 2, 0)>(vb), h2 = tr_read<v_rd_off(D0, 2, 1)>(vb), l3 = tr_read<v_rd_off(D0, 3, 0)>(vb), h3 = tr_read<v_rd_off(D0, 3, 1)>(vb);
    asm volatile("s_waitcnt lgkmcnt(0)" ::: "memory"); SBAR();
#define PK(L, H) (bf16x8){L[0], L[1], L[2], L[3], H[0], H[1], H[2], H[3]}
    od = __builtin_amdgcn_mfma_f32_32x32x16_bf16(pa0, PK(l0, h0), od, 0, 0, 0);
    od = __builtin_amdgcn_mfma_f32_32x32x16_bf16(pa1, PK(l1, h1), od, 0, 0, 0);
    od = __builtin_amdgcn_mfma_f32_32x32x16_bf16(pa2, PK(l2, h2), od, 0, 0, 0);
    od = __builtin_amdgcn_mfma_f32_32x32x16_bf16(pa3, PK(l3, h3), od, 0, 0, 0);
#undef PK
}
__device__ __forceinline__ void pv_d0(f32x16* o, int vb, bf16x8 pa0, bf16x8 pa1, bf16x8 pa2, bf16x8 pa3) {
    pv_one<0>(o[0], vb, pa0, pa1, pa2, pa3); pv_one<1>(o[1], vb, pa0, pa1, pa2, pa3); pv_one<2>(o[2], vb, pa0, pa1, pa2, pa3); pv_one<3>(o[3], vb, pa0, pa1, pa2, pa3);
}
__device__ __forceinline__ void unit(const bf16* __restrict__ Qb, const bf16* __restrict__ Kh, const bf16* __restrict__ Vh, bf16* __restrict__ Ob,
                                     const float* __restrict__ qn, const float* __restrict__ kmp, int qb, int h, LAS char* lds, int tid_in) {
    int tid = tid_in;
    const int wid = __builtin_amdgcn_readfirstlane(tid >> 6), lane = tid & 63, r32 = lane & 31, hi = lane >> 5;
    LAS char* V_lds = lds; LAS char* K_lds = lds + 2 * SHM_V;
    LAS float* wsf = (LAS float*)(lds + OFF_WS) + wid * 64; LAS float* li_l = wsf; LAS float* al_l = wsf + 32;
    LAS float* KM = (LAS float*)(lds + OFF_KM);
    for (int i = tid; i < 8 * 128; i += 512) { const int n = i >> 7, d = i & 127; const float* p = kmp + (size_t)n * 512 + d; KM[i] = ((p[0] + p[128]) + (p[256] + p[384])) * (1.0f / 256.0f); }
    __syncthreads();
    float m_reg = -1e30f, l_reg = 0.f; bf16x8 qr[8];
    unsigned selmask;
    {
        const bf16* Qw = Qb + (size_t)(wid * 32 + r32) * LD + hi * 8;
        v4u raw[8]; float ss = 0.f;
#pragma unroll
        for (int d0 = 0; d0 < 8; ++d0) { raw[d0] = *(const v4u*)(Qw + d0 * 16);
            const float x0 = bflo(raw[d0].x), x1 = bfhi(raw[d0].x), x2 = bflo(raw[d0].y), x3 = bfhi(raw[d0].y), x4 = bflo(raw[d0].z), x5 = bfhi(raw[d0].z), x6 = bflo(raw[d0].w), x7 = bfhi(raw[d0].w);
            ss += (x0 * x0 + x1 * x1) + (x2 * x2 + x3 * x3) + (x4 * x4 + x5 * x5) + (x6 * x6 + x7 * x7); }
        ss = half_sum(ss);
        const float rinv = rsqrtf(ss * (1.0f / 128.0f) + EPS);
        float gate[8];
#pragma unroll
        for (int n = 0; n < 8; ++n) gate[n] = 0.f;
#pragma unroll
        for (int d0 = 0; d0 < 8; ++d0) { const f32x4 g0 = *(const f32x4*)(qn + d0 * 16 + hi * 8), g1 = *(const f32x4*)(qn + d0 * 16 + hi * 8 + 4);
            const float q0 = bflo(raw[d0].x) * rinv * g0.x, q1 = bfhi(raw[d0].x) * rinv * g0.y, q2 = bflo(raw[d0].y) * rinv * g0.z, q3 = bfhi(raw[d0].y) * rinv * g0.w;
            const float q4 = bflo(raw[d0].z) * rinv * g1.x, q5 = bfhi(raw[d0].z) * rinv * g1.y, q6 = bflo(raw[d0].w) * rinv * g1.z, q7 = bfhi(raw[d0].w) * rinv * g1.w;
            if (qb > 3) {
#pragma unroll
                for (int n = 0; n < 8; ++n) { const f32x4 k0 = *(const LAS f32x4*)(KM + n * 128 + d0 * 16 + hi * 8), k1 = *(const LAS f32x4*)(KM + n * 128 + d0 * 16 + hi * 8 + 4);
                    gate[n] += (q0 * k0.x + q1 * k0.y) + (q2 * k0.z + q3 * k0.w) + (q4 * k1.x + q5 * k1.y) + (q6 * k1.z + q7 * k1.w); } }
            u32x4 w = {cvtpk(q0, q1), cvtpk(q2, q3), cvtpk(q4, q5), cvtpk(q6, q7)};
            qr[d0] = *reinterpret_cast<bf16x8*>(&w); }
        selmask = 0u;
        if (qb <= 3) selmask = (1u << qb) - 1u;
        else {
#pragma unroll
            for (int n = 0; n < 8; ++n) { gate[n] = half_sum(gate[n]); gate[n] = (n < qb) ? gate[n] : -3e38f; }
#pragma unroll
            for (int it = 0; it < 3; ++it) { float best = -3e38f; int bi = 0;
#pragma unroll
                for (int n = 0; n < 8; ++n) { const bool ok = (n < qb) && !((selmask >> n) & 1u); if (ok && gate[n] > best) { best = gate[n]; bi = n; } }
                selmask |= 1u << bi; }
        }
        selmask |= 1u << qb;
    }
    asm volatile("" : "+v"(tid));
    f32x16 o[4] = {};
    float a = exp2f(-0.5f * (float)(h + 1)) * (1.0f / SCALE);
    asm volatile("" : "+v"(a));
    const float NINF = -__builtin_inff();
    const int trow = wid * 32 + r32;
#define TILE_PARAMS(j, yl, dg, dl) do { const int n_ = (j) >> 2, jj_ = (j) & 3; const float yb_ = a * (float)(64 * (j) - 256 * qb + 4 * hi); \
        if (n_ < qb) { yl = ((selmask >> n_) & 1u) ? yb_ : NINF; dg = false; dl = 0; } \
        else if (64 * jj_ + 63 <= 32 * wid) { yl = yb_; dg = false; dl = 0; } \
        else if (64 * jj_ > 32 * wid + 31) { yl = NINF; dg = false; dl = 0; } \
        else { yl = yb_; dg = true; dl = trow - 64 * jj_ - 4 * hi; } } while (0)
    const int sr = tid >> 4, sc = (tid & 15) * 8, vst0 = v_st(sr, sc), vst1 = v_st(32 + sr, sc);
    const int vb0 = (int)(uintptr_t)V_lds + v_rd_base(tid & 63);
    const unsigned goff0 = (unsigned)(sr * LD + sc) * 2u, goff1 = goff0 + 32u * LD * 2u;
    struct { bf16x8 vs0, vs1, ks0, ks1; } sr_[1];
#define SLOAD(i, k0) do { const char* vt_ = (const char*)Vh + (size_t)(k0) * (LD * 2); const char* kt_ = (const char*)Kh + (size_t)(k0) * (LD * 2); \
    sr_[i].vs0 = *(const bf16x8*)(vt_ + goff0); sr_[i].vs1 = *(const bf16x8*)(vt_ + goff1); sr_[i].ks0 = *(const bf16x8*)(kt_ + goff0); sr_[i].ks1 = *(const bf16x8*)(kt_ + goff1); } while (0)
#define SWRITE(b, i) do { *(LAS bf16x8*)(V_lds + (b) * SHM_V + vst0) = sr_[i].vs0;          \
    *(LAS bf16x8*)(V_lds + (b) * SHM_V + vst1) = sr_[i].vs1; const int kc = sc * 2;               \
    *(LAS bf16x8*)(K_lds + (b) * SHM_K + KSWZ(sr, kc)) = sr_[i].ks0;                       \
    *(LAS bf16x8*)(K_lds + (b) * SHM_K + KSWZ(32 + sr, kc)) = sr_[i].ks1; } while (0)
#define SWAIT() asm volatile("s_waitcnt vmcnt(0)" ::: "memory")
#define RESC(al) do { if (__any((al) < 1.f)) { if (hi == 0) al_l[r32] = (al); asm volatile("s_waitcnt lgkmcnt(0)" ::: "memory"); \
    _Pragma("unroll") for (int d = 0; d < 4; ++d) _Pragma("unroll") for (int r = 0; r < 16; ++r) o[d][r] *= al_l[crow(r, hi)]; } } while (0)
    f32x16 pA0, pA1, pB0, pB1; float mnA, mnB, alA, alB; bf16x8 pa0, pa1, pa2, pa3; const int NT = 4 * (qb + 1);
    float yl; bool dg; int dl;
    constexpr int SE = 0, SO = 0;
    SLOAD(SE, 0); asm volatile("s_waitcnt vmcnt(0)" ::: "memory"); SWRITE(0, SE); __syncthreads();
    qkt(pA0, pA1, K_lds, qr, r32, hi); TILE_PARAMS(0, yl, dg, dl); partialSM(pA0, pA1, m_reg, mnA, alA, a, yl, dg, dl, hi);
    SLOAD(SO, 64);
    SWAIT(); SWRITE(1, SO); __syncthreads();
    for (int j = 1; j + 1 < NT; j += 2) {
        SBAR(); qkt(pB0, pB1, K_lds + SHM_K, qr, r32, hi);
        finishSM(pA0, pA1, alA, l_reg, pa0, pa1, pa2, pa3); SBAR();
        SLOAD(SO, (j + 1) * 64); SBAR();
        pv_d0(o, vb0, pa0, pa1, pa2, pa3); TILE_PARAMS(j, yl, dg, dl); partialSM(pB0, pB1, m_reg, mnB, alB, a, yl, dg, dl, hi);
        __syncthreads(); SWAIT(); SWRITE(0, SE);
        RESC(alB); __syncthreads();
        SBAR(); qkt(pA0, pA1, K_lds, qr, r32, hi);
        finishSM(pB0, pB1, alB, l_reg, pa0, pa1, pa2, pa3); SBAR();
        SLOAD(SE, (j + 2) * 64); SBAR();
        pv_d0(o, vb0 + (int)SHM_V, pa0, pa1, pa2, pa3); TILE_PARAMS(j + 1, yl, dg, dl); partialSM(pA0, pA1, m_reg, mnA, alA, a, yl, dg, dl, hi);
        __syncthreads(); SWAIT(); SWRITE(1, SO);
        RESC(alA); __syncthreads();
    }
    SBAR(); qkt(pB0, pB1, K_lds + SHM_K, qr, r32, hi);
    finishSM(pA0, pA1, alA, l_reg, pa0, pa1, pa2, pa3); SBAR();
    pv_d0(o, vb0, pa0, pa1, pa2, pa3); TILE_PARAMS(NT - 1, yl, dg, dl); partialSM(pB0, pB1, m_reg, mnB, alB, a, yl, dg, dl, hi);
    __syncthreads(); RESC(alB);
    finishSM(pB0, pB1, alB, l_reg, pa0, pa1, pa2, pa3); SBAR();
    pv_d0(o, vb0 + (int)SHM_V, pa0, pa1, pa2, pa3);
    if (hi == 0) li_l[r32] = l_reg; asm volatile("s_waitcnt lgkmcnt(0)" ::: "memory");
    asm volatile("" : "+v"(tid));
    float rli[16];
#pragma unroll
    for (int r = 0; r < 16; ++r) rli[r] = __builtin_amdgcn_rcpf(li_l[crow(r, hi)]);
    { const int hi2 = (tid >> 5) & 1; bf16* Ow = Ob + (size_t)(wid * 32) * LD + (tid & 31);
#pragma unroll
    for (int r = 0; r < 16; ++r) { const int orow = crow(r, hi2);
#pragma unroll
        for (int d0 = 0; d0 < 4; ++d0) Ow[(size_t)orow * LD + d0 * 32] = (bf16)f2bf(o[d0][r] * rli[r]); } }
    __syncthreads();
#undef SLOAD
#undef SWRITE
#undef SWAIT
#undef RESC
#undef TILE_PARAMS
}
#undef KSWZ
#undef SBAR
}

__device__ __forceinline__ void kvnorm_item(int item, const bf16* KRAW, const float* k_norm, bf16* KNB, float* KMP, int lane) {
    const int part = item & 3, n = (item >> 2) & 7, h = (item >> 5) & 15, b = item >> 9;
    const int tk = lane >> 4, c8 = (lane & 15) * 8;
    const f32x4 g0 = *(const f32x4*)(k_norm + c8), g1 = *(const f32x4*)(k_norm + c8 + 4);
    float acc[8];
#pragma unroll
    for (int i = 0; i < 8; ++i) acc[i] = 0.f;
    for (int it = 0; it < 16; ++it) {
        const size_t off = ((size_t)b * S + n * BLK + part * 64 + it * 4 + tk) * D + h * DH + c8;
        const v4u raw = *(const v4u*)(KRAW + off);
        float v[8] = {bflo(raw.x), bfhi(raw.x), bflo(raw.y), bfhi(raw.y), bflo(raw.z), bfhi(raw.z), bflo(raw.w), bfhi(raw.w)};
        float ss = 0.f;
#pragma unroll
        for (int i = 0; i < 8; ++i) ss = fmaf(v[i], v[i], ss);
        ss = sum16(ss);
        const float r = rsqrtf(ss * (1.0f / DH) + EPS);
        v[0] *= r * g0.x; v[1] *= r * g0.y; v[2] *= r * g0.z; v[3] *= r * g0.w; v[4] *= r * g1.x; v[5] *= r * g1.y; v[6] *= r * g1.z; v[7] *= r * g1.w;
#pragma unroll
        for (int i = 0; i < 8; ++i) acc[i] += v[i];
        v4u o; o.x = pk2(v[0], v[1]); o.y = pk2(v[2], v[3]); o.z = pk2(v[4], v[5]); o.w = pk2(v[6], v[7]);
        *(v4u*)(KNB + off) = o;
    }
#pragma unroll
    for (int i = 0; i < 8; ++i) { acc[i] += swz_xor<16>(acc[i]); acc[i] = half_sum(acc[i]); }
    if (lane < 16) { float* p = KMP + (size_t)item * 128 + c8; *(f32x4*)p = (f32x4){acc[0], acc[1], acc[2], acc[3]}; *(f32x4*)(p + 4) = (f32x4){acc[4], acc[5], acc[6], acc[7]}; }
}

__global__ void __launch_bounds__(NWAVES * 64, 2) fwd(Args args) {
    extern __shared__ __attribute__((aligned(16))) unsigned char lds_raw[];
    LAS unsigned char* lds = (LAS unsigned char*)lds_raw;
    volatile LAS unsigned* MISC = (volatile LAS unsigned*)(lds + MISC_OFF);
    const int tid0 = threadIdx.x, wave = __builtin_amdgcn_readfirstlane(tid0 >> 6);
    const int G = gridDim.x;
    unsigned char* ws = args.ws;
    gu32* ctl = (gu32*)(ws + WS_CTL);
    for (int u = tid0; u < (LDS_BYTES - LDSCTL_OFF) / 4; u += NWAVES * 64) ((LAS unsigned*)(lds + LDSCTL_OFF))[u] = 0u;
    __syncthreads();
    XcdBarrier bar = xcd_barrier_post((unsigned*)(ctl + CW_BAR) + args.li * XCD_BAR_WORDS, MISC + 8);

#define WT   ((bf16*)(wsp + WS_WT))
#define HB   ((bf16*)(wsp + WS_XN))
#define PSUM ((float*)(wsp + WS_OF + 2 * MiB))
#define RSL  ((LAS float*)(lds + LDSCTL_OFF + 1024))
#define QS   ((bf16*)(wsp + WS_QS))
#define KS   ((bf16*)(wsp + WS_KS))
#define VS   ((bf16*)(wsp + WS_VS))
#define GT   ((bf16*)(wsp + WS_GT))
#define GS   ((float*)(wsp + WS_GS))
#define OG   ((bf16*)(wsp + WS_OG))
#define U    ((bf16*)(wsp + WS_U))
#define KRAW ((bf16*)(wsp + WS_KRAW))
#define VV   ((bf16*)(wsp + WS_VV))
#define QRAW ((bf16*)(wsp + WS_QRAW))
#define LBS  ((float*)(wsp + WS_SMALL + SM_LBS))
#define KNORMC ((float*)(wsp + WS_SMALL + SM_KNORM))
#define QNORMC ((float*)(wsp + WS_SMALL + SM_QNORM))
#define KNB  ((bf16*)(wsp + WS_KN))
#define KMP  ((float*)(wsp + WS_OF))
    float* hres = args.out;
    const int lo = args.ph_lo, hi = args.ph_hi;
    const int NGW = G * NWAVES;
    bool any = false;
#define PHASE_BEGIN(p) if (lo <= (p) && (p) < hi) { if (any) xcd_barrier(bar); any = true; GAS unsigned char* wsp = (GAS unsigned char*)args.ws; asm volatile("" : "+s"(wsp)); int bx = blockIdx.x; asm volatile("" : "+s"(bx)); (void)bx; int tz_ = threadIdx.x; asm volatile("" : "+v"(tz_)); const int tid = tz_, lane = tz_ & 63; (void)tid; (void)lane;
#define PHASE_END() }

    PHASE_BEGIN(0)
        {
            const int d = bx * (NWAVES * 64) + tid;
            if (d < D) { const float a = in_ptr(I_LB)[d], b = in_ptr(I_LB)[D + d], mx = fmaxf(a, b), ea = expf(a - mx), eb = expf(b - mx), sm = ea + eb, p0 = ea / sm, p1 = eb / sm;
                LBS[d] = 0.f; LBS[D + d] = (p0 + p1) - p0; }
            if (d < 128) KNORMC[d] = in_ptr(I_KNORM)[d];
            if (d < 256) QNORMC[d] = in_ptr(I_BQNORM)[d];
        }
        for (int m = bx * NWAVES + wave; m < M; m += NGW) intake_row(in_ptr(I_X) + (size_t)m * D, HB + (size_t)m * D, PSUM + (size_t)m * 32, lane);
        {
            LAS float* scr = (LAS float*)(lds + RING_OFF + wave * 16384);
            convert_weights(WT, 0, 1, bx * NWAVES + wave, NGW, scr, lane);
        }
    PHASE_END()

    for (int l = 0; l < 4; ++l) {
        const int pb = 1 + 9 * l;
        if (l < 2) {
            PHASE_BEGIN(pb + 1)
                pg8::Gemm g = pg8::gemm_rowmajor(HB, WT + WE_WIN + (size_t)l * D * 4 * D, M, 4 * D, D); pg8::StaticOrder So; So.init(M, 4 * D, G, bx);
                pg8::EpiHgrn E{QS, (size_t)(WS_KS - WS_QS) / 2, GS, LBS + l * D, RSL}; pg8::row_scale_table(PSUM, RSL, So, tid);
                pg8::gemm_phase<pg8::EpiHgrn, pg8::StaticOrder, true, true>(lds + RING_OFF, g, So, E);
            PHASE_END()
        } else {
            PHASE_BEGIN(pb + 1)
                const bool first = (l == 2);
                pg8::Gemm g = pg8::gemm_rowmajor(HB, first ? WT + WE_KVQ : WT + WE_Q1, M, first ? 3 * D : D, D); pg8::StaticOrder So; So.init(M, first ? 3 * D : D, G, bx);
                pg8::EpiSplit E{KRAW, (size_t)(WS_VV - WS_KRAW) / 2, first ? 0 : 2, RSL}; pg8::row_scale_table(PSUM, RSL, So, tid);
                pg8::gemm_phase<pg8::EpiSplit, pg8::StaticOrder, true, true>(lds + RING_OFF, g, So, E);
            PHASE_END()
        }
        if (l < 2) {
            PHASE_BEGIN(pb + 2)
                if (bx < NB * H) gla_seq(bx, QS, KS, VS, GS, GT, OG, lds + RING_OFF, tid);
                else if (G > NB * H) convert_weights(WT, l == 0 ? 1 : 8, l == 0 ? 8 : 17, (bx - NB * H) * NWAVES + wave, (G - NB * H) * NWAVES, (LAS float*)(lds + RING_OFF + wave * 16384), lane);
            PHASE_END()
        } else {
            if (l == 2) {
                PHASE_BEGIN(pb + 2)
                    for (int it = bx * NWAVES + wave; it < NB * H * NBLK * 4; it += NGW) kvnorm_item(it, KRAW, KNORMC, KNB, KMP, lane);
                PHASE_END()
            }
            PHASE_BEGIN(pb + 4)
                for (int pi = bx; pi < 256; pi += G) {
                    const int bh = pi & 63, pr = pi >> 6, b = bh >> 4, h = bh & 15;
                    for (int u = 0; u < 2; ++u) {
                        const int qb = u == 0 ? 7 - pr : pr;
                        const size_t qoff = ((size_t)b * S + 256 * qb) * D + h * DH, koff = (size_t)b * S * D + h * DH;
                        moba::unit(QRAW + qoff, KNB + koff, VV + koff, OG + qoff, QNORMC + (size_t)(l - 2) * DH, KMP + (size_t)bh * 4096, qb, h, (LAS char*)(lds + RING_OFF), tid);
                    }
                }
            PHASE_END()
        }
        PHASE_BEGIN(pb + 5)
            pg8::Gemm g = pg8::gemm_rowmajor(OG, l < 2 ? WT + WE_WOUT + (size_t)l * D * D : WT + WE_WO + (size_t)(l - 2) * D * D, M, D, D); pg8::StaticOrder So; So.init(M, D, G, bx);
            pg8::EpiRes<false> E{HB, PSUM, nullptr, D};
            pg8::gemm_phase<pg8::EpiRes<false>, pg8::StaticOrder, true, true>(lds + RING_OFF, g, So, E);
        PHASE_END()
        PHASE_BEGIN(pb + 7)
            pg8::Gemm g = pg8::gemm_rowmajor(HB, WT + WE_W1 + (size_t)l * D * FF, M, FF, D); pg8::StaticOrder So; So.init(M, FF, G, bx);
            pg8::EpiRelu2 E{U, FF, RSL}; pg8::row_scale_table(PSUM, RSL, So, tid);
            pg8::gemm_phase<pg8::EpiRelu2, pg8::StaticOrder, true, true>(lds + RING_OFF, g, So, E);
        PHASE_END()
        PHASE_BEGIN(pb + 8)
            pg8::Gemm g{U, WT + WE_W2 + (size_t)l * FF * D, M, D, FF, 64, 64, 32768, 32768, (size_t)(FF / 64) * 32768, (size_t)(FF / 64) * 32768};     pg8::StaticOrder So; So.init(M, D, G, bx);
            if (l == 3) { pg8::EpiRes<true> E{HB, PSUM, hres, D}; pg8::gemm_phase<pg8::EpiRes<true>, pg8::StaticOrder, true, true>(lds + RING_OFF, g, So, E); }
            else { pg8::EpiRes<false> E{HB, PSUM, nullptr, D}; pg8::gemm_phase<pg8::EpiRes<false>, pg8::StaticOrder, true, true>(lds + RING_OFF, g, So, E); }
        PHASE_END()
    }
#undef PHASE_BEGIN
#undef PHASE_END
#undef WT
#undef HB
#undef PSUM
#undef RSL
#undef QS
#undef KS
#undef VS
#undef GT
#undef GS
#undef OG
#undef U
#undef KRAW
#undef VV
#undef QRAW
#undef LBS
#undef KNORMC
#undef QNORMC
#undef KNB
#undef KMP
}

extern "C" void kernel_launch(void* const* d_in, const int* in_sizes, int n_in, void* d_out, int out_size, void* d_ws, size_t ws_size, hipStream_t stream) {
    static int grid = 0;
    if (grid == 0) {
        if (n_in != 16 || out_size != M * D || ws_size < WS_END) { fprintf(stderr, "kernel_launch: unexpected sizes (n_in %d, out %d, ws %zu < %zu); nothing launched\n", n_in, out_size, ws_size, (size_t)WS_END); grid = -1; return; }
        int dev = 0, cus = 0, per_cu = 0;
        if (hipGetDevice(&dev) != hipSuccess || hipDeviceGetAttribute(&cus, hipDeviceAttributeMultiprocessorCount, dev) != hipSuccess) { grid = -1; return; }
        if (hipFuncSetAttribute((const void*)fwd, hipFuncAttributeMaxDynamicSharedMemorySize, LDS_BYTES) != hipSuccess) { fprintf(stderr, "kernel_launch: hipFuncSetAttribute failed\n"); grid = -1; return; }
        if (hipOccupancyMaxActiveBlocksPerMultiprocessor(&per_cu, (const void*)fwd, NWAVES * 64, LDS_BYTES) != hipSuccess || per_cu < 1) { fprintf(stderr, "kernel_launch: occupancy query says %d blocks per CU\n", per_cu); }
        (void)hipGetLastError();
        grid = cus;
    }
    if (grid < 0) return;
    if (hipMemsetAsync((char*)d_ws + WS_CTL, 0, CTL_ZERO_BYTES, stream) != hipSuccess) return;
    Args a{};
    for (int i = 0; i < 16; ++i) a.in[i] = (const float*)d_in[i];
    a.out = (float*)d_out; a.ws = (unsigned char*)d_ws;
    a.ph_lo = 0; a.ph_hi = 37; a.li = 0;
    hipLaunchKernelGGL(fwd, dim3(grid), dim3(NWAVES * 64), LDS_BYTES, stream, a);
}
```

```cpp
#include <hip/hip_runtime.h>
#include <cstdio>
#include <cstdint>

template <int K> __device__ __forceinline__ float swz_xor(float v) { return __builtin_bit_cast(float, __builtin_amdgcn_ds_swizzle(__builtin_bit_cast(int, v), (K << 10) | 0x1f)); }
__device__ __forceinline__ float half_sum(float v) { auto rr = __builtin_amdgcn_permlane32_swap(__float_as_uint(v), __float_as_uint(v), false, false); const unsigned r0 = rr[0], r1 = rr[1]; return __uint_as_float(r0) + __uint_as_float(r1); }
__device__ __forceinline__ float sum16(float v) { v += swz_xor<1>(v); v += swz_xor<2>(v); v += swz_xor<4>(v); v += swz_xor<8>(v); return v; }
__device__ __forceinline__ float wave_sum(float v) { v = sum16(v); v += swz_xor<16>(v); return half_sum(v); }

namespace pg8 {
#define PG8_LAS __attribute__((address_space(3)))
typedef unsigned short bf16_t;
typedef short bf16x8 __attribute__((ext_vector_type(8)));
typedef float f32x4 __attribute__((ext_vector_type(4)));
typedef unsigned u32x4 __attribute__((ext_vector_type(4)));
constexpr int BM = 256, BK = 64, HALF = 128, HTB = HALF * BK * 2  , STAGE_BYTES = 8 * HTB, NXCD = 8, WGM = 8;

__host__ __device__ __forceinline__ int lds_byte(int r, int c) { const int st = (r >> 4) * 2 + (c >> 5), rr = r & 15, cc = c & 31, ob = rr * 64 + cc * 2; return st * 1024 + (ob ^ (((ob >> 9) & 1) << 5)); }
__host__ __device__ __forceinline__ void stage_rc(int b, int& R, int& C) { const int st = b / 1024, sb = b % 1024, swz = sb ^ (((sb >> 9) & 1) << 5); R = (st >> 1) * 16 + swz / 64; C = (st & 1) * 32 + (swz % 64) / 2; }
__host__ __device__ __forceinline__ int perm32(int rho) { const int n = rho >> 4, i = rho & 15; return 8 * (i >> 2) + 4 * n + (i & 3); }

struct Unit { int pm, pn, ord; };
struct Gemm { const bf16_t* A; const bf16_t* Bt; int M, N, K, lda, ldb; size_t ksa, ksb, tsa, tsb; };
__host__ __device__ inline Gemm gemm_rowmajor(const bf16_t* A, const bf16_t* Bt, int M, int N, int K) { return Gemm{A, Bt, M, N, K, K, K, 128, 128, (size_t)256 * K * 2, (size_t)256 * K * 2}; }

struct StaticOrder {
    int nM, nN, nwg, G, c;
    __host__ __device__ void init(int M, int N, int G_, int c_) { nM = M / BM; nN = N / BM; nwg = nM * nN; G = G_; c = c_; }
    __host__ __device__ bool next(int i, Unit& u) const {
        const long L = (long)i * G + c; if (L >= nwg) return false;
        int wgid = (int)L; { const int q = nwg / NXCD, r = nwg % NXCD, xcd = wgid % NXCD, off = wgid / NXCD; wgid = (xcd < r ? xcd * (q + 1) : r * (q + 1) + (xcd - r) * q) + off; }
        const int nig = WGM * nN, gid = wgid / nig, fm = gid * WGM, gsz = (nM - fm) < WGM ? (nM - fm) : WGM;
        u.pm = fm + ((wgid % nig) % gsz); u.pn = (wgid % nig) / gsz; u.ord = i; return true;
    }
    __device__ __forceinline__ void a_ready(const Unit&) const {}
    __device__ __forceinline__ void done(const Unit&) const {}
};

__device__ __forceinline__ unsigned cvt_pk_bf16(float lo, float hi) { unsigned r; asm("v_cvt_pk_bf16_f32 %0, %1, %2" : "=v"(r) : "v"(lo), "v"(hi)); return r; }
typedef float f32x2 __attribute__((ext_vector_type(2)));
template <class Sched> __device__ __forceinline__ void row_scale_table(const float* PS, PG8_LAS float* RS, const Sched& So, int tid) {
#pragma unroll
    for (int pass = 0; pass < 4; ++pass) { Unit uu; const int i = 2 * pass + (tid >> 8);
        if (So.next(i, uu)) { const f32x4* p = (const f32x4*)(PS + (size_t)(uu.pm * BM + (tid & 255)) * 32); f32x4 a = p[0];
#pragma unroll
            for (int k = 1; k < 8; ++k) a = a + p[k];
            RS[i * 256 + (tid & 255)] = rsqrtf(((a[0] + a[1]) + (a[2] + a[3])) * (1.0f / 2048.0f) + 1e-6f); } }
    asm volatile("s_waitcnt vmcnt(0) lgkmcnt(0)" ::: "memory"); __builtin_amdgcn_s_barrier(); asm volatile("" ::: "memory");
}
template <bool LAST>
struct EpiRes {
    static constexpr bool PERM = true, AFTER_DRAIN = false;
    bf16_t* HB; float* PS; float* Fout; int ldc;
    __device__ __forceinline__ void operator()(const f32x4 (&acc)[2][2][4][2], const Unit& u, int wr, int wc, int fr, int fq) const {
        const int row0 = u.pm * BM + wr * 64 + fr, col0 = u.pn * BM + wc * 64 + 8 * fq;
        u32x4 hv[2][4][2];
#pragma unroll
        for (int ai = 0; ai < 2; ++ai)
#pragma unroll
            for (int m = 0; m < 4; ++m)
#pragma unroll
                for (int bj = 0; bj < 2; ++bj) hv[ai][m][bj] = *(const u32x4*)(HB + (size_t)(row0 + ai * HALF + m * 16) * ldc + col0 + bj * 32);
#pragma unroll
        for (int ai = 0; ai < 2; ++ai)
#pragma unroll
            for (int m = 0; m < 4; ++m) { const int row = row0 + ai * HALF + m * 16; float ss = 0.f;
#pragma unroll
                for (int bj = 0; bj < 2; ++bj) { const u32x4 r = hv[ai][m][bj]; const size_t off = (size_t)row * ldc + col0 + bj * 32;
                    const f32x4 h0 = (f32x4){__builtin_bit_cast(float, r.x << 16), __builtin_bit_cast(float, r.x & 0xffff0000u), __builtin_bit_cast(float, r.y << 16), __builtin_bit_cast(float, r.y & 0xffff0000u)} + acc[ai][bj][m][0];
                    const f32x4 h1 = (f32x4){__builtin_bit_cast(float, r.z << 16), __builtin_bit_cast(float, r.z & 0xffff0000u), __builtin_bit_cast(float, r.w << 16), __builtin_bit_cast(float, r.w & 0xffff0000u)} + acc[ai][bj][m][1];
                    if constexpr (LAST) { *(f32x4*)(Fout + off) = h0; *(f32x4*)(Fout + off + 4) = h1; }
                    else { ss += ((h0[0] * h0[0] + h0[1] * h0[1]) + (h0[2] * h0[2] + h0[3] * h0[3])) + ((h1[0] * h1[0] + h1[1] * h1[1]) + (h1[2] * h1[2] + h1[3] * h1[3]));
                        u32x4 w; w.x = cvt_pk_bf16(h0[0], h0[1]); w.y = cvt_pk_bf16(h0[2], h0[3]); w.z = cvt_pk_bf16(h1[0], h1[1]); w.w = cvt_pk_bf16(h1[2], h1[3]);
                        *(u32x4*)(HB + off) = w; } }
                if constexpr (!LAST) { ss += swz_xor<16>(ss); ss = half_sum(ss);
                    if (fq == 0) PS[(size_t)row * 32 + u.pn * 4 + wc] = ss; } }
    }
};
struct EpiRelu2 {
    static constexpr bool PERM = true, AFTER_DRAIN = false;
    bf16_t* O; int ncols; PG8_LAS float* RS;
    __device__ __forceinline__ void operator()(const f32x4 (&acc)[2][2][4][2], const Unit& u, int wr, int wc, int fr, int fq) const {
        bf16_t* tile = O + ((size_t)(u.pm * (ncols / 64) + u.pn * 4 + wc) * 256 + wr * 64 + fr) * 64 + 8 * fq;
#pragma unroll
        for (int ai = 0; ai < 2; ++ai)
#pragma unroll
            for (int m = 0; m < 4; ++m) { bf16_t* rowp = tile + (ai * HALF + m * 16) * 64; const float rs = RS[u.ord * 256 + ai * HALF + wr * 64 + m * 16 + fr], rs2 = rs * rs;
#pragma unroll
                for (int bj = 0; bj < 2; ++bj) { f32x4 v0 = acc[ai][bj][m][0], v1 = acc[ai][bj][m][1];
#pragma unroll
                    for (int j = 0; j < 4; ++j) { const float a = __builtin_amdgcn_fmed3f(v0[j], 0.f, 3.0e38f), b = __builtin_amdgcn_fmed3f(v1[j], 0.f, 3.0e38f); v0[j] = (a * a) * rs2; v1[j] = (b * b) * rs2; }
                    u32x4 w; w.x = cvt_pk_bf16(v0[0], v0[1]); w.y = cvt_pk_bf16(v0[2], v0[3]); w.z = cvt_pk_bf16(v1[0], v1[1]); w.w = cvt_pk_bf16(v1[2], v1[3]);
                    *(u32x4*)(rowp + bj * 32) = w; } }
    }
};
struct EpiSplit {
    static constexpr bool PERM = true, AFTER_DRAIN = false;
    bf16_t* O0; size_t gstride; int g0; PG8_LAS float* RS;
    __device__ __forceinline__ void operator()(const f32x4 (&acc)[2][2][4][2], const Unit& u, int wr, int wc, int fr, int fq) const {
        const int g = g0 + (u.pn >> 3); bf16_t* base = O0 + (size_t)g * gstride;
        const int row0 = u.pm * BM + wr * 64 + fr, col0 = (u.pn & 7) * BM + wc * 64 + 8 * fq;
#pragma unroll
        for (int ai = 0; ai < 2; ++ai)
#pragma unroll
            for (int m = 0; m < 4; ++m) { bf16_t* rowp = base + (size_t)(row0 + ai * HALF + m * 16) * 2048 + col0; const float rs = RS[u.ord * 256 + ai * HALF + wr * 64 + m * 16 + fr];
#pragma unroll
                for (int bj = 0; bj < 2; ++bj) { const f32x4 v0 = acc[ai][bj][m][0] * rs, v1 = acc[ai][bj][m][1] * rs;
                    u32x4 w; w.x = cvt_pk_bf16(v0[0], v0[1]); w.y = cvt_pk_bf16(v0[2], v0[3]); w.z = cvt_pk_bf16(v1[0], v1[1]); w.w = cvt_pk_bf16(v1[2], v1[3]);
                    *(u32x4*)(rowp + bj * 32) = w; } }
    }
};
struct EpiHgrn {
    static constexpr bool PERM = true, AFTER_DRAIN = false;
    bf16_t* Qs; size_t qstride; float* Gs; const float* lb; PG8_LAS float* RS;
    __device__ __forceinline__ void operator()(const f32x4 (&acc)[2][2][4][2], const Unit& u, int wr, int wc, int fr, int fq) const {
        const int quarter = u.pn >> 3;
        const int row0 = u.pm * BM + wr * 64 + fr, col0 = (u.pn & 7) * BM + wc * 64 + 8 * fq;
        if (quarter == 1) {
            f32x4 lbv[2][2];
#pragma unroll
            for (int bj = 0; bj < 2; ++bj)
#pragma unroll
                for (int n = 0; n < 2; ++n) lbv[bj][n] = *(const f32x4*)(lb + col0 + bj * 32 + 4 * n);
#pragma unroll
            for (int ai = 0; ai < 2; ++ai)
#pragma unroll
                for (int m = 0; m < 4; ++m) { const size_t ro = (size_t)(row0 + ai * HALF + m * 16) * 2048 + col0; const float rs = RS[u.ord * 256 + ai * HALF + wr * 64 + m * 16 + fr];
#pragma unroll
                    for (int bj = 0; bj < 2; ++bj) { f32x4 lf[2];
#pragma unroll
                        for (int n = 0; n < 2; ++n)
#pragma unroll
                            for (int j = 0; j < 4; ++j) { const float x = fmaxf(acc[ai][bj][m][n][j] * rs, -80.f), e = __expf(-x), r = __builtin_amdgcn_rcpf(1.f + e);
                                const float l0 = lbv[bj][n][j], om = 1.f - l0; lf[n][j] = __log2f(fmaf(om, r, l0)); }
                        *(f32x4*)(Gs + ro + bj * 32) = lf[0]; *(f32x4*)(Gs + ro + bj * 32 + 4) = lf[1]; } }
        } else {
            bf16_t* base = Qs + (size_t)quarter * qstride;
            const bool act = quarter != 2;
#pragma unroll
            for (int ai = 0; ai < 2; ++ai)
#pragma unroll
                for (int m = 0; m < 4; ++m) { bf16_t* rowp = base + (size_t)(row0 + ai * HALF + m * 16) * 2048 + col0; const float rs = RS[u.ord * 256 + ai * HALF + wr * 64 + m * 16 + fr];
#pragma unroll
                    for (int bj = 0; bj < 2; ++bj) { f32x4 v0 = acc[ai][bj][m][0] * rs, v1 = acc[ai][bj][m][1] * rs;
                        if (act) {
#pragma unroll
                            for (int j = 0; j < 4; ++j) { const float a = fmaxf(v0[j], -80.f), b = fmaxf(v1[j], -80.f);
                                v0[j] = a * __builtin_amdgcn_rcpf(1.f + __expf(-a)); v1[j] = b * __builtin_amdgcn_rcpf(1.f + __expf(-b)); } }
                        u32x4 w; w.x = cvt_pk_bf16(v0[0], v0[1]); w.y = cvt_pk_bf16(v0[2], v0[3]); w.z = cvt_pk_bf16(v1[0], v1[1]); w.w = cvt_pk_bf16(v1[2], v1[3]);
                        *(u32x4*)(rowp + bj * 32) = w; } }
        }
    }
};


template <class Epi, class Sched, bool ALIGN_EPI = false, bool SP2 = false>
__device__ __forceinline__ void gemm_phase(PG8_LAS unsigned char* lds, const Gemm g, const Sched& S, const Epi& E) {
    int tid_ = threadIdx.x; asm volatile("" : "+v"(tid_));
    const int tid = tid_, wid = __builtin_amdgcn_readfirstlane(tid >> 6), lane = tid & 63, wr = wid >> 2, wc = wid & 3, fr = lane & 15, fq = lane >> 4;
    const int K = g.K, nt = K / BK;
    unsigned voffA[2], voffB[2];
#pragma unroll
    for (int i = 0; i < 2; ++i) { int R, C; stage_rc(tid * 16 + i * 8192, R, C); const int Rb = Epi::PERM ? (2 * (R & ~31) + perm32(R & 31)) : R;
        voffA[i] = (unsigned)(R * g.lda + C) * 2u; voffB[i] = (unsigned)(Rb * g.ldb + C) * 2u; }
    const size_t kstepA = g.ksa, kstepB = g.ksb;
    const size_t hstepA = (size_t)HALF * g.lda * 2, hstepB = (size_t)(Epi::PERM ? 32 : HALF) * g.ldb * 2;
    const size_t tstepA = g.tsa, tstepB = g.tsb;
    const unsigned ldsw = (unsigned)wid * 1024u;
    const int aoff = lds_byte(wr * 64 + fr, fq * 8), boff = lds_byte(wc * 32 + fr, fq * 8);
#define PG8_SA(b, h) (((b) * 2 + (h)) * HTB)
#define PG8_SB(b, h) ((4 + (b) * 2 + (h)) * HTB)
#define PG8_STAGE(bufoff, gbase, voff) do { _Pragma("unroll") for (int _i = 0; _i < 2; ++_i) \
        __builtin_amdgcn_global_load_lds((const unsigned*)((const char*)(gbase) + (voff)[_i]), (PG8_LAS unsigned*)(lds + (bufoff) + ldsw + _i * 8192), 16, 0, 0); } while (0)
#define PG8_LDA(dst, b, h) do { _Pragma("unroll") for (int m = 0; m < 4; ++m) _Pragma("unroll") for (int k = 0; k < 2; ++k) dst[m][k] = *(const PG8_LAS bf16x8*)(lds + PG8_SA(b, h) + aoff + m * 2048 + k * 1024); } while (0)
#define PG8_LDB(dst, b, h) do { _Pragma("unroll") for (int n = 0; n < 2; ++n) _Pragma("unroll") for (int k = 0; k < 2; ++k) dst[n][k] = *(const PG8_LAS bf16x8*)(lds + PG8_SB(b, h) + boff + n * 2048 + k * 1024); } while (0)
#define PG8_MMA(ai, bj, At, Bt) do { __builtin_amdgcn_s_setprio(1); _Pragma("unroll") for (int m = 0; m < 4; ++m) _Pragma("unroll") for (int n = 0; n < 2; ++n) _Pragma("unroll") for (int k = 0; k < 2; ++k) \
        acc[ai][bj][m][n] = __builtin_amdgcn_mfma_f32_16x16x32_bf16(Bt[n][k], At[m][k], acc[ai][bj][m][n], 0, 0, 0); __builtin_amdgcn_s_setprio(0); } while (0)
#define PG8_WAIT_V(n) asm volatile("s_waitcnt vmcnt(" #n ")" ::: "memory")
#define PG8_WAIT_L(n) asm volatile("s_waitcnt lgkmcnt(" #n ")" ::: "memory")
#define PG8_BAR __builtin_amdgcn_s_barrier()
#define PG8_SCHED __builtin_amdgcn_sched_barrier(0)
    Unit cur, nxt; int ui = 0;
    if (!S.next(0, cur)) return;
    f32x4 acc[2][2][4][2];
#pragma unroll
    for (int a = 0; a < 2; ++a)
#pragma unroll
        for (int b = 0; b < 2; ++b)
#pragma unroll
            for (int m = 0; m < 4; ++m)
#pragma unroll
                for (int n = 0; n < 2; ++n) acc[a][b][m][n] = (f32x4){0.f, 0.f, 0.f, 0.f};
    bf16x8 At[4][2], B0[2][2], B1[2][2];
    const char* cA = (const char*)g.A + (size_t)cur.pm * tstepA; const char* cB = (const char*)g.Bt + (size_t)cur.pn * tstepB;
    S.a_ready(cur);
    if constexpr (SP2) {
        PG8_STAGE(PG8_SB(0, 0), cB, voffB); PG8_STAGE(PG8_SB(0, 1), cB + hstepB, voffB); PG8_STAGE(PG8_SA(0, 0), cA, voffA); PG8_STAGE(PG8_SA(0, 1), cA + hstepA, voffA);
        if (wr == 1) PG8_BAR;
        PG8_WAIT_V(2); PG8_BAR;
        PG8_STAGE(PG8_SB(1, 0), cB + kstepB, voffB); PG8_STAGE(PG8_SA(1, 0), cA + kstepA, voffA); PG8_STAGE(PG8_SB(1, 1), cB + hstepB + kstepB, voffB);
        PG8_WAIT_V(6); PG8_BAR;
    } else {
        PG8_STAGE(PG8_SB(0, 0), cB, voffB); PG8_STAGE(PG8_SA(0, 0), cA, voffA); PG8_STAGE(PG8_SB(0, 1), cB + hstepB, voffB); PG8_STAGE(PG8_SA(0, 1), cA + hstepA, voffA);
        if (wr == 1) PG8_BAR;
        PG8_WAIT_V(4); PG8_BAR;
        PG8_STAGE(PG8_SB(1, 0), cB + kstepB, voffB); PG8_STAGE(PG8_SA(1, 0), cA + kstepA, voffA); PG8_STAGE(PG8_SB(1, 1), cB + hstepB + kstepB, voffB);
        PG8_WAIT_V(6); PG8_BAR;
    }
    for (;;) {
        const bool has_next = S.next(ui + 1, nxt);
        const char* nA = has_next ? (const char*)g.A + (size_t)nxt.pm * tstepA : cA; const char* nB = has_next ? (const char*)g.Bt + (size_t)nxt.pn * tstepB : cB;
        for (int t = 0; t < nt; t += 2) {
            const bool last = (t == nt - 2);
            const char* a1 = cA + (size_t)(t + 1) * kstepA;
            const char* a2 = last ? nA : cA + (size_t)(t + 2) * kstepA; const char* b2 = last ? nB : cB + (size_t)(t + 2) * kstepB;
            const char* a3 = a2 + kstepA; const char* b3 = b2 + kstepB;
            if (last && has_next) S.a_ready(nxt);
            if constexpr (SP2) {
            PG8_LDB(B0, 0, 0); PG8_LDB(B1, 0, 1); PG8_SCHED; PG8_LDA(At, 0, 0); PG8_STAGE(PG8_SA(1, 1), a1 + hstepA, voffA);
            PG8_WAIT_V(8); PG8_WAIT_L(0); PG8_BAR; PG8_MMA(0, 0, At, B0); PG8_MMA(0, 1, At, B1); PG8_BAR; PG8_SCHED;
            PG8_LDA(At, 0, 1); PG8_STAGE(PG8_SB(0, 0), b2, voffB); PG8_STAGE(PG8_SB(0, 1), b2 + hstepB, voffB); PG8_STAGE(PG8_SA(0, 0), a2, voffA);
            PG8_WAIT_V(8); PG8_WAIT_L(0); PG8_BAR; PG8_MMA(1, 0, At, B0); PG8_MMA(1, 1, At, B1); PG8_BAR; PG8_SCHED;
            PG8_LDB(B0, 1, 0); PG8_LDB(B1, 1, 1); PG8_SCHED; PG8_LDA(At, 1, 0); PG8_STAGE(PG8_SA(0, 1), a2 + hstepA, voffA);
            PG8_WAIT_V(8); PG8_WAIT_L(0); PG8_BAR; PG8_MMA(0, 0, At, B0); PG8_MMA(0, 1, At, B1); PG8_BAR; PG8_SCHED;
            PG8_LDA(At, 1, 1); PG8_STAGE(PG8_SB(1, 0), b3, voffB); PG8_STAGE(PG8_SB(1, 1), b3 + hstepB, voffB); PG8_STAGE(PG8_SA(1, 0), a3, voffA);
            PG8_WAIT_V(8); PG8_WAIT_L(0); PG8_BAR; PG8_MMA(1, 0, At, B0); PG8_MMA(1, 1, At, B1); PG8_BAR; PG8_SCHED;
            } else {
            PG8_LDB(B0, 0, 0); PG8_SCHED; PG8_LDA(At, 0, 0); PG8_STAGE(PG8_SA(1, 1), a1 + hstepA, voffA);
            PG8_WAIT_L(8); PG8_BAR; PG8_WAIT_L(0); PG8_MMA(0, 0, At, B0); PG8_BAR; PG8_SCHED;
            PG8_LDB(B1, 0, 1); PG8_STAGE(PG8_SB(0, 0), b2, voffB);
            PG8_BAR; PG8_WAIT_L(0); PG8_MMA(0, 1, At, B1); PG8_BAR;
            PG8_LDA(At, 0, 1); PG8_STAGE(PG8_SA(0, 0), a2, voffA);
            PG8_BAR; PG8_WAIT_L(0); PG8_MMA(1, 0, At, B0); PG8_BAR; PG8_SCHED;
            PG8_STAGE(PG8_SB(0, 1), b2 + hstepB, voffB);
            PG8_WAIT_V(6); PG8_BAR; PG8_MMA(1, 1, At, B1); PG8_BAR;
            PG8_LDB(B0, 1, 0); PG8_SCHED; PG8_LDA(At, 1, 0); PG8_STAGE(PG8_SA(0, 1), a2 + hstepA, voffA);
            PG8_WAIT_L(8); PG8_BAR; PG8_WAIT_L(0); PG8_MMA(0, 0, At, B0); PG8_BAR; PG8_SCHED;
            PG8_LDB(B1, 1, 1); PG8_STAGE(PG8_SB(1, 0), b3, voffB);
            PG8_BAR; PG8_WAIT_L(0); PG8_MMA(0, 1, At, B1); PG8_BAR;
            PG8_LDA(At, 1, 1); PG8_STAGE(PG8_SA(1, 0), a3, voffA);
            PG8_BAR; PG8_WAIT_L(0); PG8_MMA(1, 0, At, B0); PG8_BAR; PG8_SCHED;
            PG8_STAGE(PG8_SB(1, 1), b3 + hstepB, voffB);
            PG8_WAIT_V(6); PG8_BAR; PG8_MMA(1, 1, At, B1); PG8_BAR;
            }
        }
        if constexpr (ALIGN_EPI) { if (wr == 0) PG8_BAR; }
        if constexpr (!Epi::AFTER_DRAIN) { E(acc, cur, wr, wc, fr, fq); S.done(cur); }
        if (!has_next) break;
#pragma unroll
        for (int a = 0; a < 2; ++a)
#pragma unroll
            for (int b = 0; b < 2; ++b)
#pragma unroll
                for (int m = 0; m < 4; ++m)
#pragma unroll
                    for (int n = 0; n < 2; ++n) acc[a][b][m][n] = (f32x4){0.f, 0.f, 0.f, 0.f};
        cur = nxt; cA = nA; cB = nB; ++ui;
        if constexpr (ALIGN_EPI) { if (wr == 1) PG8_BAR; }
    }
    PG8_WAIT_V(0);
    if constexpr (!ALIGN_EPI) { if (wr == 0) PG8_BAR; }
    PG8_BAR;
    if constexpr (Epi::AFTER_DRAIN) { E.fused(acc, cur, wr, wc, fr, fq, lds, wid, lane); S.done(cur); }
#undef PG8_SA
#undef PG8_SB
#undef PG8_STAGE
#undef PG8_LDA
#undef PG8_LDB
#undef PG8_MMA
#undef PG8_WAIT_V
#undef PG8_WAIT_L
#undef PG8_BAR
#undef PG8_SCHED
}
}

constexpr int D = 2048, NB = 4, S = 2048, M = NB * S, FF = 8192, H = 16, DH = 128, NBLK = 8, BLK = 256;
constexpr float EPS = 1e-6f;
constexpr int NWAVES = 8;
constexpr size_t MiB = 1u << 20;
constexpr size_t WS_CTL = 0, CTL_ZERO_BYTES = 32768;
constexpr size_t WS_WT = 1 * MiB;
constexpr size_t WE_WIN = 0, WE_WOUT = 33554432, WE_KVQ = 41943040, WE_Q1 = 54525952, WE_WO = 58720256, WE_W1 = 67108864, WE_W2 = 134217728, WE_END = 201326592;
constexpr size_t WS_XN = 385 * MiB, WS_QS = 417 * MiB, WS_KS = 449 * MiB, WS_VS = 481 * MiB, WS_GT = 513 * MiB, WS_GS = 545 * MiB, WS_OG = 609 * MiB, WS_U = 641 * MiB;
constexpr size_t WS_KRAW = 769 * MiB, WS_VV = 801 * MiB, WS_QRAW = 833 * MiB, WS_OF = 865 * MiB, WS_KN = 929 * MiB, WS_SMALL = 993 * MiB, WS_END = 994 * MiB;
constexpr size_t SM_LBS = 0, SM_KNORM = 16384, SM_QNORM = 16384 + 512, SM_KMEAN = 65536;
static_assert((4096 + 3456) * 4 <= 32768, "barrier words inside the memset");
constexpr int CW_BAR = 4096;
constexpr int RING_OFF = 0, RING_BYTES = 131072;
constexpr int LDSCTL_OFF = RING_BYTES, MISC_OFF = LDSCTL_OFF + 320;
constexpr int LDS_BYTES = 147456;

#define GAS __attribute__((address_space(1)))
#define LAS __attribute__((address_space(3)))
typedef unsigned short bf16;
typedef unsigned v4u __attribute__((ext_vector_type(4)));
typedef unsigned v2u __attribute__((ext_vector_type(2)));
typedef float f32x2 __attribute__((ext_vector_type(2)));
typedef float f32x4 __attribute__((ext_vector_type(4)));
typedef short bf16x8 __attribute__((ext_vector_type(8)));
typedef GAS unsigned gu32;
#define RLX_AGENT __ATOMIC_RELAXED, __HIP_MEMORY_SCOPE_AGENT
#define LDS_WAIT() asm volatile("s_waitcnt lgkmcnt(0)" ::: "memory")
#define VM_WAIT() asm volatile("s_waitcnt vmcnt(0)" ::: "memory")
__device__ __forceinline__ unsigned f2bf(float f) { unsigned u = __builtin_bit_cast(unsigned, f); return (u + 0x7fffu + ((u >> 16) & 1u)) >> 16; }
__device__ __forceinline__ unsigned pk2(float lo, float hi) { return f2bf(lo) | (f2bf(hi) << 16); }
__device__ __forceinline__ float bf2f(unsigned short b) { return __builtin_bit_cast(float, (unsigned)b << 16); }
__device__ __forceinline__ float bflo(unsigned w) { return __builtin_bit_cast(float, w << 16); }
__device__ __forceinline__ float bfhi(unsigned w) { return __builtin_bit_cast(float, w & 0xffff0000u); }
static_assert(WS_VS - WS_KS == WS_KS - WS_QS && WS_GT - WS_VS == WS_KS - WS_QS && WS_QRAW - WS_VV == WS_VV - WS_KRAW, "strided tensor groups");
#define XB_TMO      128
#define XB_XCNT(j)  (256  + 64 * (j))
#define XB_XSUB(j)  (1280 + 64 * (j))
#define XB_XGEN(j)  (2304 + 64 * (j))
#define XB_TOP      3328
#define XB_TOPGEN   3392
#define XCD_BAR_WORDS 3456
#define XB_SPIN_CAP (1u << 18)

__device__ __forceinline__ unsigned xb_ld(unsigned* p)              { return __hip_atomic_load(p, __ATOMIC_RELAXED, __HIP_MEMORY_SCOPE_AGENT); }
__device__ __forceinline__ unsigned xb_add(unsigned* p, unsigned v) { return __hip_atomic_fetch_add(p, v, __ATOMIC_RELAXED, __HIP_MEMORY_SCOPE_AGENT); }
__device__ __forceinline__ unsigned xb_xcc_id() { return (unsigned)__builtin_amdgcn_s_getreg((3 << 11) | 20) & 0xFu; }
#define XB_SPIN(cond, bar) do { unsigned _sp = 0; while (cond) { __builtin_amdgcn_s_sleep(1); \
    if ((++_sp & 255u) == 0u) { if (xb_ld(&(bar)[XB_TMO])) break; if (_sp > XB_SPIN_CAP) { atomicAdd(&(bar)[XB_TMO], 1u); break; } } } } while (0)

struct XcdBarrier {
    unsigned* bar; unsigned x;
    volatile LAS unsigned* st;
};

__device__ __forceinline__ XcdBarrier xcd_barrier_post(unsigned* bar, volatile LAS unsigned* st) {
    XcdBarrier b; b.bar = bar; b.x = xb_xcc_id(); b.st = st;
    if (threadIdx.x == 0) (void)xb_add(&bar[XB_XCNT(b.x)], 1u);
    return b;
}
__device__ __forceinline__ void xcd_barrier_complete(unsigned* bar, unsigned x, unsigned& nloc, unsigned& nx) {
    const unsigned G = gridDim.x * gridDim.y * gridDim.z;
    unsigned sum, cnt, mine, sp = 0u;
    for (;;) {
        sum = 0u; cnt = 0u; mine = 0u;
#pragma unroll
        for (unsigned j = 0; j < 16; ++j) { const unsigned c = xb_ld(&bar[XB_XCNT(j)]); sum += c; cnt += (c > 0u) ? 1u : 0u; mine = (j == x) ? c : mine; }
        if (sum == G) break;
        __builtin_amdgcn_s_sleep(1);
        if ((++sp & 255u) == 0u) { if (xb_ld(&bar[XB_TMO])) break; if (sp > XB_SPIN_CAP) { atomicAdd(&bar[XB_TMO], 1u); break; } }
    }
    nloc = mine > 0u ? mine : 1u; nx = cnt > 0u ? cnt : 1u;
}

__device__ __forceinline__ void xcd_barrier(const XcdBarrier& b) {
    asm volatile("s_waitcnt vmcnt(0)" ::: "memory");
    __syncthreads();
    if (threadIdx.x == 0) {
        unsigned* bar = b.bar;
        __builtin_amdgcn_s_waitcnt(0);
        unsigned nloc = b.st[0], nx = b.st[1];
        if (nloc == 0u) { xcd_barrier_complete(bar, b.x, nloc, nx); b.st[0] = nloc; b.st[1] = nx; }
        const unsigned old = xb_add(&bar[XB_XSUB(b.x)], 1u);
        const unsigned gen = old / nloc;
        if (old + 1u == (gen + 1u) * nloc) {
            __builtin_amdgcn_fence(__ATOMIC_RELEASE, "agent");
            asm volatile("s_waitcnt vmcnt(0)" ::: "memory");
            const unsigned og = xb_add(&bar[XB_TOP], 1u);
            const unsigned tg = og / nx;
            if (og + 1u == (tg + 1u) * nx) xb_add(&bar[XB_TOPGEN], 1u);
            else XB_SPIN(xb_ld(&bar[XB_TOPGEN]) == tg, bar);
            __builtin_amdgcn_fence(__ATOMIC_ACQUIRE, "agent");
            xb_add(&bar[XB_XGEN(b.x)], 1u);
            asm volatile("s_waitcnt vmcnt(0)" ::: "memory");
        } else {
            XB_SPIN(xb_ld(&bar[XB_XGEN(b.x)]) == gen, bar);
            __builtin_amdgcn_fence(__ATOMIC_ACQUIRE, "agent");
            asm volatile("s_waitcnt vmcnt(0)" ::: "memory");
        }
    }
    __syncthreads();
}


struct Args { const float* in[16]; float* out; unsigned char* ws; int ph_lo, ph_hi, li, pad; };
enum InIdx { I_X = 0, I_ANORM, I_AWIN, I_AHEAD, I_AWOUT, I_LB, I_KVNORM, I_WKV, I_KNORM, I_BNORM, I_BWQ, I_BQNORM, I_BWO, I_MLPNORM, I_W1, I_W2 };
__device__ __forceinline__ const float* in_ptr(int i) {
    const __attribute__((address_space(4))) unsigned char* ka = (const __attribute__((address_space(4))) unsigned char*)__builtin_amdgcn_kernarg_segment_ptr();
    int off = i * 8; asm volatile("" : "+s"(off));
    const float* p = *(const float* const __attribute__((address_space(4)))*)(ka + off);
    return (const float*)(const GAS float*)p;
}

struct ItemRegs { f32x4 v[8], g0, g1; };
__device__ __forceinline__ void item_load(ItemRegs& r, const float* W, const float* gain, int K, int N, int item, int lane) {
    const int nblk = N / 32, kb = item / nblk, nb = item % nblk, k0 = 64 * kb, n0 = 32 * nb;
    const int ks = lane >> 3, n4 = (lane & 7) * 4, c = lane & 7;
#pragma unroll
    for (int i = 0; i < 8; ++i) r.v[i] = __builtin_nontemporal_load((const GAS f32x4*)(W + (size_t)(k0 + ks + 8 * i) * N + n0 + n4));
    const float* gp = gain ? gain + k0 + 8 * c : W;
    r.g0 = *(const GAS f32x4*)gp; r.g1 = *(const GAS f32x4*)(gp + 4);
    if (!gain) { r.g0 = (f32x4){1.f, 1.f, 1.f, 1.f}; r.g1 = r.g0; }
}
__device__ __forceinline__ void item_finish(const ItemRegs& r, int K, int N, bf16* WT, LAS float* scr, int item, int lane, int tiled) {
    const int nblk = N / 32, kb = item / nblk, nb = item % nblk, k0 = 64 * kb, n0 = 32 * nb;
    const int ks = lane >> 3, n4 = (lane & 7) * 4, c = lane & 7;
#pragma unroll
    for (int i = 0; i < 8; ++i) { LAS float* d = scr + (ks + 8 * i) * 33 + n4; d[0] = r.v[i].x; d[1] = r.v[i].y; d[2] = r.v[i].z; d[3] = r.v[i].w; }
    LDS_WAIT(); asm volatile("" ::: "memory");
#pragma unroll
    for (int j = 0; j < 4; ++j) { const int n = (lane >> 3) + 8 * j; const LAS float* s = scr + (8 * c) * 33 + n;
        v4u o; o.x = pk2(s[0 * 33] * r.g0.x, s[1 * 33] * r.g0.y); o.y = pk2(s[2 * 33] * r.g0.z, s[3 * 33] * r.g0.w); o.z = pk2(s[4 * 33] * r.g1.x, s[5 * 33] * r.g1.y); o.w = pk2(s[6 * 33] * r.g1.z, s[7 * 33] * r.g1.w);
        bf16* dst = tiled ? WT + (((size_t)((n0 + n) >> 8) * (K / 64) + kb) * 256 + ((n0 + n) & 255)) * 64 + 8 * c
                          : WT + (size_t)(n0 + n) * K + k0 + 8 * c;
        __builtin_nontemporal_store(o, (GAS v4u*)dst); }
    LDS_WAIT(); asm volatile("" ::: "memory");
}
struct MatDesc { const float* src; const float* gain; bf16* dst; int K, N, items, tiled; };
__device__ __forceinline__ MatDesc mat_desc(bf16* WT, int id) {
    MatDesc m; int kind, l;
    if (id < 4)        { kind = id; l = 0; }
    else if (id < 8)   { kind = id - 4; l = 1; }
    else if (id == 8)  { kind = 4; l = 0; }
    else if (id == 9)  { kind = 5; l = 0; }
    else if (id == 10) { kind = 6; l = 0; }
    else if (id == 11) { kind = 2; l = 2; }
    else if (id == 12) { kind = 3; l = 2; }
    else if (id == 13) { kind = 5; l = 1; }
    else if (id == 14) { kind = 6; l = 1; }
    else if (id == 15) { kind = 2; l = 3; }
    else               { kind = 3; l = 3; }
    if (kind == 0)      { m.src = in_ptr(I_AWIN) + (size_t)l * D * 4 * D; m.gain = in_ptr(I_ANORM) + l * D; m.dst = WT + WE_WIN + (size_t)l * D * 4 * D; m.K = D; m.N = 4 * D; }
    else if (kind == 1) { m.src = in_ptr(I_AWOUT) + (size_t)l * D * D; m.gain = in_ptr(I_AHEAD) + l * D; m.dst = WT + WE_WOUT + (size_t)l * D * D; m.K = D; m.N = D; }
    else if (kind == 2) { m.src = in_ptr(I_W1) + (size_t)l * D * FF; m.gain = in_ptr(I_MLPNORM) + l * D; m.dst = WT + WE_W1 + (size_t)l * D * FF; m.K = D; m.N = FF; }
    else if (kind == 3) { m.src = in_ptr(I_W2) + (size_t)l * FF * D; m.gain = nullptr; m.dst = WT + WE_W2 + (size_t)l * FF * D; m.K = FF; m.N = D; }
    else if (kind == 4) { m.src = in_ptr(I_WKV); m.gain = in_ptr(I_KVNORM); m.dst = WT + WE_KVQ; m.K = D; m.N = 2 * D; }
    else if (kind == 5) { m.src = in_ptr(I_BWQ) + (size_t)l * D * D; m.gain = in_ptr(I_BNORM) + l * D; m.dst = l == 0 ? WT + WE_KVQ + (size_t)2 * D * D : WT + WE_Q1; m.K = D; m.N = D; }
    else                { m.src = in_ptr(I_BWO) + (size_t)l * D * D; m.gain = nullptr; m.dst = WT + WE_WO + (size_t)l * D * D; m.K = D; m.N = D; }
    m.items = (m.K / 64) * (m.N / 32); m.tiled = (kind == 3) ? 1 : 0;
    return m;
}
__device__ __forceinline__ void convert_weights(bf16* WT, int id_lo, int id_hi, int wv, int nwv, LAS float* scr, int lane) {
    int id = id_lo; MatDesc md = mat_desc(WT, id); int base = 0, it = wv;
    while (it >= base + md.items) { base += md.items; ++id; if (id >= id_hi) return; md = mat_desc(WT, id); }
    ItemRegs ra, rb;
    MatDesc ma = md; int ia = it - base; item_load(ra, ma.src, ma.gain, ma.K, ma.N, ia, lane);
    for (;;) {
        bool more = true; it += nwv;
        while (it >= base + md.items) { base += md.items; ++id; if (id >= id_hi) { more = false; break; } md = mat_desc(WT, id); }
        MatDesc mb = md; int ib = more ? it - base : 0;
        item_load(rb, mb.src, mb.gain, mb.K, mb.N, ib, lane);
        item_finish(ra, ma.K, ma.N, ma.dst, scr, ia, lane, ma.tiled);
        if (!more) return;
        it += nwv;
        while (it >= base + md.items) { base += md.items; ++id; if (id >= id_hi) { more = false; break; } md = mat_desc(WT, id); }
        ma = md; ia = more ? it - base : 0;
        item_load(ra, ma.src, ma.gain, ma.K, ma.N, ia, lane);
        item_finish(rb, mb.K, mb.N, mb.dst, scr, ib, lane, mb.tiled);
        if (!more) return;
    }
}
__device__ __forceinline__ void intake_row(const float* xrow, bf16* hbrow, float* psrow, int lane) {
    const GAS f32x4* xr = (const GAS f32x4*)xrow + lane;
    f32x4 v[8]; float s = 0.f;
#pragma unroll
    for (int j = 0; j < 8; ++j) { v[j] = xr[64 * j]; s += (v[j].x * v[j].x + v[j].y * v[j].y) + (v[j].z * v[j].z + v[j].w * v[j].w); }
    s = wave_sum(s);
    GAS v2u* o8 = (GAS v2u*)hbrow + lane;
#pragma unroll
    for (int j = 0; j < 8; ++j) { v2u w; w.x = pk2(v[j].x, v[j].y); w.y = pk2(v[j].z, v[j].w); o8[64 * j] = w; }
    if (lane < 32) psrow[lane] = (lane == 0) ? s : 0.f;
}

constexpr int GC = 64, NCH = S / GC, GSPLIT = 20;
constexpr int GQ_PT = 0, GQ_SS = 4096, GQ_QT = 5120, GQ_KT = GQ_QT + 64 * 272, GQ_VT = GQ_KT + 64 * 272, GQ_AM = GQ_VT + 128 * 144, GQ_SX = 67584, GQ_KDT = GQ_SX + 128 * 272;
static_assert(GQ_AM + 64 * 144 <= GQ_SX && GQ_KDT + 128 * 144 <= RING_BYTES, "GLA LDS map");
__device__ __forceinline__ bf16x8 lds_frag(LAS const unsigned char* base, int stride_bytes, int row0, int k0, int lane) {
    return *(const LAS bf16x8*)(base + (row0 + (lane & 15)) * stride_bytes + (k0 + 8 * (lane >> 4)) * 2);
}
__device__ __forceinline__ unsigned cvtpk_bf16(float lo, float hi) { unsigned r; asm("v_cvt_pk_bf16_f32 %0, %1, %2" : "=v"(r) : "v"(lo), "v"(hi)); return r; }
__device__ __forceinline__ void gla_seq(int bh, int c_pre, int c_lo, int c_hi, const bf16* QS, const bf16* KS, const bf16* VS, const float* GS, const bf16* GT, bf16* OG, LAS unsigned char* L, int tid) {
    const int b = bh >> 4, h = bh & 15;
    const int lane = tid & 63, w = __builtin_amdgcn_readfirstlane(tid >> 6);
    const int tt = w >> 1, sh = w & 1, g4 = 4 * (lane >> 4), l15 = lane & 15;
    LAS float* PT = (LAS float*)(L + GQ_PT); LAS float* SS = (LAS float*)(L + GQ_SS);
    const size_t ebase = (size_t)b * S * D + h * DH;
    const __amdgpu_buffer_rsrc_t rq = __builtin_amdgcn_make_buffer_rsrc((void*)(QS + ebase), 0, S * D * 2, 0x00020000), rk = __builtin_amdgcn_make_buffer_rsrc((void*)(KS + ebase), 0, S * D * 2, 0x00020000);
    const __amdgpu_buffer_rsrc_t rv = __builtin_amdgcn_make_buffer_rsrc((void*)(VS + ebase), 0, S * D * 2, 0x00020000), rg = __builtin_amdgcn_make_buffer_rsrc((void*)(GS + ebase), 0, S * D * 4, 0x00020000);
    const __amdgpu_buffer_rsrc_t rt = __builtin_amdgcn_make_buffer_rsrc((void*)(GT + ebase), 0, S * D * 2, 0x00020000), ro = __builtin_amdgcn_make_buffer_rsrc((void*)(OG + ebase), 0, S * D * 2, 0x00020000);
    const unsigned vo2 = (unsigned)((w * 8) * D + 2 * lane) * 2u, vo4 = vo2 * 2u;
    const unsigned vrow = (unsigned)((lane >> 2) * D + 16 * (lane & 3)) * 2u;
    f32x4 st[8];
#pragma unroll
    for (int j = 0; j < 8; ++j) st[j] = (f32x4){0.f, 0.f, 0.f, 0.f};
    f32x2 cs[8], gr[8]; unsigned qq[8], vv[8];
#define GLA_LOAD_GV(c) do { const int so_ = (c) * GC * D * 2; \
        _Pragma("unroll") for (int i = 0; i < 8; ++i) { const v2u g_ = __builtin_amdgcn_raw_buffer_load_b64(rg, vo4, 2 * (so_ + i * D * 2), 0); gr[i] = (f32x2){__uint_as_float(g_.x), __uint_as_float(g_.y)}; } \
        _Pragma("unroll") for (int i = 0; i < 8; ++i) vv[i] = __builtin_amdgcn_raw_buffer_load_b32(rv, vo2, so_ + i * D * 2, 0); } while (0)
#define GLA_LOAD_Q(c) do { const int so_ = (c) * GC * D * 2; _Pragma("unroll") for (int i = 0; i < 8; ++i) qq[i] = __builtin_amdgcn_raw_buffer_load_b32(rq, vo2, so_ + i * D * 2, 0); } while (0)
#define GLA_CUMSUM() do { f32x2 run_ = (f32x2){0.f, 0.f}; _Pragma("unroll") for (int i = 0; i < 8; ++i) { run_ += gr[i]; cs[i] = run_; } } while (0)
#define GLA_UPDATE() do { _Pragma("unroll") for (int j = 0; j < 8; ++j) st[j] = st[j] * dr; \
        _Pragma("unroll") for (int ks = 0; ks < 2; ++ks) { const bf16x8 a = lds_frag(L + GQ_KDT, 144, 16 * w, 32 * ks, lane); \
            _Pragma("unroll") for (int j = 0; j < 8; ++j) st[j] = __builtin_amdgcn_mfma_f32_16x16x32_bf16(a, lds_frag(L + GQ_VT, 144, 16 * j, 32 * ks, lane), st[j], 0, 0, 0); } } while (0)
#define GLA_VT_WRITE() do { \
        *(LAS v4u*)(L + GQ_VT + (2 * lane) * 144 + w * 16) = (v4u){(vv[0] & 0xffffu) | (vv[1] << 16), (vv[2] & 0xffffu) | (vv[3] << 16), (vv[4] & 0xffffu) | (vv[5] << 16), (vv[6] & 0xffffu) | (vv[7] << 16)}; \
        *(LAS v4u*)(L + GQ_VT + (2 * lane + 1) * 144 + w * 16) = (v4u){(vv[0] >> 16) | (vv[1] & 0xffff0000u), (vv[2] >> 16) | (vv[3] & 0xffff0000u), (vv[4] >> 16) | (vv[5] & 0xffff0000u), (vv[6] >> 16) | (vv[7] & 0xffff0000u)}; } while (0)
#define GLA_BAR() do { asm volatile("s_waitcnt lgkmcnt(0)" ::: "memory"); __builtin_amdgcn_s_barrier(); asm volatile("" ::: "memory"); } while (0)
    GLA_LOAD_GV(0);
    for (int c = 0; c < c_pre; ++c) {
        GLA_CUMSUM();
        *(LAS f32x2*)(PT + w * 128 + 2 * lane) = cs[7];
        GLA_BAR();
        {
            f32x2 offs = (f32x2){0.f, 0.f}, tot = offs;
#pragma unroll
            for (int p = 0; p < 8; ++p) { const f32x2 x = *(const LAS f32x2*)(PT + p * 128 + 2 * lane); tot += x; if (p < w) offs += x; }
            offs = tot - offs;
            unsigned kd0[4], kd1[4]; f32x2 kdp;
#pragma unroll
            for (int i = 0; i < 8; ++i) { const f32x2 y = offs - cs[i];
                const f32x2 kd = ((f32x2){1.f, 1.f} - (f32x2){__builtin_amdgcn_exp2f(gr[i].x), __builtin_amdgcn_exp2f(gr[i].y)}) * (f32x2){__builtin_amdgcn_exp2f(y.x), __builtin_amdgcn_exp2f(y.y)};
                if (i & 1) { kd0[i >> 1] = cvtpk_bf16(kdp.x, kd.x); kd1[i >> 1] = cvtpk_bf16(kdp.y, kd.y); } else kdp = kd; }
            *(LAS v4u*)(L + GQ_KDT + (2 * lane) * 144 + w * 16) = (v4u){kd0[0], kd0[1], kd0[2], kd0[3]};
            *(LAS v4u*)(L + GQ_KDT + (2 * lane + 1) * 144 + w * 16) = (v4u){kd1[0], kd1[1], kd1[2], kd1[3]};
            GLA_VT_WRITE();
        }
        f32x4 dr;
        {
            const int d0 = 16 * w + g4;
            const f32x4 pa = (*(const LAS f32x4*)(PT + d0) + *(const LAS f32x4*)(PT + 128 + d0)) + (*(const LAS f32x4*)(PT + 256 + d0) + *(const LAS f32x4*)(PT + 384 + d0));
            const f32x4 pb = (*(const LAS f32x4*)(PT + 512 + d0) + *(const LAS f32x4*)(PT + 640 + d0)) + (*(const LAS f32x4*)(PT + 768 + d0) + *(const LAS f32x4*)(PT + 896 + d0));
#pragma unroll
            for (int r = 0; r < 4; ++r) dr[r] = __builtin_amdgcn_exp2f(pa[r] + pb[r]);
        }
        GLA_LOAD_GV(c + 1);
        GLA_BAR();
        GLA_UPDATE();
    }
    GLA_LOAD_Q(c_lo);
    for (int c = c_lo; c < c_hi; ++c) {
        GLA_CUMSUM();
        *(LAS f32x2*)(PT + w * 128 + 2 * lane) = cs[7];
        GLA_BAR();
        {
            f32x2 offs = (f32x2){0.f, 0.f}, bref = offs, tot = offs;
#pragma unroll
            for (int p = 0; p < 8; ++p) { const f32x2 x = *(const LAS f32x2*)(PT + p * 128 + 2 * lane); tot += x; if (p < 4) bref += x; if (p < w) offs += x; }
            const f32x2 fdec = (f32x2){__builtin_amdgcn_exp2f(tot.x - bref.x), __builtin_amdgcn_exp2f(tot.y - bref.y)};
            offs -= bref;
            unsigned kd0[4], kd1[4]; f32x2 kdp;
#pragma unroll
            for (int i = 0; i < 8; ++i) { const f32x2 x = offs + cs[i];
                const f32x2 e1 = (f32x2){__builtin_amdgcn_exp2f(x.x), __builtin_amdgcn_exp2f(x.y)}, e2 = (f32x2){__builtin_amdgcn_exp2f(-x.x), __builtin_amdgcn_exp2f(-x.y)};
                const f32x2 qf = (f32x2){__uint_as_float(qq[i] << 16), __uint_as_float(qq[i] & 0xffff0000u)} * e1, kf = ((f32x2){1.f, 1.f} - (f32x2){__builtin_amdgcn_exp2f(gr[i].x), __builtin_amdgcn_exp2f(gr[i].y)}) * e2;
                *(LAS unsigned*)(L + GQ_QT + (w * 8 + i) * 272 + lane * 4) = cvtpk_bf16(qf.x, qf.y);
                *(LAS unsigned*)(L + GQ_KT + (w * 8 + i) * 272 + lane * 4) = cvtpk_bf16(kf.x, kf.y);
                const f32x2 kd = kf * fdec;
                if (i & 1) { kd0[i >> 1] = cvtpk_bf16(kdp.x, kd.x); kd1[i >> 1] = cvtpk_bf16(kdp.y, kd.y); } else kdp = kd; }
            *(LAS v4u*)(L + GQ_KDT + (2 * lane) * 144 + w * 16) = (v4u){kd0[0], kd0[1], kd0[2], kd0[3]};
            *(LAS v4u*)(L + GQ_KDT + (2 * lane + 1) * 144 + w * 16) = (v4u){kd1[0], kd1[1], kd1[2], kd1[3]};
            GLA_VT_WRITE();
        }
        f32x4 dr;
        {
            const int d0 = 16 * w + g4;
            const f32x4 pa = (*(const LAS f32x4*)(PT + d0) + *(const LAS f32x4*)(PT + 128 + d0)) + (*(const LAS f32x4*)(PT + 256 + d0) + *(const LAS f32x4*)(PT + 384 + d0));
            const f32x4 pb = (*(const LAS f32x4*)(PT + 512 + d0) + *(const LAS f32x4*)(PT + 640 + d0)) + (*(const LAS f32x4*)(PT + 768 + d0) + *(const LAS f32x4*)(PT + 896 + d0));
            f32x4 er;
#pragma unroll
            for (int r = 0; r < 4; ++r) { er[r] = __builtin_amdgcn_exp2f(pa[r]); dr[r] = __builtin_amdgcn_exp2f(pa[r] + pb[r]); }
#pragma unroll
            for (int j = 0; j < 8; ++j) { v2u o; o.x = cvtpk_bf16(st[j][0] * er[0], st[j][1] * er[1]); o.y = cvtpk_bf16(st[j][2] * er[2], st[j][3] * er[3]);
                *(LAS v2u*)(L + GQ_SX + (16 * j + l15) * 272 + d0 * 2) = o; }
        }
        { const int cn = (c + 1 < NCH) ? c + 1 : c; GLA_LOAD_GV(cn); GLA_LOAD_Q(cn); }
        const int so_out = ((c * GC + 16 * tt) * D + 64 * sh) * 2;
        const v4u gta = __builtin_amdgcn_raw_buffer_load_b128(rt, vrow, so_out, 0), gtb = __builtin_amdgcn_raw_buffer_load_b128(rt, vrow, so_out + 16, 0);
        GLA_BAR();
#pragma unroll
        for (int u = 0; u < 2; ++u) { const int stl = 2 * sh + u; f32x4 a = (f32x4){0.f, 0.f, 0.f, 0.f};
            if (stl <= tt) {
#pragma unroll
                for (int ks = 0; ks < 4; ++ks) a = __builtin_amdgcn_mfma_f32_16x16x32_bf16(lds_frag(L + GQ_QT, 272, 16 * tt, 32 * ks, lane), lds_frag(L + GQ_KT, 272, 16 * stl, 32 * ks, lane), a, 0, 0, 0);
            }
            const int s_ = 16 * stl + l15, t0 = 16 * tt + g4;
            const unsigned w01 = cvtpk_bf16(s_ <= t0 ? a[0] : 0.f, s_ <= t0 + 1 ? a[1] : 0.f), w23 = cvtpk_bf16(s_ <= t0 + 2 ? a[2] : 0.f, s_ <= t0 + 3 ? a[3] : 0.f);
            *(LAS unsigned short*)(L + GQ_AM + (t0 + 0) * 144 + s_ * 2) = (unsigned short)w01; *(LAS unsigned short*)(L + GQ_AM + (t0 + 1) * 144 + s_ * 2) = (unsigned short)(w01 >> 16);
            *(LAS unsigned short*)(L + GQ_AM + (t0 + 2) * 144 + s_ * 2) = (unsigned short)w23; *(LAS unsigned short*)(L + GQ_AM + (t0 + 3) * 144 + s_ * 2) = (unsigned short)(w23 >> 16); }
        GLA_UPDATE();
        GLA_BAR();
        f32x4 acc[4];
#pragma unroll
        for (int j = 0; j < 4; ++j) acc[j] = (f32x4){0.f, 0.f, 0.f, 0.f};
#pragma unroll
        for (int ks = 0; ks < 4; ++ks) { const bf16x8 a = lds_frag(L + GQ_QT, 272, 16 * tt, 32 * ks, lane);
#pragma unroll
            for (int j = 0; j < 4; ++j) acc[j] = __builtin_amdgcn_mfma_f32_16x16x32_bf16(a, lds_frag(L + GQ_SX, 272, 16 * (4 * sh + j), 32 * ks, lane), acc[j], 0, 0, 0); }
#pragma unroll
        for (int ks = 0; ks < 2; ++ks) { const bf16x8 a = lds_frag(L + GQ_AM, 144, 16 * tt, 32 * ks, lane);
#pragma unroll
            for (int j = 0; j < 4; ++j) acc[j] = __builtin_amdgcn_mfma_f32_16x16x32_bf16(a, lds_frag(L + GQ_VT, 144, 16 * (4 * sh + j), 32 * ks, lane), acc[j], 0, 0, 0); }
        float ssq[4];
#pragma unroll
        for (int r = 0; r < 4; ++r) { float x = 0.f;
#pragma unroll
            for (int j = 0; j < 4; ++j) x += acc[j][r] * acc[j][r];
            ssq[r] = sum16(x); }
        if (l15 == 0) {
#pragma unroll
            for (int r = 0; r < 4; ++r) SS[(16 * tt + g4 + r) * 2 + sh] = ssq[r]; }
        GLA_BAR();
        {
            LAS unsigned char* scr = L + GQ_SX + w * 4352;
#pragma unroll
            for (int r = 0; r < 4; ++r) { const int t = 16 * tt + g4 + r;
                const float rn = rsqrtf((SS[t * 2] + SS[t * 2 + 1]) * (1.0f / DH) + EPS);
#pragma unroll
                for (int j = 0; j < 4; ++j) *(LAS float*)(scr + (g4 + r) * 272 + (16 * j + l15) * 4) = acc[j][r] * rn; }
            asm volatile("s_waitcnt lgkmcnt(0)" ::: "memory");
            const LAS unsigned char* rp = scr + (lane >> 2) * 272 + (lane & 3) * 64;
            const f32x4 o0 = *(const LAS f32x4*)(rp), o1 = *(const LAS f32x4*)(rp + 16), o2 = *(const LAS f32x4*)(rp + 32), o3 = *(const LAS f32x4*)(rp + 48);
#define GMUL(o, gw) cvtpk_bf16(o[0] * __uint_as_float(gw.x << 16), o[1] * __uint_as_float(gw.x & 0xffff0000u)), cvtpk_bf16(o[2] * __uint_as_float(gw.y << 16), o[3] * __uint_as_float(gw.y & 0xffff0000u))
            const v2u ga0 = (v2u){gta.x, gta.y}, ga1 = (v2u){gta.z, gta.w}, gb0 = (v2u){gtb.x, gtb.y}, gb1 = (v2u){gtb.z, gtb.w};
            const v4u wa = (v4u){GMUL(o0, ga0), GMUL(o1, ga1)}, wb = (v4u){GMUL(o2, gb0), GMUL(o3, gb1)};
#undef GMUL
            __builtin_amdgcn_raw_buffer_store_b128(wa, ro, vrow, so_out, 0); __builtin_amdgcn_raw_buffer_store_b128(wb, ro, vrow, so_out + 16, 0);
        }
    }
#undef GLA_LOAD_GV
#undef GLA_LOAD_Q
#undef GLA_CUMSUM
#undef GLA_UPDATE
#undef GLA_VT_WRITE
#undef GLA_BAR
}


namespace moba {
using f32x16 = __attribute__((ext_vector_type(16))) float;
using s16x4  = __attribute__((ext_vector_type(4))) short;
using u32x4  = __attribute__((ext_vector_type(4))) unsigned;
constexpr int LD = 2048;
constexpr float SCALE = 0.088388347648318440f;
constexpr float C2 = SCALE * 1.4426950408889634f;
constexpr float THR_RAW = 8.0f / SCALE;
constexpr size_t SHM_V = 64 * 128 * 2, SHM_K = 64 * 128 * 2;
constexpr int OFF_WS = 2 * SHM_V + 2 * SHM_K, OFF_KM = OFF_WS + 8 * 64 * 4, ATT_LDS = OFF_KM + 8 * 128 * 4;
#define KSWZ(row, colB) ((row) * 256 + ((colB) ^ (((row) & 7) << 4)))
#define SBAR() __builtin_amdgcn_sched_barrier(0)
__device__ __forceinline__ int crow(int r, int hi) { return (r & 3) + 8 * (r >> 2) + 4 * hi; }
__device__ __forceinline__ unsigned cvtpk(float lo, float hi) { unsigned r; asm volatile("v_cvt_pk_bf16_f32 %0, %1, %2" : "=v"(r) : "v"(lo), "v"(hi)); return r; }
__device__ __forceinline__ void partialSM(f32x16& p0, f32x16& p1, float& m_reg, float& mn, float& alpha, float a, float yl, bool diag, int dlim, int hi) {
    const float NINF = -__builtin_inff();
    const float a3 = 3.f * a, a8 = 8.f * a, a24 = 24.f * a, a32 = 32.f * a;
#pragma unroll
    for (int r = 0; r < 16; ++r) { const int i = r & 3, k = r >> 2; float x = p0[r], z = p1[r];
        if (i == 1) { x += a; z += a; } else if (i == 2) { x = fmaf(a, 2.f, x); z = fmaf(a, 2.f, z); } else if (i == 3) { x += a3; z += a3; }
        if (k == 1) { x += a8; z += a8; } else if (k == 2) { x = fmaf(a8, 2.f, x); z = fmaf(a8, 2.f, z); } else if (k == 3) { x += a24; z += a24; }
        p0[r] = x; p1[r] = z; }
    if (diag) {
#pragma unroll
        for (int r = 0; r < 16; ++r) { const int k0 = (r & 3) + 8 * (r >> 2); p0[r] = (k0 > dlim) ? NINF : p0[r]; p1[r] = (32 + k0 > dlim) ? NINF : p1[r]; }
    }
    float pmax = p0[0], pmax1 = p1[0];
#pragma unroll
    for (int r = 1; r < 16; ++r) { pmax = fmaxf(pmax, p0[r]); pmax1 = fmaxf(pmax1, p1[r]); }
    pmax = fmaxf(pmax, pmax1 + a32) + yl;
    { auto rr = __builtin_amdgcn_permlane32_swap(__float_as_uint(pmax), __float_as_uint(pmax), false, false);
      pmax = fmaxf(__uint_as_float(rr[0]), __uint_as_float(rr[1])); }
    if (__builtin_expect(__all(pmax - m_reg <= THR_RAW), 1)) { mn = m_reg; alpha = 1.f; }
    else { mn = fmaxf(m_reg, pmax); alpha = __builtin_amdgcn_exp2f((m_reg - mn) * C2); m_reg = mn; }
    const float mnC = (yl - mn) * C2, mnC1 = (yl - mn + a32) * C2;
#pragma unroll
    for (int r = 0; r < 16; ++r) { p0[r] = fmaf(p0[r], C2, mnC); p1[r] = fmaf(p1[r], C2, mnC1); }
#pragma unroll
    for (int r = 0; r < 16; ++r) p0[r] = __builtin_amdgcn_exp2f(p0[r]);
}
__device__ __forceinline__ void finishSM(f32x16& p0, f32x16& p1, float alpha, float& l_reg, bf16x8& pa0, bf16x8& pa1, bf16x8& pa2, bf16x8& pa3) {
#pragma unroll
    for (int r = 0; r < 16; ++r) p1[r] = __builtin_amdgcn_exp2f(p1[r]);
    float ps = 0.f;
#pragma unroll
    for (int r = 0; r < 16; ++r) ps += p0[r];
#pragma unroll
    for (int r = 0; r < 16; ++r) ps += p1[r];
    { auto rr = __builtin_amdgcn_permlane32_swap(__float_as_uint(ps), __float_as_uint(ps), false, false);
      ps = __uint_as_float(rr[0]) + __uint_as_float(rr[1]); }
    l_reg = l_reg * alpha + ps;
#define PK4(P, BASE, OUT) do { unsigned a0 = cvtpk(P[BASE + 0], P[BASE + 1]), a1 = cvtpk(P[BASE + 2], P[BASE + 3]);   \
    unsigned b0 = cvtpk(P[BASE + 4], P[BASE + 5]), b1 = cvtpk(P[BASE + 6], P[BASE + 7]);                              \
    auto r0 = __builtin_amdgcn_permlane32_swap(a0, b0, false, false); auto r1 = __builtin_amdgcn_permlane32_swap(a1, b1, false, false); \
    u32x4 w = {r0[0], r1[0], r0[1], r1[1]}; OUT = *reinterpret_cast<bf16x8*>(&w); } while (0)
    PK4(p0, 0, pa0); PK4(p0, 8, pa1); PK4(p1, 0, pa2); PK4(p1, 8, pa3);
#undef PK4
}
__device__ __forceinline__ void qkt(f32x16& p0, f32x16& p1, const LAS char* Ks, const bf16x8* qr, int r32, int hi) {
    p0 = f32x16{}; p1 = f32x16{};
#pragma unroll
    for (int d0 = 0; d0 < 8; ++d0) { const int cb = (d0 * 16 + hi * 8) * 2;
        const bf16x8 b0 = *(const LAS bf16x8*)(Ks + KSWZ(r32, cb));
        const bf16x8 b1 = *(const LAS bf16x8*)(Ks + KSWZ(32 + r32, cb));
        p0 = __builtin_amdgcn_mfma_f32_32x32x16_bf16(b0, qr[d0], p0, 0, 0, 0);
        p1 = __builtin_amdgcn_mfma_f32_32x32x16_bf16(b1, qr[d0], p1, 0, 0, 0); }
}
__device__ __forceinline__ int v_st(int k, int c) { const int kk = (k & ~0xC) | ((k & 4) << 1) | ((k & 8) >> 1); return ((kk >> 3) * 4 + (c >> 5)) * 512 + ((kk & 7) * 32 + (c & 31)) * 2; }
__device__ __forceinline__ int v_rd_base(int lane) { return ((lane & 3) << 3) | (((lane >> 2) & 3) << 6) | (((lane >> 4) & 1) << 5) | (((lane >> 5) & 1) << 8); }
constexpr int v_rd_off(int d0, int ks, int half) { return d0 * 512 + ks * 4096 + half * 2048; }
template <int OFF> __device__ __forceinline__ s16x4 tr_read(int vb) {
    s16x4 r; asm volatile("ds_read_b64_tr_b16 %0, %1 offset:%2" : "=&v"(r) : "v"(vb), "i"(OFF) : "memory"); return r;
}
template <int D0> __device__ __forceinline__ void pv_one(f32x16& od, int vb, bf16x8 pa0, bf16x8 pa1, bf16x8 pa2, bf16x8 pa3) {
    const s16x4 l0 = tr_read<v_rd_off(D0, 0, 0)>(vb), h0 = tr_read<v_rd_off(D0, 0, 1)>(vb), l1 = tr_read<v_rd_off(D0, 1, 0)>(vb), h1 = tr_read<v_rd_off(D0, 1, 1)>(vb);
    const s16x4 l2 = tr_read<v_rd_off(D0, 2, 0)>(vb), h2 = tr_read<v_rd_off(D0, 2, 1)>(vb), l3 = tr_read<v_rd_off(D0, 3, 0)>(vb), h3 = tr_read<v_rd_off(D0, 3, 1)>(vb);
    asm volatile("s_waitcnt lgkmcnt(0)" ::: "memory"); SBAR();
#define PK(L, H) (bf16x8){L[0], L[1], L[2], L[3], H[0], H[1], H[2], H[3]}
    od = __builtin_amdgcn_mfma_f32_32x32x16_bf16(pa0, PK(l0, h0), od, 0, 0, 0);
    od = __builtin_amdgcn_mfma_f32_32x32x16_bf16(pa1, PK(l1, h1), od, 0, 0, 0);
    od = __builtin_amdgcn_mfma_f32_32x32x16_bf16(pa2, PK(l2, h2), od, 0, 0, 0);
    od = __builtin_amdgcn_mfma_f32_32x32x16_bf16(pa3, PK(l3, h3), od, 0, 0, 0);
#undef PK
}
__device__ __forceinline__ void pv_d0(f32x16* o, int vb, bf16x8 pa0, bf16x8 pa1, bf16x8 pa2, bf16x8 pa3) {
    pv_one<0>(o[0], vb, pa0, pa1, pa2, pa3); pv_one<1>(o[1], vb, pa0, pa1, pa2, pa3); pv_one<2>(o[2], vb, pa0, pa1, pa2, pa3); pv_one<3>(o[3], vb, pa0, pa1, pa2, pa3);
}
__device__ __forceinline__ void unit(const bf16* __restrict__ Qb, const bf16* __restrict__ Kh, const bf16* __restrict__ Vh, bf16* __restrict__ Ob,
                                     const float* __restrict__ qn, const float* __restrict__ kmp, int qb, int h, LAS char* lds, int tid_in) {
    int tid = tid_in;
    const int wid = __builtin_amdgcn_readfirstlane(tid >> 6), lane = tid & 63, r32 = lane & 31, hi = lane >> 5;
    LAS char* V_lds = lds; LAS char* K_lds = lds + 2 * SHM_V;
    LAS float* wsf = (LAS float*)(lds + OFF_WS) + wid * 64; LAS float* li_l = wsf; LAS float* al_l = wsf + 32;
    LAS float* KM = (LAS float*)(lds + OFF_KM);
    for (int i = tid; i < 8 * 128; i += 512) { const int n = i >> 7, d = i & 127; const float* p = kmp + (size_t)n * 512 + d; KM[i] = ((p[0] + p[128]) + (p[256] + p[384])) * (1.0f / 256.0f); }
    __syncthreads();
    float m_reg = -1e30f, l_reg = 0.f; bf16x8 qr[8];
    unsigned selmask;
    {
        const bf16* Qw = Qb + (size_t)(wid * 32 + r32) * LD + hi * 8;
        v4u raw[8]; float ss = 0.f;
#pragma unroll
        for (int d0 = 0; d0 < 8; ++d0) { raw[d0] = *(const v4u*)(Qw + d0 * 16);
            const float x0 = bflo(raw[d0].x), x1 = bfhi(raw[d0].x), x2 = bflo(raw[d0].y), x3 = bfhi(raw[d0].y), x4 = bflo(raw[d0].z), x5 = bfhi(raw[d0].z), x6 = bflo(raw[d0].w), x7 = bfhi(raw[d0].w);
            ss += (x0 * x0 + x1 * x1) + (x2 * x2 + x3 * x3) + (x4 * x4 + x5 * x5) + (x6 * x6 + x7 * x7); }
        ss = half_sum(ss);
        const float rinv = rsqrtf(ss * (1.0f / 128.0f) + EPS);
        float gate[8];
#pragma unroll
        for (int n = 0; n < 8; ++n) gate[n] = 0.f;
#pragma unroll
        for (int d0 = 0; d0 < 8; ++d0) { const f32x4 g0 = *(const f32x4*)(qn + d0 * 16 + hi * 8), g1 = *(const f32x4*)(qn + d0 * 16 + hi * 8 + 4);
            const float q0 = bflo(raw[d0].x) * rinv * g0.x, q1 = bfhi(raw[d0].x) * rinv * g0.y, q2 = bflo(raw[d0].y) * rinv * g0.z, q3 = bfhi(raw[d0].y) * rinv * g0.w;
            const float q4 = bflo(raw[d0].z) * rinv * g1.x, q5 = bfhi(raw[d0].z) * rinv * g1.y, q6 = bflo(raw[d0].w) * rinv * g1.z, q7 = bfhi(raw[d0].w) * rinv * g1.w;
            if (qb > 3) {
#pragma unroll
                for (int n = 0; n < 8; ++n) { const f32x4 k0 = *(const LAS f32x4*)(KM + n * 128 + d0 * 16 + hi * 8), k1 = *(const LAS f32x4*)(KM + n * 128 + d0 * 16 + hi * 8 + 4);
                    gate[n] += (q0 * k0.x + q1 * k0.y) + (q2 * k0.z + q3 * k0.w) + (q4 * k1.x + q5 * k1.y) + (q6 * k1.z + q7 * k1.w); } }
            u32x4 w = {cvtpk(q0, q1), cvtpk(q2, q3), cvtpk(q4, q5), cvtpk(q6, q7)};
            qr[d0] = *reinterpret_cast<bf16x8*>(&w); }
        selmask = 0u;
        if (qb <= 3) selmask = (1u << qb) - 1u;
        else {
#pragma unroll
            for (int n = 0; n < 8; ++n) { gate[n] = half_sum(gate[n]); gate[n] = (n < qb) ? gate[n] : -3e38f; }
#pragma unroll
            for (int it = 0; it < 3; ++it) { float best = -3e38f; int bi = 0;
#pragma unroll
                for (int n = 0; n < 8; ++n) { const bool ok = (n < qb) && !((selmask >> n) & 1u); if (ok && gate[n] > best) { best = gate[n]; bi = n; } }
                selmask |= 1u << bi; }
        }
        selmask |= 1u << qb;
    }
    asm volatile("" : "+v"(tid));
    f32x16 o[4] = {};
    float a = exp2f(-0.5f * (float)(h + 1)) * (1.0f / SCALE);
    asm volatile("" : "+v"(a));
    const float NINF = -__builtin_inff();
    const int trow = wid * 32 + r32;
#define TILE_PARAMS(j, yl, dg, dl) do { const int n_ = (j) >> 2, jj_ = (j) & 3; const float yb_ = a * (float)(64 * (j) - 256 * qb + 4 * hi); \
        if (n_ < qb) { yl = ((selmask >> n_) & 1u) ? yb_ : NINF; dg = false; dl = 0; } \
        else if (64 * jj_ + 63 <= 32 * wid) { yl = yb_; dg = false; dl = 0; } \
        else if (64 * jj_ > 32 * wid + 31) { yl = NINF; dg = false; dl = 0; } \
        else { yl = yb_; dg = true; dl = trow - 64 * jj_ - 4 * hi; } } while (0)
    const int sr = tid >> 4, sc = (tid & 15) * 8, vst0 = v_st(sr, sc), vst1 = v_st(32 + sr, sc);
    const int vb0 = (int)(uintptr_t)V_lds + v_rd_base(tid & 63);
    const unsigned goff0 = (unsigned)(sr * LD + sc) * 2u, goff1 = goff0 + 32u * LD * 2u;
    struct { bf16x8 vs0, vs1, ks0, ks1; } sr_[1];
#define SLOAD(i, k0) do { const char* vt_ = (const char*)Vh + (size_t)(k0) * (LD * 2); const char* kt_ = (const char*)Kh + (size_t)(k0) * (LD * 2); \
    sr_[i].vs0 = *(const bf16x8*)(vt_ + goff0); sr_[i].vs1 = *(const bf16x8*)(vt_ + goff1); sr_[i].ks0 = *(const bf16x8*)(kt_ + goff0); sr_[i].ks1 = *(const bf16x8*)(kt_ + goff1); } while (0)
#define SWRITE(b, i) do { *(LAS bf16x8*)(V_lds + (b) * SHM_V + vst0) = sr_[i].vs0;          \
    *(LAS bf16x8*)(V_lds + (b) * SHM_V + vst1) = sr_[i].vs1; const int kc = sc * 2;               \
    *(LAS bf16x8*)(K_lds + (b) * SHM_K + KSWZ(sr, kc)) = sr_[i].ks0;                       \
    *(LAS bf16x8*)(K_lds + (b) * SHM_K + KSWZ(32 + sr, kc)) = sr_[i].ks1; } while (0)
#define SWAIT() asm volatile("s_waitcnt vmcnt(0)" ::: "memory")
#define RESC(al) do { if (__any((al) < 1.f)) { if (hi == 0) al_l[r32] = (al); asm volatile("s_waitcnt lgkmcnt(0)" ::: "memory"); \
    _Pragma("unroll") for (int d = 0; d < 4; ++d) _Pragma("unroll") for (int r = 0; r < 16; ++r) o[d][r] *= al_l[crow(r, hi)]; } } while (0)
    f32x16 pA0, pA1, pB0, pB1; float mnA, mnB, alA, alB; bf16x8 pa0, pa1, pa2, pa3; const int NT = 4 * (qb + 1);
    float yl; bool dg; int dl;
    constexpr int SE = 0, SO = 0;
    SLOAD(SE, 0); asm volatile("s_waitcnt vmcnt(0)" ::: "memory"); SWRITE(0, SE); __syncthreads();
    qkt(pA0, pA1, K_lds, qr, r32, hi); TILE_PARAMS(0, yl, dg, dl); partialSM(pA0, pA1, m_reg, mnA, alA, a, yl, dg, dl, hi);
    SLOAD(SO, 64);
    SWAIT(); SWRITE(1, SO); __syncthreads();
    for (int j = 1; j + 1 < NT; j += 2) {
        SBAR(); qkt(pB0, pB1, K_lds + SHM_K, qr, r32, hi);
        finishSM(pA0, pA1, alA, l_reg, pa0, pa1, pa2, pa3); SBAR();
        SLOAD(SO, (j + 1) * 64); SBAR();
        pv_d0(o, vb0, pa0, pa1, pa2, pa3); TILE_PARAMS(j, yl, dg, dl); partialSM(pB0, pB1, m_reg, mnB, alB, a, yl, dg, dl, hi);
        __syncthreads(); SWAIT(); SWRITE(0, SE);
        RESC(alB); __syncthreads();
        SBAR(); qkt(pA0, pA1, K_lds, qr, r32, hi);
        finishSM(pB0, pB1, alB, l_reg, pa0, pa1, pa2, pa3); SBAR();
        SLOAD(SE, (j + 2) * 64); SBAR();
        pv_d0(o, vb0 + (int)SHM_V, pa0, pa1, pa2, pa3); TILE_PARAMS(j + 1, yl, dg, dl); partialSM(pA0, pA1, m_reg, mnA, alA, a, yl, dg, dl, hi);
        __syncthreads(); SWAIT(); SWRITE(1, SO);
        RESC(alA); __syncthreads();
    }
    SBAR(); qkt(pB0, pB1, K_lds + SHM_K, qr, r32, hi);
    finishSM(pA0, pA1, alA, l_reg, pa0, pa1, pa2, pa3); SBAR();
    pv_d0(o, vb0, pa0, pa1, pa2, pa3); TILE_PARAMS(NT - 1, yl, dg, dl); partialSM(pB0, pB1, m_reg, mnB, alB, a, yl, dg, dl, hi);
    __syncthreads(); RESC(alB);
    finishSM(pB0, pB1, alB, l_reg, pa0, pa1, pa2, pa3); SBAR();
    pv_d0(o, vb0 + (int)SHM_V, pa0, pa1, pa2, pa3);
    if (hi == 0) li_l[r32] = l_reg; asm volatile("s_waitcnt lgkmcnt(0)" ::: "memory");
    asm volatile("" : "+v"(tid));
    float rli[16];
#pragma unroll
    for (int r = 0; r < 16; ++r) rli[r] = __builtin_amdgcn_rcpf(li_l[crow(r, hi)]);
    { const int hi2 = (tid >> 5) & 1; bf16* Ow = Ob + (size_t)(wid * 32) * LD + (tid & 31);
#pragma unroll
    for (int r = 0; r < 16; ++r) { const int orow = crow(r, hi2);
#pragma unroll
        for (int d0 = 0; d0 < 4; ++d0) Ow[(size_t)orow * LD + d0 * 32] = (bf16)f2bf(o[d0][r] * rli[r]); } }
    __syncthreads();
#undef SLOAD
#undef SWRITE
#undef SWAIT
#undef RESC
#undef TILE_PARAMS
}
#undef KSWZ
#undef SBAR
}

__device__ __forceinline__ void kvnorm_item(int item, const bf16* KRAW, const float* k_norm, bf16* KNB, float* KMP, int lane) {
    const int part = item & 3, n = (item >> 2) & 7, h = (item >> 5) & 15, b = item >> 9;
    const int tk = lane >> 4, c8 = (lane & 15) * 8;
    const f32x4 g0 = *(const f32x4*)(k_norm + c8), g1 = *(const f32x4*)(k_norm + c8 + 4);
    float acc[8];
#pragma unroll
    for (int i = 0; i < 8; ++i) acc[i] = 0.f;
    for (int it = 0; it < 16; ++it) {
        const size_t off = ((size_t)b * S + n * BLK + part * 64 + it * 4 + tk) * D + h * DH + c8;
        const v4u raw = *(const v4u*)(KRAW + off);
        float v[8] = {bflo(raw.x), bfhi(raw.x), bflo(raw.y), bfhi(raw.y), bflo(raw.z), bfhi(raw.z), bflo(raw.w), bfhi(raw.w)};
        float ss = 0.f;
#pragma unroll
        for (int i = 0; i < 8; ++i) ss = fmaf(v[i], v[i], ss);
        ss = sum16(ss);
        const float r = rsqrtf(ss * (1.0f / DH) + EPS);
        v[0] *= r * g0.x; v[1] *= r * g0.y; v[2] *= r * g0.z; v[3] *= r * g0.w; v[4] *= r * g1.x; v[5] *= r * g1.y; v[6] *= r * g1.z; v[7] *= r * g1.w;
#pragma unroll
        for (int i = 0; i < 8; ++i) acc[i] += v[i];
        v4u o; o.x = pk2(v[0], v[1]); o.y = pk2(v[2], v[3]); o.z = pk2(v[4], v[5]); o.w = pk2(v[6], v[7]);
        *(v4u*)(KNB + off) = o;
    }
#pragma unroll
    for (int i = 0; i < 8; ++i) { acc[i] += swz_xor<16>(acc[i]); acc[i] = half_sum(acc[i]); }
    if (lane < 16) { float* p = KMP + (size_t)item * 128 + c8; *(f32x4*)p = (f32x4){acc[0], acc[1], acc[2], acc[3]}; *(f32x4*)(p + 4) = (f32x4){acc[4], acc[5], acc[6], acc[7]}; }
}

__global__ void __launch_bounds__(NWAVES * 64, 2) fwd(Args args) {
    extern __shared__ __attribute__((aligned(16))) unsigned char lds_raw[];
    LAS unsigned char* lds = (LAS unsigned char*)lds_raw;
    volatile LAS unsigned* MISC = (volatile LAS unsigned*)(lds + MISC_OFF);
    const int tid0 = threadIdx.x, wave = __builtin_amdgcn_readfirstlane(tid0 >> 6);
    const int G = gridDim.x;
    unsigned char* ws = args.ws;
    gu32* ctl = (gu32*)(ws + WS_CTL);
    for (int u = tid0; u < (LDS_BYTES - LDSCTL_OFF) / 4; u += NWAVES * 64) ((LAS unsigned*)(lds + LDSCTL_OFF))[u] = 0u;
    __syncthreads();
    XcdBarrier bar = xcd_barrier_post((unsigned*)(ctl + CW_BAR) + args.li * XCD_BAR_WORDS, MISC + 8);

#define WT   ((bf16*)(wsp + WS_WT))
#define HB   ((bf16*)(wsp + WS_XN))
#define PSUM ((float*)(wsp + WS_OF + 2 * MiB))
#define RSL  ((LAS float*)(lds + LDSCTL_OFF + 1024))
#define QS   ((bf16*)(wsp + WS_QS))
#define KS   ((bf16*)(wsp + WS_KS))
#define VS   ((bf16*)(wsp + WS_VS))
#define GT   ((bf16*)(wsp + WS_GT))
#define GS   ((float*)(wsp + WS_GS))
#define OG   ((bf16*)(wsp + WS_OG))
#define U    ((bf16*)(wsp + WS_U))
#define KRAW ((bf16*)(wsp + WS_KRAW))
#define VV   ((bf16*)(wsp + WS_VV))
#define QRAW ((bf16*)(wsp + WS_QRAW))
#define LBS  ((float*)(wsp + WS_SMALL + SM_LBS))
#define KNORMC ((float*)(wsp + WS_SMALL + SM_KNORM))
#define QNORMC ((float*)(wsp + WS_SMALL + SM_QNORM))
#define KNB  ((bf16*)(wsp + WS_KN))
#define KMP  ((float*)(wsp + WS_OF))
    float* hres = args.out;
    const int lo = args.ph_lo, hi = args.ph_hi;
    const int NGW = G * NWAVES;
    bool any = false;
#define PHASE_BEGIN(p) if (lo <= (p) && (p) < hi) { if (any) xcd_barrier(bar); any = true; GAS unsigned char* wsp = (GAS unsigned char*)args.ws; asm volatile("" : "+s"(wsp)); int bx = blockIdx.x; asm volatile("" : "+s"(bx)); (void)bx; int tz_ = threadIdx.x; asm volatile("" : "+v"(tz_)); const int tid = tz_, lane = tz_ & 63; (void)tid; (void)lane;
#define PHASE_END() }

    PHASE_BEGIN(0)
        {
            const int d = bx * (NWAVES * 64) + tid;
            if (d < D) { const float a = in_ptr(I_LB)[d], b = in_ptr(I_LB)[D + d], mx = fmaxf(a, b), ea = expf(a - mx), eb = expf(b - mx), sm = ea + eb, p0 = ea / sm, p1 = eb / sm;
                LBS[d] = 0.f; LBS[D + d] = (p0 + p1) - p0; }
            if (d < 128) KNORMC[d] = in_ptr(I_KNORM)[d];
            if (d < 256) QNORMC[d] = in_ptr(I_BQNORM)[d];
        }
        for (int m = bx * NWAVES + wave; m < M; m += NGW) intake_row(in_ptr(I_X) + (size_t)m * D, HB + (size_t)m * D, PSUM + (size_t)m * 32, lane);
        {
            LAS float* scr = (LAS float*)(lds + RING_OFF + wave * 16384);
            convert_weights(WT, 0, 1, bx * NWAVES + wave, NGW, scr, lane);
        }
    PHASE_END()

    for (int l = 0; l < 4; ++l) {
        const int pb = 1 + 9 * l;
        if (l < 2) {
            PHASE_BEGIN(pb + 1)
                pg8::Gemm g = pg8::gemm_rowmajor(HB, WT + WE_WIN + (size_t)l * D * 4 * D, M, 4 * D, D); pg8::StaticOrder So; So.init(M, 4 * D, G, bx);
                pg8::EpiHgrn E{QS, (size_t)(WS_KS - WS_QS) / 2, GS, LBS + l * D, RSL}; pg8::row_scale_table(PSUM, RSL, So, tid);
                pg8::gemm_phase<pg8::EpiHgrn, pg8::StaticOrder, true, true>(lds + RING_OFF, g, So, E);
            PHASE_END()
        } else {
            PHASE_BEGIN(pb + 1)
                const bool first = (l == 2);
                pg8::Gemm g = pg8::gemm_rowmajor(HB, first ? WT + WE_KVQ : WT + WE_Q1, M, first ? 3 * D : D, D); pg8::StaticOrder So; So.init(M, first ? 3 * D : D, G, bx);
                pg8::EpiSplit E{KRAW, (size_t)(WS_VV - WS_KRAW) / 2, first ? 0 : 2, RSL}; pg8::row_scale_table(PSUM, RSL, So, tid);
                pg8::gemm_phase<pg8::EpiSplit, pg8::StaticOrder, true, true>(lds + RING_OFF, g, So, E);
            PHASE_END()
        }
        if (l < 2) {
            PHASE_BEGIN(pb + 2)
                const int nseg = (G >= 3 * NB * H) ? 2 : 1, ngla = nseg * NB * H;
                if (bx < ngla) { const int seg = bx / (NB * H), bh = bx - seg * (NB * H);
                    const int c0 = seg ? GSPLIT : 0, c1 = (nseg == 2 && seg == 0) ? GSPLIT : NCH;
                    gla_seq(bh, c0, c0, c1, QS, KS, VS, GS, GT, OG, lds + RING_OFF, tid); }
                else if (G > ngla) convert_weights(WT, l == 0 ? 1 : 8, l == 0 ? 8 : 17, (bx - ngla) * NWAVES + wave, (G - ngla) * NWAVES, (LAS float*)(lds + RING_OFF + wave * 16384), lane);
            PHASE_END()
        } else {
            if (l == 2) {
                PHASE_BEGIN(pb + 2)
                    for (int it = bx * NWAVES + wave; it < NB * H * NBLK * 4; it += NGW) kvnorm_item(it, KRAW, KNORMC, KNB, KMP, lane);
                PHASE_END()
            }
            PHASE_BEGIN(pb + 4)
                for (int pi = bx; pi < 256; pi += G) {
                    const int bh = pi & 63, pr = pi >> 6, b = bh >> 4, h = bh & 15;
                    for (int u = 0; u < 2; ++u) {
                        const int qb = u == 0 ? 7 - pr : pr;
                        const size_t qoff = ((size_t)b * S + 256 * qb) * D + h * DH, koff = (size_t)b * S * D + h * DH;
                        moba::unit(QRAW + qoff, KNB + koff, VV + koff, OG + qoff, QNORMC + (size_t)(l - 2) * DH, KMP + (size_t)bh * 4096, qb, h, (LAS char*)(lds + RING_OFF), tid);
                    }
                }
            PHASE_END()
        }
        PHASE_BEGIN(pb + 5)
            pg8::Gemm g = pg8::gemm_rowmajor(OG, l < 2 ? WT + WE_WOUT + (size_t)l * D * D : WT + WE_WO + (size_t)(l - 2) * D * D, M, D, D); pg8::StaticOrder So; So.init(M, D, G, bx);
            pg8::EpiRes<false> E{HB, PSUM, nullptr, D};
            pg8::gemm_phase<pg8::EpiRes<false>, pg8::StaticOrder, true, true>(lds + RING_OFF, g, So, E);
        PHASE_END()
        PHASE_BEGIN(pb + 7)
            pg8::Gemm g = pg8::gemm_rowmajor(HB, WT + WE_W1 + (size_t)l * D * FF, M, FF, D); pg8::StaticOrder So; So.init(M, FF, G, bx);
            pg8::EpiRelu2 E{U, FF, RSL}; pg8::row_scale_table(PSUM, RSL, So, tid);
            pg8::gemm_phase<pg8::EpiRelu2, pg8::StaticOrder, true, true>(lds + RING_OFF, g, So, E);
        PHASE_END()
        PHASE_BEGIN(pb + 8)
            pg8::Gemm g{U, WT + WE_W2 + (size_t)l * FF * D, M, D, FF, 64, 64, 32768, 32768, (size_t)(FF / 64) * 32768, (size_t)(FF / 64) * 32768};     pg8::StaticOrder So; So.init(M, D, G, bx);
            if (l == 3) { pg8::EpiRes<true> E{HB, PSUM, hres, D}; pg8::gemm_phase<pg8::EpiRes<true>, pg8::StaticOrder, true, true>(lds + RING_OFF, g, So, E); }
            else { pg8::EpiRes<false> E{HB, PSUM, nullptr, D}; pg8::gemm_phase<pg8::EpiRes<false>, pg8::StaticOrder, true, true>(lds + RING_OFF, g, So, E); }
        PHASE_END()
    }
#undef PHASE_BEGIN
#undef PHASE_END
#undef WT
#undef HB
#undef PSUM
#undef RSL
#undef QS
#undef KS
#undef VS
#undef GT
#undef GS
#undef OG
#undef U
#undef KRAW
#undef VV
#undef QRAW
#undef LBS
#undef KNORMC
#undef QNORMC
#undef KNB
#undef KMP
}

extern "C" void kernel_launch(void* const* d_in, const int* in_sizes, int n_in, void* d_out, int out_size, void* d_ws, size_t ws_size, hipStream_t stream) {
    static int grid = 0;
    if (grid == 0) {
        if (n_in != 16 || out_size != M * D || ws_size < WS_END) { fprintf(stderr, "kernel_launch: unexpected sizes (n_in %d, out %d, ws %zu < %zu); nothing launched\n", n_in, out_size, ws_size, (size_t)WS_END); grid = -1; return; }
        int dev = 0, cus = 0, per_cu = 0;
        if (hipGetDevice(&dev) != hipSuccess || hipDeviceGetAttribute(&cus, hipDeviceAttributeMultiprocessorCount, dev) != hipSuccess) { grid = -1; return; }
        if (hipFuncSetAttribute((const void*)fwd, hipFuncAttributeMaxDynamicSharedMemorySize, LDS_BYTES) != hipSuccess) { fprintf(stderr, "kernel_launch: hipFuncSetAttribute failed\n"); grid = -1; return; }
        if (hipOccupancyMaxActiveBlocksPerMultiprocessor(&per_cu, (const void*)fwd, NWAVES * 64, LDS_BYTES) != hipSuccess || per_cu < 1) { fprintf(stderr, "kernel_launch: occupancy query says %d blocks per CU\n", per_cu); }
        (void)hipGetLastError();
        grid = cus;
    }
    if (grid < 0) return;
    if (hipMemsetAsync((char*)d_ws + WS_CTL, 0, CTL_ZERO_BYTES, stream) != hipSuccess) return;
    Args a{};
    for (int i = 0; i < 16; ++i) a.in[i] = (const float*)d_in[i];
    a.out = (float*)d_out; a.ws = (unsigned char*)d_ws;
    a.ph_lo = 0; a.ph_hi = 37; a.li = 0;
    hipLaunchKernelGGL(fwd, dim3(grid), dim3(NWAVES * 64), LDS_BYTES, stream, a);
}
```

```cpp
#include <hip/hip_runtime.h>
#include <cstdio>
#include <cstdint>

template <int K> __device__ __forceinline__ float swz_xor(float v) { return __builtin_bit_cast(float, __builtin_amdgcn_ds_swizzle(__builtin_bit_cast(int, v), (K << 10) | 0x1f)); }
__device__ __forceinline__ float half_sum(float v) { auto rr = __builtin_amdgcn_permlane32_swap(__float_as_uint(v), __float_as_uint(v), false, false); const unsigned r0 = rr[0], r1 = rr[1]; return __uint_as_float(r0) + __uint_as_float(r1); }
__device__ __forceinline__ float sum16(float v) { v += swz_xor<1>(v); v += swz_xor<2>(v); v += swz_xor<4>(v); v += swz_xor<8>(v); return v; }
__device__ __forceinline__ float wave_sum(float v) { v = sum16(v); v += swz_xor<16>(v); return half_sum(v); }

namespace pg8 {
#define PG8_LAS __attribute__((address_space(3)))
typedef unsigned short bf16_t;
typedef short bf16x8 __attribute__((ext_vector_type(8)));
typedef float f32x4 __attribute__((ext_vector_type(4)));
typedef unsigned u32x4 __attribute__((ext_vector_type(4)));
constexpr int BM = 256, BK = 64, HALF = 128, HTB = HALF * BK * 2  , STAGE_BYTES = 8 * HTB, NXCD = 8, WGM = 4;

__host__ __device__ __forceinline__ int lds_byte(int r, int c) { const int st = (r >> 4) * 2 + (c >> 5), rr = r & 15, cc = c & 31, ob = rr * 64 + cc * 2; return st * 1024 + (ob ^ (((ob >> 9) & 1) << 5)); }
__host__ __device__ __forceinline__ void stage_rc(int b, int& R, int& C) { const int st = b / 1024, sb = b % 1024, swz = sb ^ (((sb >> 9) & 1) << 5); R = (st >> 1) * 16 + swz / 64; C = (st & 1) * 32 + (swz % 64) / 2; }
__host__ __device__ __forceinline__ int perm32(int rho) { const int n = rho >> 4, i = rho & 15; return 8 * (i >> 2) + 4 * n + (i & 3); }

struct Unit { int pm, pn, ord; };
struct Gemm { const bf16_t* A; const bf16_t* Bt; int M, N, K, lda, ldb; size_t ksa, ksb, tsa, tsb; };
__host__ __device__ inline Gemm gemm_rowmajor(const bf16_t* A, const bf16_t* Bt, int M, int N, int K) { return Gemm{A, Bt, M, N, K, K, K, 128, 128, (size_t)256 * K * 2, (size_t)256 * K * 2}; }
__host__ __device__ inline Gemm gemm_tiled(const bf16_t* A, const bf16_t* Bt, int M, int N, int K) { return Gemm{A, Bt, M, N, K, 64, 64, 32768, 32768, (size_t)(K / 64) * 32768, (size_t)(K / 64) * 32768}; }
__host__ __device__ inline Gemm gemm_btiled(const bf16_t* A, const bf16_t* Bt, int M, int N, int K) { return Gemm{A, Bt, M, N, K, K, 64, 128, 32768, (size_t)256 * K * 2, (size_t)(K / 64) * 32768}; }

struct StaticOrder {
    int nM, nN, nwg, G, c;
    __host__ __device__ void init(int M, int N, int G_, int c_) { nM = M / BM; nN = N / BM; nwg = nM * nN; G = G_; c = c_; }
    __host__ __device__ bool next(int i, Unit& u) const {
        const long L = (long)i * G + c; if (L >= nwg) return false;
        int wgid = (int)L; { const int q = nwg / NXCD, r = nwg % NXCD, xcd = wgid % NXCD, off = wgid / NXCD; wgid = (xcd < r ? xcd * (q + 1) : r * (q + 1) + (xcd - r) * q) + off; }
        const int nig = WGM * nN, gid = wgid / nig, fm = gid * WGM, gsz = (nM - fm) < WGM ? (nM - fm) : WGM;
        u.pm = fm + ((wgid % nig) % gsz); u.pn = (wgid % nig) / gsz; u.ord = i; return true;
    }
    __device__ __forceinline__ void a_ready(const Unit&) const {}
    __device__ __forceinline__ void done(const Unit&) const {}
};

__device__ __forceinline__ unsigned cvt_pk_bf16(float lo, float hi) { unsigned r; asm("v_cvt_pk_bf16_f32 %0, %1, %2" : "=v"(r) : "v"(lo), "v"(hi)); return r; }
typedef float f32x2 __attribute__((ext_vector_type(2)));
typedef _Float16 h16x2 __attribute__((ext_vector_type(2)));
__device__ __forceinline__ unsigned pk_h2(float lo, float hi) { const h16x2 h = {(_Float16)lo, (_Float16)hi}; return __builtin_bit_cast(unsigned, h); }
template <class Sched> __device__ __forceinline__ void row_scale_table(const float* PS, PG8_LAS float* RS, const Sched& So, int tid) {
    const int r = tid & 255, hh = tid >> 8;
#pragma unroll
    for (int grp = 0; grp < 2; ++grp) { Unit u0, u1; const int i0 = 4 * grp + hh, i1 = 4 * grp + 2 + hh;
        const bool ok0 = So.next(i0, u0), ok1 = So.next(i1, u1);
        if (grp == 1 && !__any(ok0)) break;
        const int pm0 = ok0 ? u0.pm : 0, pm1 = ok1 ? u1.pm : pm0;
        const f32x4* p0 = (const f32x4*)(PS + (size_t)(pm0 * BM + r) * 32); const f32x4* p1 = (const f32x4*)(PS + (size_t)(pm1 * BM + r) * 32);
        f32x4 a[8], b[8];
#pragma unroll
        for (int k = 0; k < 8; ++k) { a[k] = p0[k]; b[k] = p1[k]; }
        const f32x4 sa = ((a[0] + a[1]) + (a[2] + a[3])) + ((a[4] + a[5]) + (a[6] + a[7])), sb = ((b[0] + b[1]) + (b[2] + b[3])) + ((b[4] + b[5]) + (b[6] + b[7]));
        if (ok0) RS[i0 * 256 + r] = rsqrtf(((sa[0] + sa[1]) + (sa[2] + sa[3])) * (1.0f / 2048.0f) + 1e-6f);
        if (ok1) RS[i1 * 256 + r] = rsqrtf(((sb[0] + sb[1]) + (sb[2] + sb[3])) * (1.0f / 2048.0f) + 1e-6f); }
    asm volatile("s_waitcnt vmcnt(0) lgkmcnt(0)" ::: "memory"); __builtin_amdgcn_s_barrier(); asm volatile("" ::: "memory");
}
template <bool LAST>
struct EpiRes {
    static constexpr bool PERM = true, AFTER_DRAIN = false, INIT = true;
    bf16_t* HB; float* PS; float* Fout; int ldc;
    __device__ __forceinline__ void init_load(u32x4 (&hv)[16], const Unit& u, int wr, int wc, int fr, int fq) const {
        const size_t tbase = ((size_t)(u.pm * (ldc / 64) + u.pn * 4 + wc) * 256 + wr * 64 + fr) * 64 + 8 * fq;
#pragma unroll
        for (int ai = 0; ai < 2; ++ai)
#pragma unroll
            for (int m = 0; m < 4; ++m)
#pragma unroll
                for (int bj = 0; bj < 2; ++bj) hv[(ai * 4 + m) * 2 + bj] = *(const u32x4*)(HB + tbase + (size_t)(ai * HALF + m * 16) * 64 + bj * 32);
    }
    __device__ __forceinline__ void init_unpack(f32x4 (&acc)[2][2][4][2], const u32x4 (&hv)[16]) const {
#pragma unroll
        for (int ai = 0; ai < 2; ++ai)
#pragma unroll
            for (int m = 0; m < 4; ++m)
#pragma unroll
                for (int bj = 0; bj < 2; ++bj) { const u32x4 r = hv[(ai * 4 + m) * 2 + bj];
                    acc[ai][bj][m][0] = (f32x4){__builtin_bit_cast(float, r.x << 16), __builtin_bit_cast(float, r.x & 0xffff0000u), __builtin_bit_cast(float, r.y << 16), __builtin_bit_cast(float, r.y & 0xffff0000u)};
                    acc[ai][bj][m][1] = (f32x4){__builtin_bit_cast(float, r.z << 16), __builtin_bit_cast(float, r.z & 0xffff0000u), __builtin_bit_cast(float, r.w << 16), __builtin_bit_cast(float, r.w & 0xffff0000u)}; }
    }
    __device__ __forceinline__ void operator()(const f32x4 (&acc)[2][2][4][2], const Unit& u, int wr, int wc, int fr, int fq) const {
        const int row0 = u.pm * BM + wr * 64 + fr, col0 = u.pn * BM + wc * 64 + 8 * fq;
        const size_t tbase = ((size_t)(u.pm * (ldc / 64) + u.pn * 4 + wc) * 256 + wr * 64 + fr) * 64 + 8 * fq;
#pragma unroll
        for (int ai = 0; ai < 2; ++ai)
#pragma unroll
            for (int m = 0; m < 4; ++m) { const int row = row0 + ai * HALF + m * 16; float ss = 0.f; f32x2 ssv = (f32x2){0.f, 0.f};
#pragma unroll
                for (int bj = 0; bj < 2; ++bj) { const size_t off = (size_t)row * ldc + col0 + bj * 32, toff = tbase + (size_t)(ai * HALF + m * 16) * 64 + bj * 32;
                    const f32x4 h0 = acc[ai][bj][m][0], h1 = acc[ai][bj][m][1];
                    if constexpr (LAST) { *(f32x4*)(Fout + off) = h0; *(f32x4*)(Fout + off + 4) = h1; }
                    else { { const f32x2 a0 = (f32x2){h0[0], h0[1]}, a1 = (f32x2){h0[2], h0[3]}, a2 = (f32x2){h1[0], h1[1]}, a3 = (f32x2){h1[2], h1[3]}; ssv += (a0 * a0 + a1 * a1) + (a2 * a2 + a3 * a3); }
                        u32x4 w; w.x = cvt_pk_bf16(h0[0], h0[1]); w.y = cvt_pk_bf16(h0[2], h0[3]); w.z = cvt_pk_bf16(h1[0], h1[1]); w.w = cvt_pk_bf16(h1[2], h1[3]);
                        *(u32x4*)(HB + toff) = w; } }
                if constexpr (!LAST) { ss = ssv.x + ssv.y; ss += swz_xor<16>(ss); ss = half_sum(ss);
                    if (fq == 0) PS[(size_t)row * 32 + u.pn * 4 + wc] = ss; } }
    }
};
struct EpiRelu2 {
    static constexpr bool PERM = true, AFTER_DRAIN = false, INIT = false;
    bf16_t* O; int ncols; PG8_LAS float* RS;
    __device__ __forceinline__ void operator()(const f32x4 (&acc)[2][2][4][2], const Unit& u, int wr, int wc, int fr, int fq) const {
        bf16_t* tile = O + ((size_t)(u.pm * (ncols / 64) + u.pn * 4 + wc) * 256 + wr * 64 + fr) * 64 + 8 * fq;
#pragma unroll
        for (int ai = 0; ai < 2; ++ai)
#pragma unroll
            for (int m = 0; m < 4; ++m) { bf16_t* rowp = tile + (ai * HALF + m * 16) * 64; const float rs = RS[u.ord * 256 + ai * HALF + wr * 64 + m * 16 + fr], rs2 = rs * rs;
#pragma unroll
                for (int bj = 0; bj < 2; ++bj) { f32x4 v0 = acc[ai][bj][m][0], v1 = acc[ai][bj][m][1];
#pragma unroll
                    for (int j = 0; j < 4; j += 2) {
                        f32x2 a = (f32x2){__builtin_amdgcn_fmed3f(v0[j], 0.f, 3.0e38f), __builtin_amdgcn_fmed3f(v0[j + 1], 0.f, 3.0e38f)}, b = (f32x2){__builtin_amdgcn_fmed3f(v1[j], 0.f, 3.0e38f), __builtin_amdgcn_fmed3f(v1[j + 1], 0.f, 3.0e38f)};
                        a = (a * a) * (f32x2){rs2, rs2}; b = (b * b) * (f32x2){rs2, rs2}; v0[j] = a.x; v0[j + 1] = a.y; v1[j] = b.x; v1[j + 1] = b.y; }
                    u32x4 w; w.x = cvt_pk_bf16(v0[0], v0[1]); w.y = cvt_pk_bf16(v0[2], v0[3]); w.z = cvt_pk_bf16(v1[0], v1[1]); w.w = cvt_pk_bf16(v1[2], v1[3]);
                    *(u32x4*)(rowp + bj * 32) = w; } }
    }
};
struct EpiSplit {
    static constexpr bool PERM = true, AFTER_DRAIN = false, INIT = false;
    bf16_t* O0; size_t gstride; int g0; PG8_LAS float* RS;
    bf16_t* KN; float* KM; const float* kgain; PG8_LAS float* XS;
    __device__ __forceinline__ void operator()(const f32x4 (&acc)[2][2][4][2], const Unit& u, int wr, int wc, int fr, int fq) const {
        const int g = g0 + (u.pn >> 3); bf16_t* base = O0 + (size_t)g * gstride;
        const int row0 = u.pm * BM + wr * 64 + fr, col0 = (u.pn & 7) * BM + wc * 64 + 8 * fq;
        if (KN != nullptr && g == 0) {
#pragma unroll
            for (int ai = 0; ai < 2; ++ai)
#pragma unroll
                for (int m = 0; m < 4; ++m) { const int rl = ai * HALF + wr * 64 + m * 16 + fr; const float rs = RS[u.ord * 256 + rl]; f32x2 sv = (f32x2){0.f, 0.f};
#pragma unroll
                    for (int bj = 0; bj < 2; ++bj)
#pragma unroll
                        for (int n = 0; n < 2; ++n) { const f32x4 v = acc[ai][bj][m][n] * rs; sv += (f32x2){v[0], v[1]} * (f32x2){v[0], v[1]} + (f32x2){v[2], v[3]} * (f32x2){v[2], v[3]}; }
                    float ss = sv.x + sv.y; ss += swz_xor<16>(ss); ss = half_sum(ss);
                    if (fq == 0) XS[rl * 4 + wc] = ss; }
            asm volatile("s_waitcnt lgkmcnt(0)" ::: "memory"); __builtin_amdgcn_s_barrier(); asm volatile("" ::: "memory");
            f32x4 gk[2][2];
#pragma unroll
            for (int bj = 0; bj < 2; ++bj)
#pragma unroll
                for (int n = 0; n < 2; ++n) gk[bj][n] = *(const f32x4*)(kgain + (wc & 1) * 64 + bj * 32 + 8 * fq + 4 * n);
            const int hh = (u.pn & 7) * 2 + (wc >> 1), bb = u.pm >> 3, blk = u.pm & 7;
#pragma unroll
            for (int ai = 0; ai < 2; ++ai) { f32x4 cs[2][2];
#pragma unroll
                for (int bj = 0; bj < 2; ++bj)
#pragma unroll
                    for (int n = 0; n < 2; ++n) cs[bj][n] = (f32x4){0.f, 0.f, 0.f, 0.f};
#pragma unroll
                for (int m = 0; m < 4; ++m) { const int rl = ai * HALF + wr * 64 + m * 16 + fr;
                    const float sc = __builtin_amdgcn_rsqf((XS[rl * 4 + wc] + XS[rl * 4 + (wc ^ 1)]) * (1.0f / 128.0f) + 1e-6f) * RS[u.ord * 256 + rl];
                    bf16_t* rowp = KN + (size_t)(row0 + ai * HALF + m * 16) * 2048 + col0;
#pragma unroll
                    for (int bj = 0; bj < 2; ++bj) { const f32x4 v0 = acc[ai][bj][m][0] * sc * gk[bj][0], v1 = acc[ai][bj][m][1] * sc * gk[bj][1];
                        cs[bj][0] += v0; cs[bj][1] += v1;
                        u32x4 w; w.x = cvt_pk_bf16(v0[0], v0[1]); w.y = cvt_pk_bf16(v0[2], v0[3]); w.z = cvt_pk_bf16(v1[0], v1[1]); w.w = cvt_pk_bf16(v1[2], v1[3]);
                        *(u32x4*)(rowp + bj * 32) = w; } }
                float* kp = KM + ((size_t)(((bb * 16 + hh) * 8 + blk) * 4 + ai * 2 + wr)) * 128 + (wc & 1) * 64 + 8 * fq;
#pragma unroll
                for (int bj = 0; bj < 2; ++bj)
#pragma unroll
                    for (int n = 0; n < 2; ++n) { f32x4 t = cs[bj][n];
#pragma unroll
                        for (int j = 0; j < 4; ++j) t[j] = sum16(t[j]);
                        if (fr == 0) *(f32x4*)(kp + bj * 32 + 4 * n) = t; } }
            return;
        }
#pragma unroll
        for (int ai = 0; ai < 2; ++ai)
#pragma unroll
            for (int m = 0; m < 4; ++m) { bf16_t* rowp = base + (size_t)(row0 + ai * HALF + m * 16) * 2048 + col0; const float rs = RS[u.ord * 256 + ai * HALF + wr * 64 + m * 16 + fr];
#pragma unroll
                for (int bj = 0; bj < 2; ++bj) { const f32x4 v0 = acc[ai][bj][m][0] * rs, v1 = acc[ai][bj][m][1] * rs;
                    u32x4 w; w.x = cvt_pk_bf16(v0[0], v0[1]); w.y = cvt_pk_bf16(v0[2], v0[3]); w.z = cvt_pk_bf16(v1[0], v1[1]); w.w = cvt_pk_bf16(v1[2], v1[3]);
                    *(u32x4*)(rowp + bj * 32) = w; } }
    }
};
struct EpiHgrn {
    static constexpr bool PERM = true, AFTER_DRAIN = false, INIT = false;
    bf16_t* Qs; size_t qstride; float* Gs; const float* lb; PG8_LAS float* RS;
    __device__ __forceinline__ void operator()(const f32x4 (&acc)[2][2][4][2], const Unit& u, int wr, int wc, int fr, int fq) const {
        const int quarter = u.pn >> 3;
        const int row0 = u.pm * BM + wr * 64 + fr, col0 = (u.pn & 7) * BM + wc * 64 + 8 * fq;
        if (quarter == 1) {
            f32x4 lbv[2][2];
#pragma unroll
            for (int bj = 0; bj < 2; ++bj)
#pragma unroll
                for (int n = 0; n < 2; ++n) lbv[bj][n] = *(const f32x4*)(lb + col0 + bj * 32 + 4 * n);
#pragma unroll
            for (int ai = 0; ai < 2; ++ai)
#pragma unroll
                for (int m = 0; m < 4; ++m) { const size_t ro = (size_t)(row0 + ai * HALF + m * 16) * 2048 + col0; const float rs = RS[u.ord * 256 + ai * HALF + wr * 64 + m * 16 + fr];
#pragma unroll
                    for (int bj = 0; bj < 2; ++bj) { f32x4 lf[2];
#pragma unroll
                        for (int n = 0; n < 2; ++n)
#pragma unroll
                            for (int j = 0; j < 4; ++j) { const float x = fmaxf(acc[ai][bj][m][n][j] * rs, -80.f), e = __expf(-x), r = __builtin_amdgcn_rcpf(1.f + e);
                                const float l0 = lbv[bj][n][j], om = 1.f - l0; lf[n][j] = __log2f(fmaf(om, r, l0)); }
                        u32x4 w; w.x = pk_h2(lf[0][0], lf[0][1]); w.y = pk_h2(lf[0][2], lf[0][3]); w.z = pk_h2(lf[1][0], lf[1][1]); w.w = pk_h2(lf[1][2], lf[1][3]);
                        *(u32x4*)((_Float16*)Gs + ro + bj * 32) = w; } }
        } else {
            bf16_t* base = Qs + (size_t)quarter * qstride;
            const bool act = quarter == 0;
#pragma unroll
            for (int ai = 0; ai < 2; ++ai)
#pragma unroll
                for (int m = 0; m < 4; ++m) { bf16_t* rowp = base + (size_t)(row0 + ai * HALF + m * 16) * 2048 + col0; const float rs = RS[u.ord * 256 + ai * HALF + wr * 64 + m * 16 + fr];
#pragma unroll
                    for (int bj = 0; bj < 2; ++bj) { f32x4 v0 = acc[ai][bj][m][0] * rs, v1 = acc[ai][bj][m][1] * rs;
                        if (act) {
#pragma unroll
                            for (int j = 0; j < 4; ++j) { const float a = fmaxf(v0[j], -80.f), b = fmaxf(v1[j], -80.f);
                                v0[j] = a * __builtin_amdgcn_rcpf(1.f + __expf(-a)); v1[j] = b * __builtin_amdgcn_rcpf(1.f + __expf(-b)); } }
                        u32x4 w; w.x = cvt_pk_bf16(v0[0], v0[1]); w.y = cvt_pk_bf16(v0[2], v0[3]); w.z = cvt_pk_bf16(v1[0], v1[1]); w.w = cvt_pk_bf16(v1[2], v1[3]);
                        *(u32x4*)(rowp + bj * 32) = w; } }
        }
    }
};


template <class Epi, class Sched, bool ALIGN_EPI = false, bool SP2 = false>
__device__ __forceinline__ void gemm_phase(PG8_LAS unsigned char* lds, const Gemm g, const Sched& S, const Epi& E) {
    int tid_ = threadIdx.x; asm volatile("" : "+v"(tid_));
    const int tid = tid_, wid = __builtin_amdgcn_readfirstlane(tid >> 6), lane = tid & 63, wr = wid >> 2, wc = wid & 3, fr = lane & 15, fq = lane >> 4;
    const int K = g.K, nt = K / BK;
    unsigned voffA[2], voffB[2];
#pragma unroll
    for (int i = 0; i < 2; ++i) { int R, C; stage_rc(tid * 16 + i * 8192, R, C); const int Rb = Epi::PERM ? (2 * (R & ~31) + perm32(R & 31)) : R;
        voffA[i] = (unsigned)(R * g.lda + C) * 2u; voffB[i] = (unsigned)(Rb * g.ldb + C) * 2u; }
    const size_t kstepA = g.ksa, kstepB = g.ksb;
    const size_t hstepA = (size_t)HALF * g.lda * 2, hstepB = (size_t)(Epi::PERM ? 32 : HALF) * g.ldb * 2;
    const size_t tstepA = g.tsa, tstepB = g.tsb;
    const unsigned ldsw = (unsigned)wid * 1024u;
    const int aoff = lds_byte(wr * 64 + fr, fq * 8), boff = lds_byte(wc * 32 + fr, fq * 8);
#define PG8_SA(b, h) (((b) * 2 + (h)) * HTB)
#define PG8_SB(b, h) ((4 + (b) * 2 + (h)) * HTB)
#define PG8_STAGE(bufoff, gbase, voff) do { _Pragma("unroll") for (int _i = 0; _i < 2; ++_i) \
        __builtin_amdgcn_global_load_lds((const unsigned*)((const char*)(gbase) + (voff)[_i]), (PG8_LAS unsigned*)(lds + (bufoff) + ldsw + _i * 8192), 16, 0, 0); } while (0)
#define PG8_LDA(dst, b, h) do { _Pragma("unroll") for (int m = 0; m < 4; ++m) _Pragma("unroll") for (int k = 0; k < 2; ++k) dst[m][k] = *(const PG8_LAS bf16x8*)(lds + PG8_SA(b, h) + aoff + m * 2048 + k * 1024); } while (0)
#define PG8_LDB(dst, b, h) do { _Pragma("unroll") for (int n = 0; n < 2; ++n) _Pragma("unroll") for (int k = 0; k < 2; ++k) dst[n][k] = *(const PG8_LAS bf16x8*)(lds + PG8_SB(b, h) + boff + n * 2048 + k * 1024); } while (0)
#define PG8_MMA(ai, bj, At, Bt) do { __builtin_amdgcn_s_setprio(1); _Pragma("unroll") for (int m = 0; m < 4; ++m) _Pragma("unroll") for (int n = 0; n < 2; ++n) _Pragma("unroll") for (int k = 0; k < 2; ++k) \
        acc[ai][bj][m][n] = __builtin_amdgcn_mfma_f32_16x16x32_bf16(Bt[n][k], At[m][k], acc[ai][bj][m][n], 0, 0, 0); __builtin_amdgcn_s_setprio(0); } while (0)
#define PG8_WAIT_V(n) asm volatile("s_waitcnt vmcnt(" #n ")" ::: "memory")
#define PG8_WAIT_L(n) asm volatile("s_waitcnt lgkmcnt(" #n ")" ::: "memory")
#define PG8_BAR __builtin_amdgcn_s_barrier()
#define PG8_SCHED __builtin_amdgcn_sched_barrier(0)
    Unit cur, nxt; int ui = 0;
    if (!S.next(0, cur)) return;
    f32x4 acc[2][2][4][2];
    u32x4 hraw[16];
    if constexpr (Epi::INIT) E.init_load(hraw, cur, wr, wc, fr, fq);
    else {
#pragma unroll
    for (int a = 0; a < 2; ++a)
#pragma unroll
        for (int b = 0; b < 2; ++b)
#pragma unroll
            for (int m = 0; m < 4; ++m)
#pragma unroll
                for (int n = 0; n < 2; ++n) acc[a][b][m][n] = (f32x4){0.f, 0.f, 0.f, 0.f};
    }
    PG8_SCHED;
    bf16x8 At[4][2], B0[2][2], B1[2][2];
    const char* cA = (const char*)g.A + (size_t)cur.pm * tstepA; const char* cB = (const char*)g.Bt + (size_t)cur.pn * tstepB;
    S.a_ready(cur);
    if constexpr (SP2) {
        PG8_STAGE(PG8_SB(0, 0), cB, voffB); PG8_STAGE(PG8_SB(0, 1), cB + hstepB, voffB); PG8_STAGE(PG8_SA(0, 0), cA, voffA); PG8_STAGE(PG8_SA(0, 1), cA + hstepA, voffA);
        if (wr == 1) PG8_BAR;
        PG8_WAIT_V(2); PG8_BAR;
        PG8_STAGE(PG8_SB(1, 0), cB + kstepB, voffB); PG8_STAGE(PG8_SA(1, 0), cA + kstepA, voffA); PG8_STAGE(PG8_SB(1, 1), cB + hstepB + kstepB, voffB);
        PG8_WAIT_V(6); PG8_BAR;
    } else {
        PG8_STAGE(PG8_SB(0, 0), cB, voffB); PG8_STAGE(PG8_SA(0, 0), cA, voffA); PG8_STAGE(PG8_SB(0, 1), cB + hstepB, voffB); PG8_STAGE(PG8_SA(0, 1), cA + hstepA, voffA);
        if (wr == 1) PG8_BAR;
        PG8_WAIT_V(4); PG8_BAR;
        PG8_STAGE(PG8_SB(1, 0), cB + kstepB, voffB); PG8_STAGE(PG8_SA(1, 0), cA + kstepA, voffA); PG8_STAGE(PG8_SB(1, 1), cB + hstepB + kstepB, voffB);
        PG8_WAIT_V(6); PG8_BAR;
    }
    if constexpr (Epi::INIT) { PG8_SCHED; E.init_unpack(acc, hraw); PG8_SCHED; }
    for (;;) {
        const bool has_next = S.next(ui + 1, nxt);
        const char* nA = has_next ? (const char*)g.A + (size_t)nxt.pm * tstepA : cA; const char* nB = has_next ? (const char*)g.Bt + (size_t)nxt.pn * tstepB : cB;
        for (int t = 0; t < nt; t += 2) {
            const bool last = (t == nt - 2);
            const char* a1 = cA + (size_t)(t + 1) * kstepA;
            const char* a2 = last ? nA : cA + (size_t)(t + 2) * kstepA; const char* b2 = last ? nB : cB + (size_t)(t + 2) * kstepB;
            const char* a3 = a2 + kstepA; const char* b3 = b2 + kstepB;
            if (last && has_next) S.a_ready(nxt);
            if constexpr (SP2) {
            PG8_LDB(B0, 0, 0); PG8_LDB(B1, 0, 1); PG8_SCHED; PG8_LDA(At, 0, 0); PG8_STAGE(PG8_SA(1, 1), a1 + hstepA, voffA);
            PG8_WAIT_V(8); PG8_WAIT_L(0); PG8_BAR; PG8_MMA(0, 0, At, B0); PG8_MMA(0, 1, At, B1); PG8_BAR; PG8_SCHED;
            PG8_LDA(At, 0, 1); PG8_STAGE(PG8_SB(0, 0), b2, voffB); PG8_STAGE(PG8_SB(0, 1), b2 + hstepB, voffB); PG8_STAGE(PG8_SA(0, 0), a2, voffA);
            PG8_WAIT_V(8); PG8_WAIT_L(0); PG8_BAR; PG8_MMA(1, 0, At, B0); PG8_MMA(1, 1, At, B1); PG8_BAR; PG8_SCHED;
            PG8_LDB(B0, 1, 0); PG8_LDB(B1, 1, 1); PG8_SCHED; PG8_LDA(At, 1, 0); PG8_STAGE(PG8_SA(0, 1), a2 + hstepA, voffA);
            PG8_WAIT_V(8); PG8_WAIT_L(0); PG8_BAR; PG8_MMA(0, 0, At, B0); PG8_MMA(0, 1, At, B1); PG8_BAR; PG8_SCHED;
            PG8_LDA(At, 1, 1); PG8_STAGE(PG8_SB(1, 0), b3, voffB); PG8_STAGE(PG8_SB(1, 1), b3 + hstepB, voffB); PG8_STAGE(PG8_SA(1, 0), a3, voffA);
            PG8_WAIT_V(8); PG8_WAIT_L(0); PG8_BAR; PG8_MMA(1, 0, At, B0); PG8_MMA(1, 1, At, B1); PG8_BAR; PG8_SCHED;
            } else {
            PG8_LDB(B0, 0, 0); PG8_SCHED; PG8_LDA(At, 0, 0); PG8_STAGE(PG8_SA(1, 1), a1 + hstepA, voffA);
            PG8_WAIT_L(8); PG8_BAR; PG8_WAIT_L(0); PG8_MMA(0, 0, At, B0); PG8_BAR; PG8_SCHED;
            PG8_LDB(B1, 0, 1); PG8_STAGE(PG8_SB(0, 0), b2, voffB);
            PG8_BAR; PG8_WAIT_L(0); PG8_MMA(0, 1, At, B1); PG8_BAR;
            PG8_LDA(At, 0, 1); PG8_STAGE(PG8_SA(0, 0), a2, voffA);
            PG8_BAR; PG8_WAIT_L(0); PG8_MMA(1, 0, At, B0); PG8_BAR; PG8_SCHED;
            PG8_STAGE(PG8_SB(0, 1), b2 + hstepB, voffB);
            PG8_WAIT_V(6); PG8_BAR; PG8_MMA(1, 1, At, B1); PG8_BAR;
            PG8_LDB(B0, 1, 0); PG8_SCHED; PG8_LDA(At, 1, 0); PG8_STAGE(PG8_SA(0, 1), a2 + hstepA, voffA);
            PG8_WAIT_L(8); PG8_BAR; PG8_WAIT_L(0); PG8_MMA(0, 0, At, B0); PG8_BAR; PG8_SCHED;
            PG8_LDB(B1, 1, 1); PG8_STAGE(PG8_SB(1, 0), b3, voffB);
            PG8_BAR; PG8_WAIT_L(0); PG8_MMA(0, 1, At, B1); PG8_BAR;
            PG8_LDA(At, 1, 1); PG8_STAGE(PG8_SA(1, 0), a3, voffA);
            PG8_BAR; PG8_WAIT_L(0); PG8_MMA(1, 0, At, B0); PG8_BAR; PG8_SCHED;
            PG8_STAGE(PG8_SB(1, 1), b3 + hstepB, voffB);
            PG8_WAIT_V(6); PG8_BAR; PG8_MMA(1, 1, At, B1); PG8_BAR;
            }
        }
        if constexpr (ALIGN_EPI) { if (wr == 0) PG8_BAR; }
        if constexpr (!Epi::AFTER_DRAIN) { E(acc, cur, wr, wc, fr, fq); S.done(cur); }
        if (!has_next) break;
        if constexpr (Epi::INIT) { E.init_load(hraw, nxt, wr, wc, fr, fq); E.init_unpack(acc, hraw); }
        else {
#pragma unroll
        for (int a = 0; a < 2; ++a)
#pragma unroll
            for (int b = 0; b < 2; ++b)
#pragma unroll
                for (int m = 0; m < 4; ++m)
#pragma unroll
                    for (int n = 0; n < 2; ++n) acc[a][b][m][n] = (f32x4){0.f, 0.f, 0.f, 0.f};
        }
        cur = nxt; cA = nA; cB = nB; ++ui;
        if constexpr (ALIGN_EPI) { if (wr == 1) PG8_BAR; }
    }
    PG8_WAIT_V(0);
    if constexpr (!ALIGN_EPI) { if (wr == 0) PG8_BAR; }
    PG8_BAR;
    if constexpr (Epi::AFTER_DRAIN) { E.fused(acc, cur, wr, wc, fr, fq, lds, wid, lane); S.done(cur); }
#undef PG8_SA
#undef PG8_SB
#undef PG8_STAGE
#undef PG8_LDA
#undef PG8_LDB
#undef PG8_MMA
#undef PG8_WAIT_V
#undef PG8_WAIT_L
#undef PG8_BAR
#undef PG8_SCHED
}
}

constexpr int D = 2048, NB = 4, S = 2048, M = NB * S, FF = 8192, H = 16, DH = 128, NBLK = 8, BLK = 256;
constexpr float EPS = 1e-6f;
constexpr int NWAVES = 8;
constexpr size_t MiB = 1u << 20;
constexpr size_t WS_CTL = 0, CTL_ZERO_BYTES = 32768;
constexpr size_t WS_WT = 1 * MiB;
constexpr size_t WE_WIN = 0, WE_WOUT = 33554432, WE_KVQ = 41943040, WE_Q1 = 54525952, WE_WO = 58720256, WE_W1 = 67108864, WE_W2 = 134217728, WE_END = 201326592;
constexpr size_t WS_XN = 385 * MiB, WS_QS = 417 * MiB, WS_KS = 449 * MiB, WS_VS = 481 * MiB, WS_GT = 513 * MiB, WS_GS = 545 * MiB, WS_OG = 609 * MiB, WS_U = 641 * MiB;
constexpr size_t WS_KRAW = 769 * MiB, WS_VV = 801 * MiB, WS_QRAW = 833 * MiB, WS_OF = 865 * MiB, WS_KN = 929 * MiB, WS_SMALL = 993 * MiB, WS_END = 994 * MiB;
constexpr size_t SM_LBS = 0, SM_KNORM = 16384, SM_QNORM = 16384 + 512, SM_KMEAN = 65536;
static_assert((4096 + 3456) * 4 <= 32768, "barrier words inside the memset");
constexpr int CW_BAR = 4096;
constexpr int RING_OFF = 0, RING_BYTES = 131072;
constexpr int LDSCTL_OFF = RING_BYTES, MISC_OFF = LDSCTL_OFF + 320;
constexpr int LDS_BYTES = 147456;

#define GAS __attribute__((address_space(1)))
#define LAS __attribute__((address_space(3)))
typedef unsigned short bf16;
typedef unsigned v4u __attribute__((ext_vector_type(4)));
typedef unsigned v2u __attribute__((ext_vector_type(2)));
typedef float f32x2 __attribute__((ext_vector_type(2)));
typedef float f32x4 __attribute__((ext_vector_type(4)));
typedef short bf16x8 __attribute__((ext_vector_type(8)));
typedef GAS unsigned gu32;
#define RLX_AGENT __ATOMIC_RELAXED, __HIP_MEMORY_SCOPE_AGENT
#define LDS_WAIT() asm volatile("s_waitcnt lgkmcnt(0)" ::: "memory")
#define VM_WAIT() asm volatile("s_waitcnt vmcnt(0)" ::: "memory")
__device__ __forceinline__ unsigned f2bf(float f) { unsigned u = __builtin_bit_cast(unsigned, f); return (u + 0x7fffu + ((u >> 16) & 1u)) >> 16; }
__device__ __forceinline__ unsigned pk2(float lo, float hi) { return f2bf(lo) | (f2bf(hi) << 16); }
__device__ __forceinline__ float bf2f(unsigned short b) { return __builtin_bit_cast(float, (unsigned)b << 16); }
__device__ __forceinline__ float bflo(unsigned w) { return __builtin_bit_cast(float, w << 16); }
__device__ __forceinline__ float bfhi(unsigned w) { return __builtin_bit_cast(float, w & 0xffff0000u); }
static_assert(WS_VS - WS_KS == WS_KS - WS_QS && WS_GT - WS_VS == WS_KS - WS_QS && WS_QRAW - WS_VV == WS_VV - WS_KRAW, "strided tensor groups");
#define XB_TMO      128
#define XB_XCNT(j)  (256  + 64 * (j))
#define XB_XSUB(j)  (1280 + 64 * (j))
#define XB_XGEN(j)  (2304 + 64 * (j))
#define XB_TOP      3328
#define XB_TOPGEN   3392
#define XCD_BAR_WORDS 3456
#define XB_SPIN_CAP (1u << 18)

__device__ __forceinline__ unsigned xb_ld(unsigned* p)              { return __hip_atomic_load(p, __ATOMIC_RELAXED, __HIP_MEMORY_SCOPE_AGENT); }
__device__ __forceinline__ unsigned xb_add(unsigned* p, unsigned v) { return __hip_atomic_fetch_add(p, v, __ATOMIC_RELAXED, __HIP_MEMORY_SCOPE_AGENT); }
__device__ __forceinline__ unsigned xb_xcc_id() { return (unsigned)__builtin_amdgcn_s_getreg((3 << 11) | 20) & 0xFu; }
#define XB_SPIN(cond, bar) do { unsigned _sp = 0; while (cond) { __builtin_amdgcn_s_sleep(1); \
    if ((++_sp & 255u) == 0u) { if (xb_ld(&(bar)[XB_TMO])) break; if (_sp > XB_SPIN_CAP) { atomicAdd(&(bar)[XB_TMO], 1u); break; } } } } while (0)

struct XcdBarrier {
    unsigned* bar; unsigned x;
    volatile LAS unsigned* st;
};

__device__ __forceinline__ XcdBarrier xcd_barrier_post(unsigned* bar, volatile LAS unsigned* st) {
    XcdBarrier b; b.bar = bar; b.x = xb_xcc_id(); b.st = st;
    if (threadIdx.x == 0) (void)xb_add(&bar[XB_XCNT(b.x)], 1u);
    return b;
}
__device__ __forceinline__ void xcd_barrier_complete(unsigned* bar, unsigned x, unsigned& nloc, unsigned& nx) {
    const unsigned G = gridDim.x * gridDim.y * gridDim.z;
    unsigned sum, cnt, mine, sp = 0u;
    for (;;) {
        sum = 0u; cnt = 0u; mine = 0u;
#pragma unroll
        for (unsigned j = 0; j < 16; ++j) { const unsigned c = xb_ld(&bar[XB_XCNT(j)]); sum += c; cnt += (c > 0u) ? 1u : 0u; mine = (j == x) ? c : mine; }
        if (sum == G) break;
        __builtin_amdgcn_s_sleep(1);
        if ((++sp & 255u) == 0u) { if (xb_ld(&bar[XB_TMO])) break; if (sp > XB_SPIN_CAP) { atomicAdd(&bar[XB_TMO], 1u); break; } }
    }
    nloc = mine > 0u ? mine : 1u; nx = cnt > 0u ? cnt : 1u;
}

__device__ __forceinline__ void xcd_barrier(const XcdBarrier& b) {
    asm volatile("s_waitcnt vmcnt(0)" ::: "memory");
    __syncthreads();
    if (threadIdx.x == 0) {
        unsigned* bar = b.bar;
        __builtin_amdgcn_s_waitcnt(0);
        unsigned nloc = b.st[0], nx = b.st[1];
        if (nloc == 0u) { xcd_barrier_complete(bar, b.x, nloc, nx); b.st[0] = nloc; b.st[1] = nx; }
        const unsigned old = xb_add(&bar[XB_XSUB(b.x)], 1u);
        const unsigned gen = old / nloc;
        if (old + 1u == (gen + 1u) * nloc) {
            __builtin_amdgcn_fence(__ATOMIC_RELEASE, "agent");
            asm volatile("s_waitcnt vmcnt(0)" ::: "memory");
            const unsigned og = xb_add(&bar[XB_TOP], 1u);
            const unsigned tg = og / nx;
            if (og + 1u == (tg + 1u) * nx) xb_add(&bar[XB_TOPGEN], 1u);
            else XB_SPIN(xb_ld(&bar[XB_TOPGEN]) == tg, bar);
            __builtin_amdgcn_fence(__ATOMIC_ACQUIRE, "agent");
            xb_add(&bar[XB_XGEN(b.x)], 1u);
            asm volatile("s_waitcnt vmcnt(0)" ::: "memory");
        } else {
            XB_SPIN(xb_ld(&bar[XB_XGEN(b.x)]) == gen, bar);
            __builtin_amdgcn_fence(__ATOMIC_ACQUIRE, "agent");
            asm volatile("s_waitcnt vmcnt(0)" ::: "memory");
        }
    }
    __syncthreads();
}


#define CW_XCC 0
#define CW_GRP(g) (512 + 64 * (g))
__device__ __forceinline__ bool xcd_groups_affine(unsigned* ctl, int G, int lane) {
    if (G != 256) return false;
    bool ok = true;
#pragma unroll
    for (int k = 0; k < 4; ++k) { const int e = lane + 64 * k; const unsigned v = xb_ld(&ctl[CW_XCC + e]), r = xb_ld(&ctl[CW_XCC + (e & 7)]); ok = ok && (v != 0u) && (v == r); }
    return __all(ok);
}
__device__ __forceinline__ void grp_barrier(unsigned* ctl, unsigned* bar, int grp, unsigned target) {
    asm volatile("s_waitcnt vmcnt(0)" ::: "memory");
    __syncthreads();
    if (threadIdx.x == 0) {
        __builtin_amdgcn_s_waitcnt(0);
        (void)xb_add(&ctl[CW_GRP(grp)], 1u);
        XB_SPIN(xb_ld(&ctl[CW_GRP(grp)]) < target, bar);
        __builtin_amdgcn_fence(__ATOMIC_ACQUIRE, "agent");
        asm volatile("s_waitcnt vmcnt(0)" ::: "memory");
    }
    __syncthreads();
}

struct Args { const float* in[16]; float* out; unsigned char* ws; int ph_lo, ph_hi, li, pad; };
enum InIdx { I_X = 0, I_ANORM, I_AWIN, I_AHEAD, I_AWOUT, I_LB, I_KVNORM, I_WKV, I_KNORM, I_BNORM, I_BWQ, I_BQNORM, I_BWO, I_MLPNORM, I_W1, I_W2 };
__device__ __forceinline__ const float* in_ptr(int i) {
    const __attribute__((address_space(4))) unsigned char* ka = (const __attribute__((address_space(4))) unsigned char*)__builtin_amdgcn_kernarg_segment_ptr();
    int off = i * 8; asm volatile("" : "+s"(off));
    const float* p = *(const float* const __attribute__((address_space(4)))*)(ka + off);
    return (const float*)(const GAS float*)p;
}

struct ItemRegs { f32x4 v[8], g0, g1; };
__device__ __forceinline__ void item_load(ItemRegs& r, const float* W, const float* gain, int K, int N, int item, int lane) {
    const int nblk = N / 32, kb = item / nblk, nb = item % nblk, k0 = 64 * kb, n0 = 32 * nb;
    const int ks = lane >> 3, n4 = (lane & 7) * 4, c = lane & 7;
#pragma unroll
    for (int i = 0; i < 8; ++i) r.v[i] = __builtin_nontemporal_load((const GAS f32x4*)(W + (size_t)(k0 + ks + 8 * i) * N + n0 + n4));
    const float* gp = gain ? gain + k0 + 8 * c : W;
    r.g0 = *(const GAS f32x4*)gp; r.g1 = *(const GAS f32x4*)(gp + 4);
    if (!gain) { r.g0 = (f32x4){1.f, 1.f, 1.f, 1.f}; r.g1 = r.g0; }
}
__device__ __forceinline__ void item_finish(const ItemRegs& r, int K, int N, bf16* WT, LAS float* scr, int item, int lane, int tiled) {
    const int nblk = N / 32, kb = item / nblk, nb = item % nblk, k0 = 64 * kb, n0 = 32 * nb;
    const int ks = lane >> 3, n4 = (lane & 7) * 4, c = lane & 7;
#pragma unroll
    for (int i = 0; i < 8; ++i) { LAS float* d = scr + (ks + 8 * i) * 33 + n4; d[0] = r.v[i].x; d[1] = r.v[i].y; d[2] = r.v[i].z; d[3] = r.v[i].w; }
    LDS_WAIT(); asm volatile("" ::: "memory");
#pragma unroll
    for (int j = 0; j < 4; ++j) { const int n = (lane >> 3) + 8 * j; const LAS float* s = scr + (8 * c) * 33 + n;
        v4u o; o.x = pk2(s[0 * 33] * r.g0.x, s[1 * 33] * r.g0.y); o.y = pk2(s[2 * 33] * r.g0.z, s[3 * 33] * r.g0.w); o.z = pk2(s[4 * 33] * r.g1.x, s[5 * 33] * r.g1.y); o.w = pk2(s[6 * 33] * r.g1.z, s[7 * 33] * r.g1.w);
        bf16* dst = tiled ? WT + (((size_t)((n0 + n) >> 8) * (K / 64) + kb) * 256 + ((n0 + n) & 255)) * 64 + 8 * c
                          : WT + (size_t)(n0 + n) * K + k0 + 8 * c;
        __builtin_nontemporal_store(o, (GAS v4u*)dst); }
    LDS_WAIT(); asm volatile("" ::: "memory");
}
struct MatDesc { const float* src; const float* gain; bf16* dst; int K, N, items, tiled; };
__device__ __forceinline__ MatDesc mat_desc(bf16* WT, int id) {
    MatDesc m; int kind, l;
    if (id < 4)        { kind = id; l = 0; }
    else if (id < 8)   { kind = id - 4; l = 1; }
    else if (id == 8)  { kind = 4; l = 0; }
    else if (id == 9)  { kind = 5; l = 0; }
    else if (id == 10) { kind = 6; l = 0; }
    else if (id == 11) { kind = 2; l = 2; }
    else if (id == 12) { kind = 3; l = 2; }
    else if (id == 13) { kind = 5; l = 1; }
    else if (id == 14) { kind = 6; l = 1; }
    else if (id == 15) { kind = 2; l = 3; }
    else               { kind = 3; l = 3; }
    if (kind == 0)      { m.src = in_ptr(I_AWIN) + (size_t)l * D * 4 * D; m.gain = in_ptr(I_ANORM) + l * D; m.dst = WT + WE_WIN + (size_t)l * D * 4 * D; m.K = D; m.N = 4 * D; }
    else if (kind == 1) { m.src = in_ptr(I_AWOUT) + (size_t)l * D * D; m.gain = in_ptr(I_AHEAD) + l * D; m.dst = WT + WE_WOUT + (size_t)l * D * D; m.K = D; m.N = D; }
    else if (kind == 2) { m.src = in_ptr(I_W1) + (size_t)l * D * FF; m.gain = in_ptr(I_MLPNORM) + l * D; m.dst = WT + WE_W1 + (size_t)l * D * FF; m.K = D; m.N = FF; }
    else if (kind == 3) { m.src = in_ptr(I_W2) + (size_t)l * FF * D; m.gain = nullptr; m.dst = WT + WE_W2 + (size_t)l * FF * D; m.K = FF; m.N = D; }
    else if (kind == 4) { m.src = in_ptr(I_WKV); m.gain = in_ptr(I_KVNORM); m.dst = WT + WE_KVQ; m.K = D; m.N = 2 * D; }
    else if (kind == 5) { m.src = in_ptr(I_BWQ) + (size_t)l * D * D; m.gain = in_ptr(I_BNORM) + l * D; m.dst = l == 0 ? WT + WE_KVQ + (size_t)2 * D * D : WT + WE_Q1; m.K = D; m.N = D; }
    else                { m.src = in_ptr(I_BWO) + (size_t)l * D * D; m.gain = nullptr; m.dst = WT + WE_WO + (size_t)l * D * D; m.K = D; m.N = D; }
    m.items = (m.K / 64) * (m.N / 32); m.tiled = 1; (void)kind;
    return m;
}
__device__ __forceinline__ void convert_weights(bf16* WT, int id_lo, int id_hi, int wv, int nwv, LAS float* scr, int lane) {
    int id = id_lo; MatDesc md = mat_desc(WT, id); int base = 0, it = wv;
    while (it >= base + md.items) { base += md.items; ++id; if (id >= id_hi) return; md = mat_desc(WT, id); }
    ItemRegs ra, rb;
    MatDesc ma = md; int ia = it - base; item_load(ra, ma.src, ma.gain, ma.K, ma.N, ia, lane);
    for (;;) {
        bool more = true; it += nwv;
        while (it >= base + md.items) { base += md.items; ++id; if (id >= id_hi) { more = false; break; } md = mat_desc(WT, id); }
        MatDesc mb = md; int ib = more ? it - base : 0;
        item_load(rb, mb.src, mb.gain, mb.K, mb.N, ib, lane);
        item_finish(ra, ma.K, ma.N, ma.dst, scr, ia, lane, ma.tiled);
        if (!more) return;
        it += nwv;
        while (it >= base + md.items) { base += md.items; ++id; if (id >= id_hi) { more = false; break; } md = mat_desc(WT, id); }
        ma = md; ia = more ? it - base : 0;
        item_load(ra, ma.src, ma.gain, ma.K, ma.N, ia, lane);
        item_finish(rb, mb.K, mb.N, mb.dst, scr, ib, lane, mb.tiled);
        if (!more) return;
    }
}
__device__ __forceinline__ void intake_row(const float* xrow, bf16* hbrow, float* psrow, int lane) {
    const GAS f32x4* xr = (const GAS f32x4*)xrow + lane;
    f32x4 v[8]; float s = 0.f;
#pragma unroll
    for (int j = 0; j < 8; ++j) { v[j] = xr[64 * j]; s += (v[j].x * v[j].x + v[j].y * v[j].y) + (v[j].z * v[j].z + v[j].w * v[j].w); }
    s = wave_sum(s);
#pragma unroll
    for (int j = 0; j < 8; ++j) { v2u w; w.x = pk2(v[j].x, v[j].y); w.y = pk2(v[j].z, v[j].w); const int col = (64 * j + lane) * 4;
        *(GAS v2u*)(hbrow + (size_t)(col >> 6) * (256 * 64) + (col & 63)) = w; }
    if (lane < 32) psrow[lane] = (lane == 0) ? s : 0.f;
}

constexpr int GC = 64, NCH = S / GC, GSPLIT = 20;
constexpr int GQ_PT = 0, GQ_SS = 4096, GQ_QT = 5120, GQ_KT = GQ_QT + 64 * 272, GQ_VT = GQ_KT + 64 * 272, GQ_AM = GQ_VT + 128 * 144, GQ_SX = 67584, GQ_KDT = GQ_SX + 128 * 272;
static_assert(GQ_AM + 64 * 144 <= GQ_SX && GQ_KDT + 128 * 144 <= RING_BYTES, "GLA LDS map");
__device__ __forceinline__ bf16x8 lds_frag(LAS const unsigned char* base, int stride_bytes, int row0, int k0, int lane) {
    return *(const LAS bf16x8*)(base + (row0 + (lane & 15)) * stride_bytes + (k0 + 8 * (lane >> 4)) * 2);
}
__device__ __forceinline__ unsigned cvtpk_bf16(float lo, float hi) { unsigned r; asm("v_cvt_pk_bf16_f32 %0, %1, %2" : "=v"(r) : "v"(lo), "v"(hi)); return r; }
__device__ __forceinline__ void gla_seq(int bh, int c_pre, int c_lo, int c_hi, const bf16* QS, const bf16* KS, const bf16* VS, const float* GS, const bf16* GT, bf16* OG, LAS unsigned char* L, int tid) {
    const int b = bh >> 4, h = bh & 15;
    const int lane = tid & 63, w = __builtin_amdgcn_readfirstlane(tid >> 6);
    const int tt = w >> 1, sh = w & 1, g4 = 4 * (lane >> 4), l15 = lane & 15;
    LAS float* PT = (LAS float*)(L + GQ_PT); LAS float* SS = (LAS float*)(L + GQ_SS);
    const size_t ebase = (size_t)b * S * D + h * DH;
    const __amdgpu_buffer_rsrc_t rq = __builtin_amdgcn_make_buffer_rsrc((void*)(QS + ebase), 0, S * D * 2, 0x00020000), rk = __builtin_amdgcn_make_buffer_rsrc((void*)(KS + ebase), 0, S * D * 2, 0x00020000);
    const __amdgpu_buffer_rsrc_t rv = __builtin_amdgcn_make_buffer_rsrc((void*)(VS + ebase), 0, S * D * 2, 0x00020000), rg = __builtin_amdgcn_make_buffer_rsrc((void*)((const _Float16*)GS + ebase), 0, S * D * 2, 0x00020000);
    const __amdgpu_buffer_rsrc_t rt = __builtin_amdgcn_make_buffer_rsrc((void*)(GT + ebase), 0, S * D * 2, 0x00020000), ro = __builtin_amdgcn_make_buffer_rsrc((void*)OG, 0, NB * S * D * 2, 0x00020000);
    const unsigned vo2 = (unsigned)((w * 8) * D + 2 * lane) * 2u, vo4 = vo2 * 2u;
    const unsigned vrow = (unsigned)((lane >> 2) * D + 16 * (lane & 3)) * 2u;
    f32x4 st[8];
#pragma unroll
    for (int j = 0; j < 8; ++j) st[j] = (f32x4){0.f, 0.f, 0.f, 0.f};
    f32x2 cs[8], gr[8]; unsigned qq[8], vv[8], graw[8];
#define GLA_LOAD_GV(c) do { const int so_ = (c) * GC * D * 2; \
        _Pragma("unroll") for (int i = 0; i < 8; ++i) { graw[i] = (unsigned)__builtin_amdgcn_raw_buffer_load_b32(rg, vo2, so_ + i * D * 2, 0); }     \
        _Pragma("unroll") for (int i = 0; i < 8; ++i) vv[i] = __builtin_amdgcn_raw_buffer_load_b32(rv, vo2, so_ + i * D * 2, 0); } while (0)
#define GLA_LOAD_Q(c) do { const int so_ = (c) * GC * D * 2; _Pragma("unroll") for (int i = 0; i < 8; ++i) qq[i] = __builtin_amdgcn_raw_buffer_load_b32(rq, vo2, so_ + i * D * 2, 0); } while (0)
#define GLA_CUMSUM() do { f32x2 run_ = (f32x2){0.f, 0.f}; _Pragma("unroll") for (int i = 0; i < 8; ++i) { const pg8::h16x2 g_ = __builtin_bit_cast(pg8::h16x2, graw[i]); gr[i] = (f32x2){(float)g_.x, (float)g_.y}; run_ += gr[i]; cs[i] = run_; } } while (0)
#define GLA_UPDATE() do { _Pragma("unroll") for (int j = 0; j < 8; ++j) st[j] = st[j] * dr; \
        _Pragma("unroll") for (int ks = 0; ks < 2; ++ks) { const bf16x8 a = lds_frag(L + GQ_KDT, 144, 16 * w, 32 * ks, lane); \
            _Pragma("unroll") for (int j = 0; j < 8; ++j) st[j] = __builtin_amdgcn_mfma_f32_16x16x32_bf16(a, lds_frag(L + GQ_VT, 144, 16 * j, 32 * ks, lane), st[j], 0, 0, 0); } } while (0)
#define GLA_VT_WRITE() do { \
        *(LAS v4u*)(L + GQ_VT + (2 * lane) * 144 + w * 16) = (v4u){(vv[0] & 0xffffu) | (vv[1] << 16), (vv[2] & 0xffffu) | (vv[3] << 16), (vv[4] & 0xffffu) | (vv[5] << 16), (vv[6] & 0xffffu) | (vv[7] << 16)}; \
        *(LAS v4u*)(L + GQ_VT + (2 * lane + 1) * 144 + w * 16) = (v4u){(vv[0] >> 16) | (vv[1] & 0xffff0000u), (vv[2] >> 16) | (vv[3] & 0xffff0000u), (vv[4] >> 16) | (vv[5] & 0xffff0000u), (vv[6] >> 16) | (vv[7] & 0xffff0000u)}; } while (0)
#define GLA_BAR() do { asm volatile("s_waitcnt lgkmcnt(0)" ::: "memory"); __builtin_amdgcn_s_barrier(); asm volatile("" ::: "memory"); } while (0)
    GLA_LOAD_GV(0);
    for (int c = 0; c < c_pre; ++c) {
        GLA_CUMSUM();
        *(LAS f32x2*)(PT + w * 128 + 2 * lane) = cs[7];
        GLA_BAR();
        {
            f32x2 offs = (f32x2){0.f, 0.f}, tot = offs;
#pragma unroll
            for (int p = 0; p < 8; ++p) { const f32x2 x = *(const LAS f32x2*)(PT + p * 128 + 2 * lane); tot += x; if (p < w) offs += x; }
            offs = tot - offs;
            unsigned kd0[4], kd1[4]; f32x2 kdp;
#pragma unroll
            for (int i = 0; i < 8; ++i) { const f32x2 y = offs - cs[i];
                const f32x2 kd = ((f32x2){1.f, 1.f} - (f32x2){__builtin_amdgcn_exp2f(gr[i].x), __builtin_amdgcn_exp2f(gr[i].y)}) * (f32x2){__builtin_amdgcn_exp2f(y.x), __builtin_amdgcn_exp2f(y.y)};
                if (i & 1) { kd0[i >> 1] = cvtpk_bf16(kdp.x, kd.x); kd1[i >> 1] = cvtpk_bf16(kdp.y, kd.y); } else kdp = kd; }
            *(LAS v4u*)(L + GQ_KDT + (2 * lane) * 144 + w * 16) = (v4u){kd0[0], kd0[1], kd0[2], kd0[3]};
            *(LAS v4u*)(L + GQ_KDT + (2 * lane + 1) * 144 + w * 16) = (v4u){kd1[0], kd1[1], kd1[2], kd1[3]};
            GLA_VT_WRITE();
        }
        f32x4 dr;
        {
            const int d0 = 16 * w + g4;
            const f32x4 pa = (*(const LAS f32x4*)(PT + d0) + *(const LAS f32x4*)(PT + 128 + d0)) + (*(const LAS f32x4*)(PT + 256 + d0) + *(const LAS f32x4*)(PT + 384 + d0));
            const f32x4 pb = (*(const LAS f32x4*)(PT + 512 + d0) + *(const LAS f32x4*)(PT + 640 + d0)) + (*(const LAS f32x4*)(PT + 768 + d0) + *(const LAS f32x4*)(PT + 896 + d0));
#pragma unroll
            for (int r = 0; r < 4; ++r) dr[r] = __builtin_amdgcn_exp2f(pa[r] + pb[r]);
        }
        GLA_LOAD_GV(c + 1);
        GLA_BAR();
        GLA_UPDATE();
    }
    GLA_LOAD_Q(c_lo);
    for (int c = c_lo; c < c_hi; ++c) {
        GLA_CUMSUM();
        *(LAS f32x2*)(PT + w * 128 + 2 * lane) = cs[7];
        GLA_BAR();
        {
            f32x2 offs = (f32x2){0.f, 0.f}, bref = offs, tot = offs;
#pragma unroll
            for (int p = 0; p < 8; ++p) { const f32x2 x = *(const LAS f32x2*)(PT + p * 128 + 2 * lane); tot += x; if (p < 4) bref += x; if (p < w) offs += x; }
            const f32x2 fdec = (f32x2){__builtin_amdgcn_exp2f(tot.x - bref.x), __builtin_amdgcn_exp2f(tot.y - bref.y)};
            offs -= bref;
            unsigned kd0[4], kd1[4]; f32x2 kdp;
#pragma unroll
            for (int i = 0; i < 8; ++i) { const f32x2 x = offs + cs[i];
                const f32x2 e1 = (f32x2){__builtin_amdgcn_exp2f(x.x), __builtin_amdgcn_exp2f(x.y)}, e2 = (f32x2){__builtin_amdgcn_exp2f(-x.x), __builtin_amdgcn_exp2f(-x.y)};
                const f32x2 qf = (f32x2){__uint_as_float(qq[i] << 16), __uint_as_float(qq[i] & 0xffff0000u)} * e1, kf = ((f32x2){1.f, 1.f} - (f32x2){__builtin_amdgcn_exp2f(gr[i].x), __builtin_amdgcn_exp2f(gr[i].y)}) * e2;
                *(LAS unsigned*)(L + GQ_QT + (w * 8 + i) * 272 + lane * 4) = cvtpk_bf16(qf.x, qf.y);
                *(LAS unsigned*)(L + GQ_KT + (w * 8 + i) * 272 + lane * 4) = cvtpk_bf16(kf.x, kf.y);
                const f32x2 kd = kf * fdec;
                if (i & 1) { kd0[i >> 1] = cvtpk_bf16(kdp.x, kd.x); kd1[i >> 1] = cvtpk_bf16(kdp.y, kd.y); } else kdp = kd; }
            *(LAS v4u*)(L + GQ_KDT + (2 * lane) * 144 + w * 16) = (v4u){kd0[0], kd0[1], kd0[2], kd0[3]};
            *(LAS v4u*)(L + GQ_KDT + (2 * lane + 1) * 144 + w * 16) = (v4u){kd1[0], kd1[1], kd1[2], kd1[3]};
            GLA_VT_WRITE();
        }
        f32x4 dr;
        {
            const int d0 = 16 * w + g4;
            const f32x4 pa = (*(const LAS f32x4*)(PT + d0) + *(const LAS f32x4*)(PT + 128 + d0)) + (*(const LAS f32x4*)(PT + 256 + d0) + *(const LAS f32x4*)(PT + 384 + d0));
            const f32x4 pb = (*(const LAS f32x4*)(PT + 512 + d0) + *(const LAS f32x4*)(PT + 640 + d0)) + (*(const LAS f32x4*)(PT + 768 + d0) + *(const LAS f32x4*)(PT + 896 + d0));
            f32x4 er;
#pragma unroll
            for (int r = 0; r < 4; ++r) { er[r] = __builtin_amdgcn_exp2f(pa[r]); dr[r] = __builtin_amdgcn_exp2f(pa[r] + pb[r]); }
#pragma unroll
            for (int j = 0; j < 8; ++j) { v2u o; o.x = cvtpk_bf16(st[j][0] * er[0], st[j][1] * er[1]); o.y = cvtpk_bf16(st[j][2] * er[2], st[j][3] * er[3]);
                *(LAS v2u*)(L + GQ_SX + (16 * j + l15) * 272 + d0 * 2) = o; }
        }
        { const int cn = (c + 1 < NCH) ? c + 1 : c; GLA_LOAD_GV(cn); GLA_LOAD_Q(cn); }
        const int so_out = ((c * GC + 16 * tt) * D + 64 * sh) * 2;
        const v4u gta = __builtin_amdgcn_raw_buffer_load_b128(rt, vrow, so_out, 0), gtb = __builtin_amdgcn_raw_buffer_load_b128(rt, vrow, so_out + 16, 0);
        GLA_BAR();
#pragma unroll
        for (int u = 0; u < 2; ++u) { const int stl = 2 * sh + u; f32x4 a = (f32x4){0.f, 0.f, 0.f, 0.f};
            if (stl <= tt) {
#pragma unroll
                for (int ks = 0; ks < 4; ++ks) a = __builtin_amdgcn_mfma_f32_16x16x32_bf16(lds_frag(L + GQ_QT, 272, 16 * tt, 32 * ks, lane), lds_frag(L + GQ_KT, 272, 16 * stl, 32 * ks, lane), a, 0, 0, 0);
            }
            const int s_ = 16 * stl + l15, t0 = 16 * tt + g4;
            const unsigned w01 = cvtpk_bf16(s_ <= t0 ? a[0] : 0.f, s_ <= t0 + 1 ? a[1] : 0.f), w23 = cvtpk_bf16(s_ <= t0 + 2 ? a[2] : 0.f, s_ <= t0 + 3 ? a[3] : 0.f);
            *(LAS unsigned short*)(L + GQ_AM + (t0 + 0) * 144 + s_ * 2) = (unsigned short)w01; *(LAS unsigned short*)(L + GQ_AM + (t0 + 1) * 144 + s_ * 2) = (unsigned short)(w01 >> 16);
            *(LAS unsigned short*)(L + GQ_AM + (t0 + 2) * 144 + s_ * 2) = (unsigned short)w23; *(LAS unsigned short*)(L + GQ_AM + (t0 + 3) * 144 + s_ * 2) = (unsigned short)(w23 >> 16); }
        GLA_UPDATE();
        GLA_BAR();
        f32x4 acc[4];
#pragma unroll
        for (int j = 0; j < 4; ++j) acc[j] = (f32x4){0.f, 0.f, 0.f, 0.f};
#pragma unroll
        for (int ks = 0; ks < 4; ++ks) { const bf16x8 a = lds_frag(L + GQ_QT, 272, 16 * tt, 32 * ks, lane);
#pragma unroll
            for (int j = 0; j < 4; ++j) acc[j] = __builtin_amdgcn_mfma_f32_16x16x32_bf16(a, lds_frag(L + GQ_SX, 272, 16 * (4 * sh + j), 32 * ks, lane), acc[j], 0, 0, 0); }
#pragma unroll
        for (int ks = 0; ks < 2; ++ks) { const bf16x8 a = lds_frag(L + GQ_AM, 144, 16 * tt, 32 * ks, lane);
#pragma unroll
            for (int j = 0; j < 4; ++j) acc[j] = __builtin_amdgcn_mfma_f32_16x16x32_bf16(a, lds_frag(L + GQ_VT, 144, 16 * (4 * sh + j), 32 * ks, lane), acc[j], 0, 0, 0); }
        float ssq[4];
#pragma unroll
        for (int r = 0; r < 4; ++r) { float x = 0.f;
#pragma unroll
            for (int j = 0; j < 4; ++j) x += acc[j][r] * acc[j][r];
            ssq[r] = sum16(x); }
        if (l15 == 0) {
#pragma unroll
            for (int r = 0; r < 4; ++r) SS[(16 * tt + g4 + r) * 2 + sh] = ssq[r]; }
        GLA_BAR();
        {
            LAS unsigned char* scr = L + GQ_SX + w * 4352;
#pragma unroll
            for (int r = 0; r < 4; ++r) { const int t = 16 * tt + g4 + r;
                const float rn = rsqrtf((SS[t * 2] + SS[t * 2 + 1]) * (1.0f / DH) + EPS);
#pragma unroll
                for (int j = 0; j < 4; ++j) *(LAS float*)(scr + (g4 + r) * 272 + (16 * j + l15) * 4) = acc[j][r] * rn; }
            asm volatile("s_waitcnt lgkmcnt(0)" ::: "memory");
            const LAS unsigned char* rp = scr + (lane >> 2) * 272 + (lane & 3) * 64;
            const f32x4 o0 = *(const LAS f32x4*)(rp), o1 = *(const LAS f32x4*)(rp + 16), o2 = *(const LAS f32x4*)(rp + 32), o3 = *(const LAS f32x4*)(rp + 48);
#define GSILU(x_) ({ const float g_ = fmaxf((x_), -80.f); g_ * __builtin_amdgcn_rcpf(1.f + __expf(-g_)); })
#define GMUL(o, gw) cvtpk_bf16(o[0] * GSILU(__uint_as_float(gw.x << 16)), o[1] * GSILU(__uint_as_float(gw.x & 0xffff0000u))), cvtpk_bf16(o[2] * GSILU(__uint_as_float(gw.y << 16)), o[3] * GSILU(__uint_as_float(gw.y & 0xffff0000u)))
            const v2u ga0 = (v2u){gta.x, gta.y}, ga1 = (v2u){gta.z, gta.w}, gb0 = (v2u){gtb.x, gtb.y}, gb1 = (v2u){gtb.z, gtb.w};
            const v4u wa = (v4u){GMUL(o0, ga0), GMUL(o1, ga1)}, wb = (v4u){GMUL(o2, gb0), GMUL(o3, gb1)};
#undef GMUL
#undef GSILU
            const int so_t = ((((b * 8 + (c >> 2)) * 32 + 2 * h + sh) * 256 + (c & 3) * 64 + 16 * tt) * 64) * 2;
            const unsigned vrow_t = (unsigned)((lane >> 2) * 64 + 16 * (lane & 3)) * 2u;
            __builtin_amdgcn_raw_buffer_store_b128(wa, ro, vrow_t, so_t, 0); __builtin_amdgcn_raw_buffer_store_b128(wb, ro, vrow_t, so_t + 16, 0);
        }
    }
#undef GLA_LOAD_GV
#undef GLA_LOAD_Q
#undef GLA_CUMSUM
#undef GLA_UPDATE
#undef GLA_VT_WRITE
#undef GLA_BAR
}


namespace moba {
using f32x16 = __attribute__((ext_vector_type(16))) float;
using s16x4  = __attribute__((ext_vector_type(4))) short;
using u32x4  = __attribute__((ext_vector_type(4))) unsigned;
constexpr int LD = 2048;
constexpr float SCALE = 0.088388347648318440f;
constexpr float C2 = SCALE * 1.4426950408889634f;
constexpr float THR2 = 8.0f * 1.4426950408889634f;
constexpr float NBIG = -30000.0f;
constexpr size_t SHM_V = 64 * 128 * 2, SHM_K = 64 * 128 * 2;
constexpr int OFF_WS = 3 * SHM_V + 2 * SHM_K, OFF_KM = OFF_WS + 8 * 64 * 4, OFF_KX = OFF_KM + 8 * 128 * 4, ATT_LDS = OFF_KX + 2048;
#define KSWZ(row, colB) ((row) * 256 + ((colB) ^ (((row) & 7) << 4)))
#define SBAR() __builtin_amdgcn_sched_barrier(0)
__device__ __forceinline__ int crow(int r, int hi) { return (r & 3) + 8 * (r >> 2) + 4 * hi; }
__device__ __forceinline__ unsigned cvtpk(float lo, float hi) { unsigned r; asm volatile("v_cvt_pk_bf16_f32 %0, %1, %2" : "=v"(r) : "v"(lo), "v"(hi)); return r; }
__device__ __forceinline__ void partialSM(f32x16& p0, f32x16& p1, float& m_reg, float& alpha, bool diag, int dlim) {
    const float NINF = -__builtin_inff();
    if (diag) {
#pragma unroll
        for (int r = 0; r < 16; ++r) { const int k0 = (r & 3) + 8 * (r >> 2); p0[r] = (k0 > dlim) ? NINF : p0[r]; p1[r] = (32 + k0 > dlim) ? NINF : p1[r]; }
    }
    float pmax = p0[0], pmax1 = p1[0];
#pragma unroll
    for (int r = 1; r < 16; ++r) { pmax = fmaxf(pmax, p0[r]); pmax1 = fmaxf(pmax1, p1[r]); }
    pmax = fmaxf(pmax, pmax1);
    { auto rr = __builtin_amdgcn_permlane32_swap(__float_as_uint(pmax), __float_as_uint(pmax), false, false);
      pmax = fmaxf(__uint_as_float(rr[0]), __uint_as_float(rr[1])); }
    if (__builtin_expect(__all(pmax <= THR2), 1)) alpha = 1.f;
    else { const float d = fmaxf(pmax, 0.f); alpha = __builtin_amdgcn_exp2f(-d); m_reg += d;
#pragma unroll
        for (int r = 0; r < 16; ++r) { p0[r] -= d; p1[r] -= d; } }
#pragma unroll
    for (int r = 0; r < 16; ++r) p0[r] = __builtin_amdgcn_exp2f(p0[r]);
}
__device__ __forceinline__ bf16x8 make_qx(float t, unsigned hmask) {
    const unsigned th = __float_as_uint(t) & 0xffff0000u; const float r1 = t - __uint_as_float(th);
    const unsigned tl = __float_as_uint(r1) & 0xffff0000u; const float r2 = r1 - __uint_as_float(tl);
    const unsigned tl2 = __float_as_uint(r2) & 0xffff0000u;
    u32x4 w = {0x3f803f80u & hmask, (th | 0x3f80u) & hmask, ((tl >> 16) | tl2) & hmask, 0u};
    return *reinterpret_cast<bf16x8*>(&w);
}
__device__ __forceinline__ void finishSM(f32x16& p0, f32x16& p1, float alpha, float& l_reg, bf16x8& pa0, bf16x8& pa1, bf16x8& pa2, bf16x8& pa3) {
#pragma unroll
    for (int r = 0; r < 16; ++r) p1[r] = __builtin_amdgcn_exp2f(p1[r]);
    float ps = 0.f;
#pragma unroll
    for (int r = 0; r < 16; ++r) ps += p0[r];
#pragma unroll
    for (int r = 0; r < 16; ++r) ps += p1[r];
    { auto rr = __builtin_amdgcn_permlane32_swap(__float_as_uint(ps), __float_as_uint(ps), false, false);
      ps = __uint_as_float(rr[0]) + __uint_as_float(rr[1]); }
    l_reg = l_reg * alpha + ps;
#define PK4(P, BASE, OUT) do { unsigned a0 = cvtpk(P[BASE + 0], P[BASE + 1]), a1 = cvtpk(P[BASE + 2], P[BASE + 3]);   \
    unsigned b0 = cvtpk(P[BASE + 4], P[BASE + 5]), b1 = cvtpk(P[BASE + 6], P[BASE + 7]);                              \
    auto r0 = __builtin_amdgcn_permlane32_swap(a0, b0, false, false); auto r1 = __builtin_amdgcn_permlane32_swap(a1, b1, false, false); \
    u32x4 w = {r0[0], r1[0], r0[1], r1[1]}; OUT = *reinterpret_cast<bf16x8*>(&w); } while (0)
    PK4(p0, 0, pa0); PK4(p0, 8, pa1); PK4(p1, 0, pa2); PK4(p1, 8, pa3);
#undef PK4
}
__device__ __forceinline__ void qkt(f32x16& p0, f32x16& p1, const LAS char* Ks, const LAS char* kxa, bf16x8 qx, const bf16x8* qr, int r32, int hi) {
    p0 = f32x16{}; p1 = f32x16{};
    { const bf16x8 kx0 = *(const LAS bf16x8*)(kxa), kx1 = *(const LAS bf16x8*)(kxa + 512);
      p0 = __builtin_amdgcn_mfma_f32_32x32x16_bf16(kx0, qx, p0, 0, 0, 0);
      p1 = __builtin_amdgcn_mfma_f32_32x32x16_bf16(kx1, qx, p1, 0, 0, 0); }
#pragma unroll
    for (int d0 = 0; d0 < 8; ++d0) { const int cb = (d0 * 16 + hi * 8) * 2;
        const bf16x8 b0 = *(const LAS bf16x8*)(Ks + KSWZ(r32, cb));
        const bf16x8 b1 = *(const LAS bf16x8*)(Ks + KSWZ(32 + r32, cb));
        p0 = __builtin_amdgcn_mfma_f32_32x32x16_bf16(b0, qr[d0], p0, 0, 0, 0);
        p1 = __builtin_amdgcn_mfma_f32_32x32x16_bf16(b1, qr[d0], p1, 0, 0, 0); }
}
__device__ __forceinline__ int v_st(int k, int c) { const int kk = (k & ~0xC) | ((k & 4) << 1) | ((k & 8) >> 1); return ((kk >> 3) * 4 + (c >> 5)) * 512 + ((kk & 7) * 32 + (c & 31)) * 2; }
__device__ __forceinline__ int v_rd_base(int lane) { return ((lane & 3) << 3) | (((lane >> 2) & 3) << 6) | (((lane >> 4) & 1) << 5) | (((lane >> 5) & 1) << 8); }
constexpr int v_rd_off(int d0, int ks, int half) { return d0 * 512 + ks * 4096 + half * 2048; }
template <int OFF> __device__ __forceinline__ s16x4 tr_read(int vb) {
    s16x4 r; asm volatile("ds_read_b64_tr_b16 %0, %1 offset:%2" : "=&v"(r) : "v"(vb), "i"(OFF) : "memory"); return r;
}
template <int D0> __device__ __forceinline__ void pv_one(f32x16& od, int vb, bf16x8 pa0, bf16x8 pa1, bf16x8 pa2, bf16x8 pa3) {
    const s16x4 l0 = tr_read<v_rd_off(D0, 0, 0)>(vb), h0 = tr_read<v_rd_off(D0, 0, 1)>(vb), l1 = tr_read<v_rd_off(D0, 1, 0)>(vb), h1 = tr_read<v_rd_off(D0, 1, 1)>(vb);
    const s16x4 l2 = tr_read<v_rd_off(D0, 2, 0)>(vb), h2 = tr_read<v_rd_off(D0, 2, 1)>(vb), l3 = tr_read<v_rd_off(D0, 3, 0)>(vb), h3 = tr_read<v_rd_off(D0, 3, 1)>(vb);
    asm volatile("s_waitcnt lgkmcnt(0)" ::: "memory"); SBAR();
#define PK(L, H) (bf16x8){L[0], L[1], L[2], L[3], H[0], H[1], H[2], H[3]}
    od = __builtin_amdgcn_mfma_f32_32x32x16_bf16(pa0, PK(l0, h0), od, 0, 0, 0);
    od = __builtin_amdgcn_mfma_f32_32x32x16_bf16(pa1, PK(l1, h1), od, 0, 0, 0);
    od = __builtin_amdgcn_mfma_f32_32x32x16_bf16(pa2, PK(l2, h2), od, 0, 0, 0);
    od = __builtin_amdgcn_mfma_f32_32x32x16_bf16(pa3, PK(l3, h3), od, 0, 0, 0);
#undef PK
}
__device__ __forceinline__ void pv_d0(f32x16* o, int vb, bf16x8 pa0, bf16x8 pa1, bf16x8 pa2, bf16x8 pa3) {
    pv_one<0>(o[0], vb, pa0, pa1, pa2, pa3); pv_one<1>(o[1], vb, pa0, pa1, pa2, pa3); pv_one<2>(o[2], vb, pa0, pa1, pa2, pa3); pv_one<3>(o[3], vb, pa0, pa1, pa2, pa3);
}
__device__ __forceinline__ void unit(const bf16* __restrict__ Qb, const bf16* __restrict__ Kh, const bf16* __restrict__ Vh, bf16* __restrict__ Ob,
                                     const float* __restrict__ qn, const float* __restrict__ kmp, int qb, int h, LAS char* lds, int tid_in) {
    int tid = tid_in;
    const int wid = __builtin_amdgcn_readfirstlane(tid >> 6), lane = tid & 63, r32 = lane & 31, hi = lane >> 5;
    LAS char* V_lds = lds; LAS char* K_lds = lds + 3 * SHM_V;
    LAS float* wsf = (LAS float*)(lds + OFF_WS) + wid * 64; LAS float* li_l = wsf; LAS float* al_l = wsf + 32;
    LAS float* KM = (LAS float*)(lds + OFF_KM);
    for (int i = tid; i < 8 * 128; i += 512) { const int n = i >> 7, d = i & 127; const float* p = kmp + (size_t)n * 512 + d; KM[i] = ((p[0] + p[128]) + (p[256] + p[384])) * (1.0f / 256.0f); }
    const float a2 = exp2f(-0.5f * (float)(h + 1)) * 1.4426950408889634f;
    if (tid < 128) {
        const float b = a2 * (float)(tid & 63);
        const unsigned bh = __float_as_uint(b) & 0xffff0000u; const float r1 = b - __uint_as_float(bh);
        const unsigned bl = __float_as_uint(r1) & 0xffff0000u; const float r2 = r1 - __uint_as_float(bl);
        const unsigned bl2 = __float_as_uint(r2) & 0xffff0000u;
        const v4u w = (tid < 64) ? (v4u){(bh >> 16) | bl, (bl2 >> 16) | 0x3f800000u, 0x3f803f80u, 0u} : (v4u){0u, 0u, 0u, 0u};
        *(LAS v4u*)(lds + OFF_KX + tid * 16) = w;
    }
    __syncthreads();
    float m_reg = 0.f, l_reg = 0.f; bf16x8 qr[8];
    unsigned selmask;
    {
        const bf16* Qw = Qb + (size_t)(wid * 32 + r32) * LD + hi * 8;
        v4u raw[8]; float ss = 0.f;
#pragma unroll
        for (int d0 = 0; d0 < 8; ++d0) { raw[d0] = *(const v4u*)(Qw + d0 * 16);
            const float x0 = bflo(raw[d0].x), x1 = bfhi(raw[d0].x), x2 = bflo(raw[d0].y), x3 = bfhi(raw[d0].y), x4 = bflo(raw[d0].z), x5 = bfhi(raw[d0].z), x6 = bflo(raw[d0].w), x7 = bfhi(raw[d0].w);
            ss += (x0 * x0 + x1 * x1) + (x2 * x2 + x3 * x3) + (x4 * x4 + x5 * x5) + (x6 * x6 + x7 * x7); }
        ss = half_sum(ss);
        const float rinv = rsqrtf(ss * (1.0f / 128.0f) + EPS);
        float gate[8];
#pragma unroll
        for (int n = 0; n < 8; ++n) gate[n] = 0.f;
#pragma unroll
        for (int d0 = 0; d0 < 8; ++d0) { const f32x4 g0 = *(const f32x4*)(qn + d0 * 16 + hi * 8), g1 = *(const f32x4*)(qn + d0 * 16 + hi * 8 + 4);
            const float q0 = bflo(raw[d0].x) * rinv * g0.x, q1 = bfhi(raw[d0].x) * rinv * g0.y, q2 = bflo(raw[d0].y) * rinv * g0.z, q3 = bfhi(raw[d0].y) * rinv * g0.w;
            const float q4 = bflo(raw[d0].z) * rinv * g1.x, q5 = bfhi(raw[d0].z) * rinv * g1.y, q6 = bflo(raw[d0].w) * rinv * g1.z, q7 = bfhi(raw[d0].w) * rinv * g1.w;
            if (qb > 3) {
#pragma unroll
                for (int n = 0; n < 8; ++n) { const f32x4 k0 = *(const LAS f32x4*)(KM + n * 128 + d0 * 16 + hi * 8), k1 = *(const LAS f32x4*)(KM + n * 128 + d0 * 16 + hi * 8 + 4);
                    gate[n] += (q0 * k0.x + q1 * k0.y) + (q2 * k0.z + q3 * k0.w) + (q4 * k1.x + q5 * k1.y) + (q6 * k1.z + q7 * k1.w); } }
            u32x4 w = {cvtpk(q0 * C2, q1 * C2), cvtpk(q2 * C2, q3 * C2), cvtpk(q4 * C2, q5 * C2), cvtpk(q6 * C2, q7 * C2)};
            qr[d0] = *reinterpret_cast<bf16x8*>(&w); }
        selmask = 0u;
        if (qb <= 3) selmask = (1u << qb) - 1u;
        else {
#pragma unroll
            for (int n = 0; n < 8; ++n) { gate[n] = half_sum(gate[n]); gate[n] = (n < qb) ? gate[n] : -3e38f; }
#pragma unroll
            for (int it = 0; it < 3; ++it) { float best = -3e38f; int bi = 0;
#pragma unroll
                for (int n = 0; n < 8; ++n) { const bool ok = (n < qb) && !((selmask >> n) & 1u); if (ok && gate[n] > best) { best = gate[n]; bi = n; } }
                selmask |= 1u << bi; }
        }
        selmask |= 1u << qb;
    }
    asm volatile("" : "+v"(tid));
    f32x16 o[4] = {};
    const unsigned hmask = hi ? 0u : 0xffffffffu;
    const LAS char* kxa = lds + OFF_KX + (hi * 64 + r32) * 16;
    const int trow = wid * 32 + r32;
#define TILE_PARAMS(j, yl, dg, dl) do { const int n_ = (j) >> 2, jj_ = (j) & 3; const float yb_ = a2 * (float)(64 * (j) - 256 * qb); \
        if (n_ < qb) { yl = ((selmask >> n_) & 1u) ? yb_ : NBIG; dg = false; dl = 0; } \
        else if (64 * jj_ + 63 <= 32 * wid) { yl = yb_; dg = false; dl = 0; } \
        else if (64 * jj_ > 32 * wid + 31) { yl = NBIG; dg = false; dl = 0; } \
        else { yl = yb_; dg = true; dl = trow - 64 * jj_ - 4 * hi; } } while (0)
    const int vb0 = (int)(uintptr_t)V_lds + v_rd_base(tid & 63);
    unsigned gk0, gk1, gv0, gv1;
    { const unsigned o0 = (unsigned)wid * 2048u + (unsigned)(tid & 63) * 16u, o1 = o0 + 1024u;
#define KOFF(o) (((o) >> 8) * (unsigned)(LD * 2) + (((((o) >> 4) & 15u) ^ (((o) >> 8) & 7u)) << 4))
#define VOFF(o, dst) do { const unsigned blk_ = (o) >> 9, p_ = (o) & 511u, kk_ = 8u * (blk_ >> 2) + (p_ >> 6), c_ = 32u * (blk_ & 3u) + ((p_ & 63u) >> 1); \
        const unsigned k_ = (kk_ & ~0xCu) | ((kk_ & 4u) << 1) | ((kk_ & 8u) >> 1); dst = k_ * (unsigned)(LD * 2) + c_ * 2u; } while (0)
      gk0 = KOFF(o0); gk1 = KOFF(o1); VOFF(o0, gv0); VOFF(o1, gv1);
#undef KOFF
#undef VOFF
    }
#define TLOAD(kslot, voff, k0) do { const char* kt_ = (const char*)Kh + (size_t)(k0) * (LD * 2); const char* vt_ = (const char*)Vh + (size_t)(k0) * (LD * 2); \
    __builtin_amdgcn_global_load_lds((const unsigned*)(kt_ + gk0), (LAS unsigned*)(K_lds + (kslot) * SHM_K + wid * 2048), 16, 0, 0); \
    __builtin_amdgcn_global_load_lds((const unsigned*)(kt_ + gk1), (LAS unsigned*)(K_lds + (kslot) * SHM_K + wid * 2048 + 1024), 16, 0, 0); \
    __builtin_amdgcn_global_load_lds((const unsigned*)(vt_ + gv0), (LAS unsigned*)(V_lds + (voff) + wid * 2048), 16, 0, 0); \
    __builtin_amdgcn_global_load_lds((const unsigned*)(vt_ + gv1), (LAS unsigned*)(V_lds + (voff) + wid * 2048 + 1024), 16, 0, 0); } while (0)
#define SWAIT() asm volatile("s_waitcnt vmcnt(0)" ::: "memory")
#define ABAR() do { asm volatile("s_waitcnt lgkmcnt(0)" ::: "memory"); __builtin_amdgcn_s_barrier(); asm volatile("" ::: "memory"); } while (0)
#define RESC(al) do { if (__any((al) < 1.f)) { if (hi == 0) al_l[r32] = (al); asm volatile("s_waitcnt lgkmcnt(0)" ::: "memory"); \
    _Pragma("unroll") for (int d = 0; d < 4; ++d) _Pragma("unroll") for (int r = 0; r < 16; ++r) o[d][r] *= al_l[crow(r, hi)]; } } while (0)
#define VNEXT(v) ((v) == 2 * (int)SHM_V ? 0 : (v) + (int)SHM_V)
    f32x16 pA0, pA1, pB0, pB1; float alA, alB; bf16x8 pa0, pa1, pa2, pa3; const int NT = 4 * (qb + 1);
    float yl; bool dg; int dl;
    TLOAD(0, 0, 0); TLOAD(1, (int)SHM_V, 64);
    SWAIT(); ABAR();
    TILE_PARAMS(0, yl, dg, dl);
    qkt(pA0, pA1, K_lds, kxa, make_qx(yl - m_reg, hmask), qr, r32, hi); partialSM(pA0, pA1, m_reg, alA, dg, dl);
    ABAR();
    int vr = 0, vw = 2 * (int)SHM_V;
    for (int j = 1; j + 1 < NT; j += 2) {
        TLOAD(0, vw, (j + 1) * 64);
        TILE_PARAMS(j, yl, dg, dl); SBAR();
        qkt(pB0, pB1, K_lds + SHM_K, kxa, make_qx(yl - m_reg, hmask), qr, r32, hi);
        finishSM(pA0, pA1, alA, l_reg, pa0, pa1, pa2, pa3); SBAR();
        pv_d0(o, vb0 + vr, pa0, pa1, pa2, pa3); partialSM(pB0, pB1, m_reg, alB, dg, dl);
        RESC(alB); SWAIT(); ABAR();
        vr = VNEXT(vr); vw = VNEXT(vw);
        TLOAD(1, vw, (j + 2) * 64);
        TILE_PARAMS(j + 1, yl, dg, dl); SBAR();
        qkt(pA0, pA1, K_lds, kxa, make_qx(yl - m_reg, hmask), qr, r32, hi);
        finishSM(pB0, pB1, alB, l_reg, pa0, pa1, pa2, pa3); SBAR();
        pv_d0(o, vb0 + vr, pa0, pa1, pa2, pa3); partialSM(pA0, pA1, m_reg, alA, dg, dl);
        RESC(alA); SWAIT(); ABAR();
        vr = VNEXT(vr); vw = VNEXT(vw);
    }
    TILE_PARAMS(NT - 1, yl, dg, dl);
    SBAR(); qkt(pB0, pB1, K_lds + SHM_K, kxa, make_qx(yl - m_reg, hmask), qr, r32, hi);
    finishSM(pA0, pA1, alA, l_reg, pa0, pa1, pa2, pa3); SBAR();
    pv_d0(o, vb0 + vr, pa0, pa1, pa2, pa3); partialSM(pB0, pB1, m_reg, alB, dg, dl);
    RESC(alB);
    finishSM(pB0, pB1, alB, l_reg, pa0, pa1, pa2, pa3); SBAR();
    vr = VNEXT(vr);
    pv_d0(o, vb0 + vr, pa0, pa1, pa2, pa3);
    if (hi == 0) li_l[r32] = l_reg; asm volatile("s_waitcnt lgkmcnt(0)" ::: "memory");
    asm volatile("" : "+v"(tid));
    float rli[16];
#pragma unroll
    for (int r = 0; r < 16; ++r) rli[r] = __builtin_amdgcn_rcpf(li_l[crow(r, hi)]);
    {
        const int hi2 = (tid >> 5) & 1, c32 = tid & 31, l64 = tid & 63;
        LAS char* scr = lds + ATT_LDS + wid * 4608;
        bf16* Og = Ob + (size_t)(wid * 32 + (l64 >> 1)) * 64 + (l64 & 1) * 32;
#pragma unroll
        for (int p = 0; p < 2; ++p) {
#pragma unroll
            for (int r = 0; r < 16; ++r) { const int orow = crow(r, hi2);
                *(LAS unsigned short*)(scr + orow * 144 + c32 * 2) = (unsigned short)cvtpk(o[2 * p][r] * rli[r], 0.f);
                *(LAS unsigned short*)(scr + orow * 144 + 64 + c32 * 2) = (unsigned short)cvtpk(o[2 * p + 1][r] * rli[r], 0.f); }
            asm volatile("s_waitcnt lgkmcnt(0)" ::: "memory");
            const LAS char* rp = scr + (l64 >> 1) * 144 + (l64 & 1) * 64;
            const v4u w0 = *(const LAS v4u*)(rp), w1 = *(const LAS v4u*)(rp + 16), w2 = *(const LAS v4u*)(rp + 32), w3 = *(const LAS v4u*)(rp + 48);
            asm volatile("s_waitcnt lgkmcnt(0)" ::: "memory");
            *(v4u*)(Og + p * (256 * 64)) = w0; *(v4u*)(Og + p * (256 * 64) + 8) = w1; *(v4u*)(Og + p * (256 * 64) + 16) = w2; *(v4u*)(Og + p * (256 * 64) + 24) = w3;
        }
    }
    __syncthreads();
#undef TLOAD
#undef SWAIT
#undef ABAR
#undef VNEXT
#undef RESC
#undef TILE_PARAMS
}
#undef KSWZ
#undef SBAR
}

__global__ void __launch_bounds__(NWAVES * 64, 2) fwd(Args args) {
    extern __shared__ __attribute__((aligned(16))) unsigned char lds_raw[];
    LAS unsigned char* lds = (LAS unsigned char*)lds_raw;
    volatile LAS unsigned* MISC = (volatile LAS unsigned*)(lds + MISC_OFF);
    const int tid0 = threadIdx.x, wave = __builtin_amdgcn_readfirstlane(tid0 >> 6);
    const int G = gridDim.x;
    unsigned char* ws = args.ws;
    gu32* ctl = (gu32*)(ws + WS_CTL);
    for (int u = tid0; u < (LDS_BYTES - LDSCTL_OFF) / 4; u += NWAVES * 64) ((LAS unsigned*)(lds + LDSCTL_OFF))[u] = 0u;
    __syncthreads();
    XcdBarrier bar = xcd_barrier_post((unsigned*)(ctl + CW_BAR) + args.li * XCD_BAR_WORDS, MISC + 8);
    if (threadIdx.x == 0) __hip_atomic_store((unsigned*)ctl + CW_XCC + blockIdx.x, bar.x + 1u, __ATOMIC_RELAXED, __HIP_MEMORY_SCOPE_AGENT);

#define WT   ((bf16*)(wsp + WS_WT))
#define HB   ((bf16*)(wsp + WS_XN))
#define PSUM ((float*)(wsp + WS_OF + 2 * MiB))
#define RSL  ((LAS float*)(lds + LDSCTL_OFF + 1024))
#define QS   ((bf16*)(wsp + WS_QS))
#define KS   ((bf16*)(wsp + WS_KS))
#define VS   ((bf16*)(wsp + WS_VS))
#define GT   ((bf16*)(wsp + WS_GT))
#define GS   ((float*)(wsp + WS_GS))
#define OG   ((bf16*)(wsp + WS_OG))
#define U    ((bf16*)(wsp + WS_U))
#define KRAW ((bf16*)(wsp + WS_KRAW))
#define VV   ((bf16*)(wsp + WS_VV))
#define QRAW ((bf16*)(wsp + WS_QRAW))
#define LBS  ((float*)(wsp + WS_SMALL + SM_LBS))
#define KNORMC ((float*)(wsp + WS_SMALL + SM_KNORM))
#define QNORMC ((float*)(wsp + WS_SMALL + SM_QNORM))
#define KNB  ((bf16*)(wsp + WS_KN))
#define KMP  ((float*)(wsp + WS_OF))
    float* hres = args.out;
    const int lo = args.ph_lo, hi = args.ph_hi;
    const int NGW = G * NWAVES;
    bool any = false, affine = false; unsigned lseq = 0;
#define PHASE_BEGIN(p) if (lo <= (p) && (p) < hi) { if (any) xcd_barrier(bar); any = true; GAS unsigned char* wsp = (GAS unsigned char*)args.ws; asm volatile("" : "+s"(wsp)); int bx = blockIdx.x; asm volatile("" : "+s"(bx)); (void)bx; int tz_ = threadIdx.x; asm volatile("" : "+v"(tz_)); const int tid = tz_, lane = tz_ & 63; (void)tid; (void)lane;
#define PHASE_END() }
#define PHASE_BEGIN_L(p) if (lo <= (p) && (p) < hi) { if (any) { if (affine) { ++lseq; grp_barrier((unsigned*)ctl, bar.bar, blockIdx.x & 7, 32u * lseq); } else xcd_barrier(bar); } any = true; GAS unsigned char* wsp = (GAS unsigned char*)args.ws; asm volatile("" : "+s"(wsp)); int bx = blockIdx.x; asm volatile("" : "+s"(bx)); (void)bx; int tz_ = threadIdx.x; asm volatile("" : "+v"(tz_)); const int tid = tz_, lane = tz_ & 63; (void)tid; (void)lane;

    PHASE_BEGIN(0)
        {
            const int d = bx * (NWAVES * 64) + tid;
            if (d < D) { const float a = in_ptr(I_LB)[d], b = in_ptr(I_LB)[D + d], mx = fmaxf(a, b), ea = expf(a - mx), eb = expf(b - mx), sm = ea + eb, p0 = ea / sm, p1 = eb / sm;
                LBS[d] = 0.f; LBS[D + d] = (p0 + p1) - p0; }
            if (d < 128) KNORMC[d] = in_ptr(I_KNORM)[d];
            if (d < 256) QNORMC[d] = in_ptr(I_BQNORM)[d];
        }
        for (int m = bx * NWAVES + wave; m < M; m += NGW) intake_row(in_ptr(I_X) + (size_t)m * D, HB + ((size_t)(m >> 8) * (D / 64) * 256 + (m & 255)) * 64, PSUM + (size_t)m * 32, lane);
        {
            LAS float* scr = (LAS float*)(lds + RING_OFF + wave * 16384);
            convert_weights(WT, 0, 1, bx * NWAVES + wave, NGW, scr, lane);
        }
    PHASE_END()

    for (int l = 0; l < 4; ++l) {
        const int pb = 1 + 9 * l;
        if (l == 0) {
            PHASE_BEGIN(pb + 1)
                affine = xcd_groups_affine((unsigned*)ctl, G, lane);
                pg8::Gemm g = pg8::gemm_tiled(HB, WT + WE_WIN + (size_t)l * D * 4 * D, M, 4 * D, D); pg8::StaticOrder So; So.init(M, 4 * D, G, bx);
                pg8::EpiHgrn E{QS, (size_t)(WS_KS - WS_QS) / 2, GS, LBS + l * D, RSL}; pg8::row_scale_table(PSUM, RSL, So, tid);
                pg8::gemm_phase<pg8::EpiHgrn, pg8::StaticOrder, true, true>(lds + RING_OFF, g, So, E);
            PHASE_END()
        } else if (l < 2) {
            PHASE_BEGIN_L(pb + 1)
                pg8::Gemm g = pg8::gemm_tiled(HB, WT + WE_WIN + (size_t)l * D * 4 * D, M, 4 * D, D); pg8::StaticOrder So; So.init(M, 4 * D, G, bx);
                pg8::EpiHgrn E{QS, (size_t)(WS_KS - WS_QS) / 2, GS, LBS + l * D, RSL}; pg8::row_scale_table(PSUM, RSL, So, tid);
                pg8::gemm_phase<pg8::EpiHgrn, pg8::StaticOrder, true, true>(lds + RING_OFF, g, So, E);
            PHASE_END()
        } else {
            PHASE_BEGIN_L(pb + 1)
                const bool first = (l == 2);
                pg8::Gemm g = pg8::gemm_tiled(HB, first ? WT + WE_KVQ : WT + WE_Q1, M, first ? 3 * D : D, D); pg8::StaticOrder So; So.init(M, first ? 3 * D : D, G, bx);
                pg8::EpiSplit E{KRAW, (size_t)(WS_VV - WS_KRAW) / 2, first ? 0 : 2, RSL, first ? KNB : (bf16*)nullptr, KMP, KNORMC, (LAS float*)(lds + LDSCTL_OFF + 9216)}; pg8::row_scale_table(PSUM, RSL, So, tid);
                pg8::gemm_phase<pg8::EpiSplit, pg8::StaticOrder, true, true>(lds + RING_OFF, g, So, E);
            PHASE_END()
        }
        if (l < 2) {
            PHASE_BEGIN(pb + 2)
                const int nseg = (G >= 3 * NB * H) ? 2 : 1, ngla = nseg * NB * H;
                if (bx < ngla) { const int seg = bx / (NB * H), bh = bx - seg * (NB * H);
                    const int c0 = seg ? GSPLIT : 0, c1 = (nseg == 2 && seg == 0) ? GSPLIT : NCH;
                    gla_seq(bh, c0, c0, c1, QS, KS, VS, GS, GT, OG, lds + RING_OFF, tid); }
                else if (G > ngla) convert_weights(WT, l == 0 ? 1 : 8, l == 0 ? 8 : 17, (bx - ngla) * NWAVES + wave, (G - ngla) * NWAVES, (LAS float*)(lds + RING_OFF + wave * 16384), lane);
            PHASE_END()
        } else {
            PHASE_BEGIN(pb + 4)
                for (int pi = bx; pi < 256; pi += G) {
                    const int bh = pi & 63, pr = pi >> 6, b = bh >> 4, h = bh & 15;
                    for (int u = 0; u < 2; ++u) {
                        const int qb = u == 0 ? 7 - pr : pr;
                        const size_t qoff = ((size_t)b * S + 256 * qb) * D + h * DH, koff = (size_t)b * S * D + h * DH;
                        moba::unit(QRAW + qoff, KNB + koff, VV + koff, OG + (size_t)((b * 8 + qb) * 32 + 2 * h) * (256 * 64), QNORMC + (size_t)(l - 2) * DH, KMP + (size_t)bh * 4096, qb, h, (LAS char*)(lds + RING_OFF), tid);
                    }
                }
            PHASE_END()
        }
        PHASE_BEGIN(pb + 5)
            pg8::Gemm g = pg8::gemm_tiled(OG, l < 2 ? WT + WE_WOUT + (size_t)l * D * D : WT + WE_WO + (size_t)(l - 2) * D * D, M, D, D); pg8::StaticOrder So; So.init(M, D, G, bx);
            pg8::EpiRes<false> E{HB, PSUM, nullptr, D};
            pg8::gemm_phase<pg8::EpiRes<false>, pg8::StaticOrder, true, true>(lds + RING_OFF, g, So, E);
        PHASE_END()
        PHASE_BEGIN_L(pb + 7)
            pg8::Gemm g = pg8::gemm_tiled(HB, WT + WE_W1 + (size_t)l * D * FF, M, FF, D); pg8::StaticOrder So; So.init(M, FF, G, bx);
            pg8::EpiRelu2 E{U, FF, RSL}; pg8::row_scale_table(PSUM, RSL, So, tid);
            pg8::gemm_phase<pg8::EpiRelu2, pg8::StaticOrder, true, true>(lds + RING_OFF, g, So, E);
        PHASE_END()
        PHASE_BEGIN_L(pb + 8)
            pg8::Gemm g{U, WT + WE_W2 + (size_t)l * FF * D, M, D, FF, 64, 64, 32768, 32768, (size_t)(FF / 64) * 32768, (size_t)(FF / 64) * 32768};     pg8::StaticOrder So; So.init(M, D, G, bx);
            if (l == 3) { pg8::EpiRes<true> E{HB, PSUM, hres, D}; pg8::gemm_phase<pg8::EpiRes<true>, pg8::StaticOrder, true, true>(lds + RING_OFF, g, So, E); }
            else { pg8::EpiRes<false> E{HB, PSUM, nullptr, D}; pg8::gemm_phase<pg8::EpiRes<false>, pg8::StaticOrder, true, true>(lds + RING_OFF, g, So, E); }
        PHASE_END()
    }
#undef PHASE_BEGIN
#undef PHASE_BEGIN_L
#undef PHASE_END
#undef WT
#undef HB
#undef PSUM
#undef RSL
#undef QS
#undef KS
#undef VS
#undef GT
#undef GS
#undef OG
#undef U
#undef KRAW
#undef VV
#undef QRAW
#undef LBS
#undef KNORMC
#undef QNORMC
#undef KNB
#undef KMP
}

extern "C" void kernel_launch(void* const* d_in, const int* in_sizes, int n_in, void* d_out, int out_size, void* d_ws, size_t ws_size, hipStream_t stream) {
    static int grid = 0;
    if (grid == 0) {
        if (n_in != 16 || out_size != M * D || ws_size < WS_END) { fprintf(stderr, "kernel_launch: unexpected sizes (n_in %d, out %d, ws %zu < %zu); nothing launched\n", n_in, out_size, ws_size, (size_t)WS_END); grid = -1; return; }
        int dev = 0, cus = 0, per_cu = 0;
        if (hipGetDevice(&dev) != hipSuccess || hipDeviceGetAttribute(&cus, hipDeviceAttributeMultiprocessorCount, dev) != hipSuccess) { grid = -1; return; }
        if (hipFuncSetAttribute((const void*)fwd, hipFuncAttributeMaxDynamicSharedMemorySize, LDS_BYTES) != hipSuccess) { fprintf(stderr, "kernel_launch: hipFuncSetAttribute failed\n"); grid = -1; return; }
        if (hipOccupancyMaxActiveBlocksPerMultiprocessor(&per_cu, (const void*)fwd, NWAVES * 64, LDS_BYTES) != hipSuccess || per_cu < 1) { fprintf(stderr, "kernel_launch: occupancy query says %d blocks per CU\n", per_cu); }
        (void)hipGetLastError();
        grid = cus;
    }
    if (grid < 0) return;
    if (hipMemsetAsync((char*)d_ws + WS_CTL, 0, CTL_ZERO_BYTES, stream) != hipSuccess) return;
    Args a{};
    for (int i = 0; i < 16; ++i) a.in[i] = (const float*)d_in[i];
    a.out = (float*)d_out; a.ws = (unsigned char*)d_ws;
    a.ph_lo = 0; a.ph_hi = 37; a.li = 0;
    hipLaunchKernelGGL(fwd, dim3(grid), dim3(NWAVES * 64), LDS_BYTES, stream, a);
}
```
